# Optimizing an MI355X kernel written in HIP

```python
import math
import jax, jax.numpy as jnp
from jax import lax
import numpy as np

D_MODEL = 1024
BATCH = 8
SEQ = 8192
DEPTH = 2

N_MIXERS = 2
ROPE_THETA = 10000.0
LN_EPS = 1e-5
DN_ALPHA = (2 * DEPTH) ** 0.25
DN_BETA = (8 * DEPTH) ** -0.25

DA_HEAD_DIM = 64
DA_HEADS = D_MODEL // (2 * DA_HEAD_DIM)
DA_Q_BLOCK = 128

SW_HEAD_DIM = 64
SW_HEADS = D_MODEL // SW_HEAD_DIM
SW_KV_HEADS = max(1, SW_HEADS // 8)
SW_GROUP = SW_HEADS // SW_KV_HEADS
SW_WINDOW = 128
SW_BLOCK = 128

PK_HEADS = 8
PK_N_KEYS = 128
PK_N_EXPERTS = PK_N_KEYS * PK_N_KEYS
PK_KEY_DIM = 128
PK_TOPK = 16
PK_TOKEN_BLOCK = 128

N_DIFF_LAYERS = (DEPTH + 1) // 2
N_SWA_LAYERS = DEPTH // 2

kernel_name = 'hybrid_diffattn_swa_sinks_peer_deepnorm'


def layer_norm(x, g, b):
    xf = x.astype(jnp.float32)
    mu = xf.mean(-1, keepdims=True)
    var = jnp.square(xf - mu).mean(-1, keepdims=True)
    return ((xf - mu) * lax.rsqrt(var + LN_EPS) * g.astype(jnp.float32) + b.astype(jnp.float32)).astype(x.dtype)


def rms_norm(x, g):
    xf = x.astype(jnp.float32)
    y = xf * lax.rsqrt(jnp.mean(xf * xf, -1, keepdims=True) + LN_EPS) * g.astype(jnp.float32)
    return y.astype(x.dtype)


def rope_tables(seq, dim):
    inv = 1.0 / (ROPE_THETA ** (jnp.arange(0, dim, 2, dtype=jnp.float32) / dim))
    ang = jnp.arange(seq, dtype=jnp.float32)[:, None] * inv[None, :]
    return jnp.cos(ang), jnp.sin(ang)


def apply_rope(t, cos, sin):
    t1, t2 = jnp.split(t.astype(jnp.float32), 2, axis=-1)
    c = cos[None, :, None, :]
    s = sin[None, :, None, :]
    return jnp.concatenate([t1 * c - t2 * s, t2 * c + t1 * s], axis=-1).astype(t.dtype)


def diff_attention(x, w_qkv, lam_params, subln_g, w_o, lambda_init, cos, sin):
    B, S, _ = x.shape
    H, d = DA_HEADS, DA_HEAD_DIM
    q, k, v = jnp.split(x @ w_qkv, 3, axis=-1)
    q = apply_rope(q.reshape(B, S, 2 * H, d), cos, sin).reshape(B, S, H, 2, d)
    k = apply_rope(k.reshape(B, S, 2 * H, d), cos, sin).reshape(B, S, H, 2, d)
    v = v.reshape(B, S, H, 2 * d)
    lp = lam_params.astype(jnp.float32)
    lam = jnp.exp(jnp.sum(lp[0] * lp[1])) - jnp.exp(jnp.sum(lp[2] * lp[3])) + lambda_init
    nb = S // DA_Q_BLOCK
    qb = q.reshape(B, nb, DA_Q_BLOCK, H, 2, d).transpose(1, 0, 2, 3, 4, 5)
    kpos = jnp.arange(S)
    scale = d ** -0.5

    def one_block(args):
        qi, bi = args
        s = jnp.einsum('bqhpd,bkhpd->bhpqk', qi, k, preferred_element_type=jnp.float32) * scale
        qpos = bi * DA_Q_BLOCK + jnp.arange(DA_Q_BLOCK)
        s = jnp.where((kpos[None, :] <= qpos[:, None])[None, None, None], s, -jnp.inf)
        p = jax.nn.softmax(s, axis=-1)
        a = p[:, :, 0] - lam * p[:, :, 1]
        return jnp.einsum('bhqk,bkhe->bqhe', a.astype(v.dtype), v)

    o = lax.map(one_block, (qb, jnp.arange(nb)))
    o = o.transpose(1, 0, 2, 3, 4).reshape(B, S, H, 2 * d)
    o = rms_norm(o, subln_g) * (1.0 - lambda_init)
    return o.reshape(B, S, H * 2 * d) @ w_o


def swa_attention(x, w_qkv, b_qkv, sinks, w_o, b_o, cos, sin):
    B, S, _ = x.shape
    H, KV, G, d, L = SW_HEADS, SW_KV_HEADS, SW_GROUP, SW_HEAD_DIM, SW_BLOCK
    qkv = x @ w_qkv + b_qkv
    q, k, v = jnp.split(qkv, [H * d, (H + KV) * d], axis=-1)
    q = apply_rope(q.reshape(B, S, H, d), cos, sin)
    k = apply_rope(k.reshape(B, S, KV, d), cos, sin)
    v = v.reshape(B, S, KV, d)
    nb = S // L
    qb = q.reshape(B, nb, L, KV, G, d)

    def banded(t):
        tb = t.reshape(B, nb, L, KV, d)
        prev = jnp.pad(tb, ((0, 0), (1, 0), (0, 0), (0, 0), (0, 0)))[:, :-1]
        return jnp.concatenate([prev, tb], axis=2)

    kb, vb = banded(k), banded(v)
    s = jnp.einsum('bnqkgd,bnjkd->bnkgqj', qb, kb, preferred_element_type=jnp.float32) * (d ** -0.5)
    qi = jnp.arange(L)[:, None] + L
    kj = jnp.arange(2 * L)[None, :]
    rel = qi - kj
    local = (rel >= 0) & (rel < SW_WINDOW)
    valid = local[None] & ((jnp.arange(nb)[:, None, None] > 0) | (kj[None] >= L))
    s = jnp.where(valid[None, :, None, None], s, -jnp.inf)
    sink = sinks.astype(jnp.float32).reshape(KV, G)[None, None, :, :, None, None]
    m = jnp.maximum(s.max(-1, keepdims=True), sink)
    e = jnp.exp(s - m)
    p = e / (e.sum(-1, keepdims=True) + jnp.exp(sink - m))
    o = jnp.einsum('bnkgqj,bnjkd->bnqkgd', p.astype(vb.dtype), vb).reshape(B, S, H * d)
    return o @ w_o + b_o


def peer(x, w_query, sub_keys, u_emb, v_emb):
    B, S, D = x.shape
    K = PK_TOPK
    xt = x.reshape((B * S) // PK_TOKEN_BLOCK, PK_TOKEN_BLOCK, D)

    def one_block(xb):
        Tb = xb.shape[0]
        q = (xb @ w_query).reshape(Tb, PK_HEADS, 2, PK_KEY_DIM // 2)
        sc = jnp.einsum('thcd,hcnd->thcn', q, sub_keys, preferred_element_type=jnp.float32)
        s1, i1 = lax.top_k(sc[:, :, 0], K)
        s2, i2 = lax.top_k(sc[:, :, 1], K)
        cand = (s1[..., :, None] + s2[..., None, :]).reshape(Tb, PK_HEADS, K * K)
        cidx = (i1[..., :, None] * PK_N_KEYS + i2[..., None, :]).reshape(Tb, PK_HEADS, K * K)
        top_s, pos = lax.top_k(cand, K)
        eidx = jnp.take_along_axis(cidx, pos, axis=-1)
        g = jax.nn.softmax(top_s, axis=-1)
        u = u_emb[eidx]
        hval = jax.nn.gelu(jnp.einsum('thkd,td->thk', u, xb, preferred_element_type=jnp.float32), approximate=False)
        w = (g * hval).astype(xb.dtype)
        return jnp.einsum('thk,thkd->td', w, v_emb[eidx])

    return lax.map(one_block, xt).reshape(B, S, D)


def setup_inputs(seed: int = 0) -> dict:
    key = jax.random.key(seed)
    ks = jax.random.split(key, 20)
    f32 = jnp.float32
    D = D_MODEL

    def nrm(k, shape, scale):
        return jax.random.normal(k, shape, f32) * scale

    x = nrm(ks[0], (BATCH, SEQ, D), 1.0)
    da_w_qkv = nrm(ks[1], (N_DIFF_LAYERS, D, 3 * D), D ** -0.5)
    da_w_qkv = da_w_qkv.at[..., 2 * D:].multiply(DN_BETA)
    da_lambda = nrm(ks[2], (N_DIFF_LAYERS, 4, DA_HEAD_DIM), 0.1)
    da_subln_g = 1.0 + nrm(ks[3], (N_DIFF_LAYERS, 2 * DA_HEAD_DIM), 0.02)
    da_w_o = nrm(ks[4], (N_DIFF_LAYERS, D, D), D ** -0.5 * DN_BETA)
    sw_width = (SW_HEADS + 2 * SW_KV_HEADS) * SW_HEAD_DIM
    sw_w_qkv = nrm(ks[5], (N_SWA_LAYERS, D, sw_width), D ** -0.5)
    sw_w_qkv = sw_w_qkv.at[..., (SW_HEADS + SW_KV_HEADS) * SW_HEAD_DIM:].multiply(DN_BETA)
    sw_b_qkv = nrm(ks[6], (N_SWA_LAYERS, sw_width), 0.02)
    sw_sinks = nrm(ks[7], (N_SWA_LAYERS, SW_HEADS), 0.5)
    sw_w_o = nrm(ks[8], (N_SWA_LAYERS, SW_HEADS * SW_HEAD_DIM, D), (SW_HEADS * SW_HEAD_DIM) ** -0.5 * DN_BETA)
    sw_b_o = nrm(ks[9], (N_SWA_LAYERS, D), 0.02)
    pk_w_query = nrm(ks[10], (DEPTH, D, PK_HEADS * PK_KEY_DIM), D ** -0.5)
    pk_sub_keys = nrm(ks[11], (DEPTH, PK_HEADS, 2, PK_N_KEYS, PK_KEY_DIM // 2), (PK_KEY_DIM // 2) ** -0.5)
    pk_u = nrm(ks[12], (DEPTH, PK_N_EXPERTS, D), D ** -0.5)
    pk_v = nrm(ks[13], (DEPTH, PK_N_EXPERTS, D), DN_BETA * PK_HEADS ** -0.5)
    ln1_g = 1.0 + nrm(ks[14], (DEPTH, D), 0.02)
    ln1_b = nrm(ks[15], (DEPTH, D), 0.02)
    ln2_g = 1.0 + nrm(ks[16], (DEPTH, D), 0.02)
    ln2_b = nrm(ks[17], (DEPTH, D), 0.02)
    return {'x': x, 'da_w_qkv': da_w_qkv, 'da_lambda': da_lambda, 'da_subln_g': da_subln_g,
            'da_w_o': da_w_o, 'sw_w_qkv': sw_w_qkv, 'sw_b_qkv': sw_b_qkv, 'sw_sinks': sw_sinks,
            'sw_w_o': sw_w_o, 'sw_b_o': sw_b_o, 'pk_w_query': pk_w_query, 'pk_sub_keys': pk_sub_keys,
            'pk_u': pk_u, 'pk_v': pk_v, 'ln1_g': ln1_g, 'ln1_b': ln1_b, 'ln2_g': ln2_g, 'ln2_b': ln2_b}


def reference(x, da_w_qkv, da_lambda, da_subln_g, da_w_o, sw_w_qkv, sw_b_qkv, sw_sinks, sw_w_o, sw_b_o,
              pk_w_query, pk_sub_keys, pk_u, pk_v, ln1_g, ln1_b, ln2_g, ln2_b):
    S = x.shape[1]
    cos, sin = rope_tables(S, DA_HEAD_DIM)
    for i in range(DEPTH):
        j = i // N_MIXERS
        if i % N_MIXERS == 0:
            lambda_init = 0.8 - 0.6 * math.exp(-0.3 * i)
            mix = diff_attention(x, da_w_qkv[j], da_lambda[j], da_subln_g[j], da_w_o[j], lambda_init, cos, sin)
        else:
            mix = swa_attention(x, sw_w_qkv[j], sw_b_qkv[j], sw_sinks[j], sw_w_o[j], sw_b_o[j], cos, sin)
        x = layer_norm(DN_ALPHA * x + mix, ln1_g[i], ln1_b[i])
        x = layer_norm(DN_ALPHA * x + peer(x, pk_w_query[i], pk_sub_keys[i], pk_u[i], pk_v[i]), ln2_g[i], ln2_b[i])
    return x
```

```cpp
#include <hip/hip_runtime.h>
#include <hip/hip_cooperative_groups.h>
#include <cstdio>
#include <cstdint>
namespace cg = cooperative_groups;

#define DI __device__ __forceinline__
typedef unsigned short bf16_t;
typedef short bf16x8 __attribute__((ext_vector_type(8)));
typedef float f32x16 __attribute__((ext_vector_type(16)));
typedef float f32x4 __attribute__((ext_vector_type(4)));
typedef float f32x2 __attribute__((ext_vector_type(2)));
typedef unsigned u32x4 __attribute__((ext_vector_type(4)));
typedef unsigned u32x2 __attribute__((ext_vector_type(2)));
typedef __bf16 bf16x2_t __attribute__((ext_vector_type(2)));
#define MFMA(a, b, c) __builtin_amdgcn_mfma_f32_32x32x16_bf16((a), (b), (c), 0, 0, 0)

constexpr int T_TOK = 65536, DM = 1024, SEQ = 8192;
constexpr float DN_ALPHA = 1.41421356237309515f;
constexpr float LN_EPS = 1e-5f;
constexpr float LOG2E = 1.44269504088896341f;
constexpr float LAMBDA_INIT0 = 0.2f;

constexpr size_t MBy = 1u << 20;
constexpr size_t R0 = 0, R1 = 384 * MBy, R2 = 512 * MBy, R3 = 640 * MBy, R4 = 768 * MBy, R5 = 832 * MBy, R6 = 960 * MBy;
constexpr size_t W_DAQKV = R6, W_DAWO = R6 + 6 * MBy, W_SWQKV = R6 + 8 * MBy, W_SWWO = R6 + 11 * MBy, W_PKQ0 = R6 + 13 * MBy, W_PKQ1 = R6 + 15 * MBy,
                 W_SUBK = R6 + 17 * MBy, W_ROPE = R6 + 18 * MBy, W_SCALE = R6 + 20 * MBy, W_BAR = R6 + 21 * MBy, WS_END = R6 + 22 * MBy;
constexpr int LDS_PHASE_BYTES = 73728, LDS_BYTES = LDS_PHASE_BYTES + 16;
#ifndef REP_GEMM
#define REP_GEMM 1
#endif
#ifndef REP_ATT0
#define REP_ATT0 1
#endif
#ifndef REP_ATT1
#define REP_ATT1 1
#endif
#ifndef REP_TOPK
#define REP_TOPK 1
#endif
#ifndef REP_GATHER
#define REP_GATHER 1
#endif
#ifndef REP_P0
#define REP_P0 1
#endif
#ifndef REP_PU
#define REP_PU 1
#endif
#ifndef REP_PV
#define REP_PV 1
#endif

__constant__ float c_inv_freq[32] = {
    1.000000000e+00f, 7.498942018e-01f, 5.623413324e-01f, 4.216965139e-01f, 3.162277639e-01f, 2.371373922e-01f, 1.778279394e-01f, 1.333521456e-01f,
    1.000000015e-01f, 7.498941571e-02f, 5.623412877e-02f, 4.216964915e-02f, 3.162277862e-02f, 2.371373586e-02f, 1.778279431e-02f, 1.333521493e-02f,
    9.999999776e-03f, 7.498942316e-03f, 5.623413250e-03f, 4.216964822e-03f, 3.162277862e-03f, 2.371373819e-03f, 1.778279431e-03f, 1.333521446e-03f,
    1.000000047e-03f, 7.498941850e-04f, 5.623413017e-04f, 4.216965463e-04f, 3.162277862e-04f, 2.371373848e-04f, 1.778279402e-04f, 1.333521504e-04f};

struct Params {
    const float* x; const float* da_w_qkv; const float* da_lambda; const float* da_subln_g; const float* da_w_o;
    const float* sw_w_qkv; const float* sw_b_qkv; const float* sw_sinks; const float* sw_w_o; const float* sw_b_o;
    const float* pk_w_query; const float* pk_sub_keys; const float* pk_u; const float* pk_v;
    const float* ln1_g; const float* ln1_b; const float* ln2_g; const float* ln2_b;
    float* out; unsigned char* ws;
};

DI unsigned pk_bf16(float a, float b) { f32x2 f = {a, b}; return __builtin_bit_cast(unsigned, __builtin_convertvector(f, bf16x2_t)); }
DI bf16_t to_bf16(float a) { return (bf16_t)(pk_bf16(a, a) & 0xffffu); }
DI float bf_lo(unsigned u) { return __uint_as_float(u << 16); }
DI float bf_hi(unsigned u) { return __uint_as_float(u & 0xffff0000u); }
DI float wave_sum(float v) {
#pragma unroll
    for (int o = 32; o >= 1; o >>= 1) v += __shfl_xor(v, o);
    return v;
}

DI void convert_flat(const float* __restrict__ src, bf16_t* __restrict__ dst, size_t n) {
    const size_t nthreads = (size_t)gridDim.x * blockDim.x;
    for (size_t i_ = (size_t)blockIdx.x * blockDim.x + threadIdx.x; i_ < (n / 8) * REP_P0; i_ += nthreads) {
        const size_t i = (REP_P0 == 1) ? i_ : i_ % (n / 8);
        const f32x4 a = ((const f32x4*)src)[2 * i], b = ((const f32x4*)src)[2 * i + 1];
        u32x4 o; o.x = pk_bf16(a.x, a.y); o.y = pk_bf16(a.z, a.w); o.z = pk_bf16(b.x, b.y); o.w = pk_bf16(b.z, b.w);
        ((u32x4*)dst)[i] = o;
    }
}
DI void transpose_convert(const float* __restrict__ src, bf16_t* __restrict__ dst, int N, float* ldsf) {
    const int tilesN = N >> 6, ntiles = 16 * tilesN;
    const int tx = threadIdx.x & 63, ty = threadIdx.x >> 6;
    for (int tile = blockIdx.x; tile < ntiles; tile += gridDim.x) {
        const int tk = tile / tilesN, tn = tile - tk * tilesN;
        __syncthreads();
#pragma unroll
        for (int i = 0; i < 16; ++i) { const int k = ty + 4 * i; ldsf[k * 65 + tx] = src[(size_t)(tk * 64 + k) * N + tn * 64 + tx]; }
        __syncthreads();
#pragma unroll
        for (int i = 0; i < 16; ++i) { const int n = ty + 4 * i; dst[(size_t)(tn * 64 + n) * 1024 + tk * 64 + tx] = to_bf16(ldsf[tx * 65 + n]); }
    }
}
DI void rope_table(f32x2* rope) {
    const int nthreads = gridDim.x * blockDim.x;
    for (int i = blockIdx.x * blockDim.x + threadIdx.x; i < SEQ * 32; i += nthreads) {
        const int pos = i >> 5, j = i & 31;
        const float ang = (float)pos * c_inv_freq[j];
        const float kf = rintf(ang * 0.636619772367581343f);
        float rr = fmaf(-kf, 1.57079637050628662109375f, ang);
        rr = fmaf(-kf, -4.37113882867379294e-8f, rr);
        const float r2 = rr * rr;
        const float sn = rr + rr * r2 * (-1.6666654611e-1f + r2 * (8.3321608736e-3f + r2 * (-1.9515295891e-4f)));
        const float cs = 1.0f - 0.5f * r2 + r2 * r2 * (4.166664568298827e-2f + r2 * (-1.388731625493765e-3f + r2 * 2.443315711809948e-5f));
        const int q = ((int)kf) & 3;
        float c, s;
        if (q == 0) { c = cs; s = sn; } else if (q == 1) { c = -sn; s = cs; } else if (q == 2) { c = -cs; s = -sn; } else { c = sn; s = -cs; }
        f32x2 o = {c, s};
        rope[i] = o;
    }
}

template <class Epi>
DI void gemm_phase(const bf16_t* __restrict__ A, const bf16_t* __restrict__ Bt, int M, int N, int K, unsigned char* lds, const Epi& epi) {
    constexpr int STR = 144, TB = 128 * STR;
    const int tid = threadIdx.x, lane = tid & 63, w = tid >> 6, wm = w >> 1, wn = w & 1, r = lane & 31, h = lane >> 5;
    const int tilesN = N >> 7, ntiles = (M >> 7) * tilesN, nk = K >> 6;
    const int lrow = tid >> 3, lcol = tid & 7;
    const int G = gridDim.x, tilesM = M >> 7;
    const bool xcd_order = (G & 7) == 0;
    const int nlb = xcd_order ? (G >> 3) : 1, PW = (tilesN & 7) == 0 ? 8 : tilesN;
    const int npad = ((ntiles + G - 1) / G) * G;
    for (int tile_ = blockIdx.x; tile_ < npad * REP_GEMM; tile_ += G) {
        int tile = (REP_GEMM == 1) ? tile_ : tile_ % npad;
        if (xcd_order) {
            const int rd = tile / G, c = tile - rd * G;
            const int lin = ((rd << 3) + (c & 7)) * nlb + (c >> 3);
            tile = lin;
        }
        if (tile >= ntiles) continue;
        const int pnl = tile / (tilesM * PW), rem = tile - pnl * (tilesM * PW);
        const int tm = rem / PW, tn = pnl * PW + (rem - tm * PW);
        const bf16_t* Ag = A + (size_t)(tm * 128 + lrow) * K + lcol * 8;
        const bf16_t* Bg = Bt + (size_t)(tn * 128 + lrow) * K + lcol * 8;
        u32x4 ra0[4], rb0[4], ra1[4], rb1[4];
#define GEMM_LOAD(RA, RB, KT) { _Pragma("unroll") for (int i = 0; i < 4; ++i) { RA[i] = *(const u32x4*)(Ag + (size_t)(32 * i) * K + (KT) * 64); RB[i] = *(const u32x4*)(Bg + (size_t)(32 * i) * K + (KT) * 64); } }
#define GEMM_STORE(RA, RB, BUF) { _Pragma("unroll") for (int i = 0; i < 4; ++i) { *(u32x4*)(lds + (BUF) * TB + (lrow + 32 * i) * STR + lcol * 16) = RA[i]; *(u32x4*)(lds + 2 * TB + (BUF) * TB + (lrow + 32 * i) * STR + lcol * 16) = RB[i]; } }
#define GEMM_COMPUTE(BUF) { \
            const unsigned char* la = lds + (BUF) * TB + (wm * 64 + r) * STR + h * 16; \
            const unsigned char* lb = lds + 2 * TB + (BUF) * TB + (wn * 64 + r) * STR + h * 16; \
            _Pragma("unroll") for (int ks = 0; ks < 4; ++ks) { \
                bf16x8 af[2], bfr[2]; \
                _Pragma("unroll") for (int mi = 0; mi < 2; ++mi) af[mi] = *(const bf16x8*)(la + mi * 32 * STR + ks * 32); \
                _Pragma("unroll") for (int ni = 0; ni < 2; ++ni) bfr[ni] = *(const bf16x8*)(lb + ni * 32 * STR + ks * 32); \
                _Pragma("unroll") for (int mi = 0; mi < 2; ++mi) \
                    _Pragma("unroll") for (int ni = 0; ni < 2; ++ni) acc[mi][ni] = MFMA(bfr[ni], af[mi], acc[mi][ni]); \
            } }
        GEMM_LOAD(ra0, rb0, 0)
        if (nk > 1) GEMM_LOAD(ra1, rb1, 1)
        f32x16 acc[2][2];
#pragma unroll
        for (int mi = 0; mi < 2; ++mi)
#pragma unroll
            for (int ni = 0; ni < 2; ++ni)
#pragma unroll
                for (int i = 0; i < 16; ++i) acc[mi][ni][i] = 0.f;
        GEMM_STORE(ra0, rb0, 0)
        __syncthreads();
        for (int kt = 0; kt < nk; kt += 2) {
            if (kt + 2 < nk) GEMM_LOAD(ra0, rb0, kt + 2)
            GEMM_COMPUTE(0)
            if (kt + 1 < nk) GEMM_STORE(ra1, rb1, 1)
            __syncthreads();
            if (kt + 1 < nk) {
                if (kt + 3 < nk) GEMM_LOAD(ra1, rb1, kt + 3)
                GEMM_COMPUTE(1)
                if (kt + 2 < nk) GEMM_STORE(ra0, rb0, 0)
                __syncthreads();
            }
        }
#undef GEMM_LOAD
#undef GEMM_STORE
#undef GEMM_COMPUTE
        epi(acc, tm * 128 + wm * 64, tn * 128 + wn * 64, r, h);
    }
}

struct EpiQKV {
    bf16_t* q; bf16_t* k; bf16_t* vt; const f32x2* rope; const float* bias; int nq, nk, dv_shift, hv;
    DI void operator()(const f32x16 (&acc)[2][2], int m0, int n0, int r, int h) const {
        if (n0 < nq + nk) {
            const bool isq = n0 < nq;
            bf16_t* dst = isq ? q + n0 : k + (n0 - nq);
            const int ld = isq ? nq : nk;
            const float qs = isq ? 0.125f * LOG2E : 1.0f;
#pragma unroll
            for (int mi = 0; mi < 2; ++mi) {
                const int m = m0 + mi * 32 + r, pos = m & (SEQ - 1);
                const f32x4* rp = (const f32x4*)(rope + pos * 32);
#pragma unroll
                for (int g = 0; g < 4; ++g) {
                    const int j0 = 8 * g + 4 * h;
                    const f32x4 cs01 = rp[j0 >> 1], cs23 = rp[(j0 >> 1) + 1];
                    f32x4 b1 = {0.f, 0.f, 0.f, 0.f}, b2 = {0.f, 0.f, 0.f, 0.f};
                    if (bias) { b1 = *(const f32x4*)(bias + n0 + j0); b2 = *(const f32x4*)(bias + n0 + 32 + j0); }
                    const float c[4] = {cs01.x, cs01.z, cs23.x, cs23.z}, s[4] = {cs01.y, cs01.w, cs23.y, cs23.w};
                    float o1[4], o2[4];
#pragma unroll
                    for (int e = 0; e < 4; ++e) {
                        const float t1 = acc[mi][0][4 * g + e] + b1[e], t2 = acc[mi][1][4 * g + e] + b2[e];
                        o1[e] = (t1 * c[e] - t2 * s[e]) * qs; o2[e] = (t2 * c[e] + t1 * s[e]) * qs;
                    }
                    u32x2 w1 = {pk_bf16(o1[0], o1[1]), pk_bf16(o1[2], o1[3])}, w2 = {pk_bf16(o2[0], o2[1]), pk_bf16(o2[2], o2[3])};
                    *(u32x2*)(dst + (size_t)m * ld + j0) = w1;
                    *(u32x2*)(dst + (size_t)m * ld + 32 + j0) = w2;
                }
            }
        } else {
            const int nv = n0 - nq - nk;
#pragma unroll
            for (int mi = 0; mi < 2; ++mi) {
                const int m = m0 + mi * 32 + r, b = m >> 13, s = m & (SEQ - 1);
#pragma unroll
                for (int ni = 0; ni < 2; ++ni)
#pragma unroll
                    for (int i = 0; i < 16; ++i) {
                        const int eg = nv + ni * 32 + (i & 3) + 8 * (i >> 2) + 4 * h;
                        const float bv = bias ? bias[nq + nk + eg] : 0.f;
                        const int hh = eg >> dv_shift, e = eg & ((1 << dv_shift) - 1);
                        vt[((size_t)((b * hv + hh) << dv_shift) + e) * SEQ + s] = to_bf16(acc[mi][ni][i] + bv);
                    }
            }
        }
    }
};
template <bool RES_F32> struct EpiRes {
    const void* res; const float* bias; bf16_t* y;
    DI void operator()(const f32x16 (&acc)[2][2], int m0, int n0, int r, int h) const {
#pragma unroll
        for (int mi = 0; mi < 2; ++mi) {
            const int m = m0 + mi * 32 + r;
#pragma unroll
            for (int ni = 0; ni < 2; ++ni)
#pragma unroll
                for (int g = 0; g < 4; ++g) {
                    const int n = n0 + ni * 32 + 8 * g + 4 * h;
                    f32x4 xr;
                    if (RES_F32) xr = *(const f32x4*)((const float*)res + (size_t)m * DM + n);
                    else { const u32x2 u = *(const u32x2*)((const bf16_t*)res + (size_t)m * DM + n); xr.x = bf_lo(u.x); xr.y = bf_hi(u.x); xr.z = bf_lo(u.y); xr.w = bf_hi(u.y); }
                    f32x4 bv = {0.f, 0.f, 0.f, 0.f};
                    if (bias) bv = *(const f32x4*)(bias + n);
                    f32x4 o;
#pragma unroll
                    for (int e = 0; e < 4; ++e) o[e] = DN_ALPHA * xr[e] + acc[mi][ni][4 * g + e] + bv[e];
                    { u32x2 wv = {pk_bf16(o[0], o[1]), pk_bf16(o[2], o[3])}; *(u32x2*)(y + (size_t)m * DM + n) = wv; }
                }
        }
    }
};
struct EpiBf16 {
    bf16_t* o;
    DI void operator()(const f32x16 (&acc)[2][2], int m0, int n0, int r, int h) const {
#pragma unroll
        for (int mi = 0; mi < 2; ++mi) {
            const int m = m0 + mi * 32 + r;
#pragma unroll
            for (int ni = 0; ni < 2; ++ni)
#pragma unroll
                for (int g = 0; g < 4; ++g) {
                    const int n = n0 + ni * 32 + 8 * g + 4 * h;
                    u32x2 wv = {pk_bf16(acc[mi][ni][4 * g], acc[mi][ni][4 * g + 1]), pk_bf16(acc[mi][ni][4 * g + 2], acc[mi][ni][4 * g + 3])};
                    *(u32x2*)(o + (size_t)m * DM + n) = wv;
                }
        }
    }
};

DI void ln_phase(const bf16_t* __restrict__ y, const float* __restrict__ g, const float* __restrict__ b, bf16_t* __restrict__ xo, float* __restrict__ xf = nullptr) {
    const int lane = threadIdx.x & 63, w = threadIdx.x >> 6;
    const int gw = blockIdx.x * 4 + w, nw = gridDim.x * 4;
    f32x4 gv[4], bv[4];
#pragma unroll
    for (int i = 0; i < 4; ++i) { gv[i] = ((const f32x4*)g)[lane + 64 * i]; bv[i] = ((const f32x4*)b)[lane + 64 * i]; }
    for (int row = gw; row < T_TOK; row += nw) {
        const u32x2* yr = (const u32x2*)(y + (size_t)row * DM);
        f32x4 v[4];
#pragma unroll
        for (int i = 0; i < 4; ++i) { const u32x2 u = yr[lane + 64 * i]; v[i].x = bf_lo(u.x); v[i].y = bf_hi(u.x); v[i].z = bf_lo(u.y); v[i].w = bf_hi(u.y); }
        float s = 0.f;
#pragma unroll
        for (int i = 0; i < 4; ++i) s += (v[i].x + v[i].y) + (v[i].z + v[i].w);
        const float mu = wave_sum(s) * (1.0f / DM);
        float q = 0.f;
#pragma unroll
        for (int i = 0; i < 4; ++i) { const f32x4 d = v[i] - mu; q += (d.x * d.x + d.y * d.y) + (d.z * d.z + d.w * d.w); }
        const float rstd = rsqrtf(wave_sum(q) * (1.0f / DM) + LN_EPS);
#pragma unroll
        for (int i = 0; i < 4; ++i) {
            const f32x4 o = (v[i] - mu) * rstd * gv[i] + bv[i];
            if (xf) *(f32x4*)(xf + (size_t)row * DM + 4 * (lane + 64 * i)) = o;
            if (xo) { u32x2 wv = {pk_bf16(o.x, o.y), pk_bf16(o.z, o.w)}; *(u32x2*)(xo + (size_t)row * DM + 4 * (lane + 64 * i)) = wv; }
        }
    }
}

struct AttnArgs {
    const bf16_t* q; const bf16_t* k; const bf16_t* vt; bf16_t* o;
    const float* lam_params; const float* subln_g; const float* sinks; float* scr;
};
DI int pi_perm(int r) { return (r & 0x13) | ((r & 4) << 1) | ((r & 8) >> 1); }

template <int MODE>
DI void attn_phase(const AttnArgs& a, unsigned char* lds) {
    constexpr int DV = MODE == 0 ? 128 : 64, EB = DV / 32;
    constexpr int KSTR = 144, VSTR = 144, KBUF = 64 * KSTR, VBUF = DV * VSTR;
    constexpr int KCH = 2, VCH = DV / 32;
    constexpr int LDK = MODE == 0 ? 1024 : 128, HV = MODE == 0 ? 8 : 2;
    constexpr int NITEMS = 8192;
    const int tid = threadIdx.x, lane = tid & 63, w = tid >> 6, r = lane & 31, h = lane >> 5;
    unsigned char* kl = lds;
    unsigned char* vl = lds + 3 * KBUF;
    const float NEG_INF = -__builtin_inff();
    const int G = gridDim.x;
    const int krow = tid >> 3, kcc = tid & 7;

    constexpr int REPA = MODE == 0 ? REP_ATT0 : REP_ATT1;
    for (int it_ = blockIdx.x; it_ < NITEMS * REPA; it_ += G) {
        const int it = (REPA == 1) ? it_ : it_ % NITEMS;
        int b, qb, qcol0, kcol0, vh, p = 0;
        if (MODE == 0) {
            int bh;
            const int s = it / G, c = it - s * G;
            if (G == 512) { const int jj = c >> 3; bh = (c & 7) + 8 * (s >> 1); p = jj & 1; qb = (s & 1) ? (jj >> 1) : 63 - (jj >> 1); }
            else if (G == 256) { const int jj = c >> 3; bh = (c & 7) + 8 * (s >> 2); p = s & 1; qb = (s & 2) ? jj : 63 - jj; }
            else { bh = it >> 7; p = it & 1; qb = 63 - ((it >> 1) & 63); }
            b = bh >> 3; const int hh = bh & 7; qcol0 = hh * 128; kcol0 = hh * 128; vh = hh;
        } else {
            const int head = it & 15; qb = (it >> 4) & 63; b = it >> 10;
            qcol0 = head * 64; vh = head >> 3; kcol0 = vh * 64;
        }
        const int q0 = qb * 128, qw0 = q0 + 32 * w, qpos = qw0 + r;
        const int kt0 = MODE == 0 ? 0 : ((q0 >= 128 ? q0 - 128 : 0) >> 6), kt1 = (q0 + 128) >> 6;
        const bf16_t* vg = a.vt + (size_t)(b * HV + vh) * DV * SEQ + (size_t)krow * SEQ + kcc * 8;
        const size_t tok = (size_t)b * SEQ + qpos;

        {
            const bf16_t* kg = a.k + (size_t)b * SEQ * LDK + kcol0 + p * 64 + (size_t)krow * LDK + kcc * 8;
            bf16x8 qf[4];
            {
                const bf16_t* qp = a.q + tok * 1024 + qcol0 + p * 64 + h * 8;
#pragma unroll
                for (int ks = 0; ks < 4; ++ks) qf[ks] = *(const bf16x8*)(qp + ks * 16);
            }
            f32x16 O[EB];
#pragma unroll
            for (int eb = 0; eb < EB; ++eb)
#pragma unroll
                for (int i = 0; i < 16; ++i) O[eb][i] = 0.f;
            float mrow = NEG_INF, lsum = 0.f;
            if (MODE == 1) { mrow = a.sinks[it & 15] * LOG2E; lsum = (h == 0) ? 1.0f : 0.0f; }

            u32x4 rk[KCH], rv[VCH];
#define ATT_LOADK(KT) { _Pragma("unroll") for (int i = 0; i < KCH; ++i) rk[i] = *(const u32x4*)(kg + (size_t)((KT) * 64 + 32 * i) * LDK); }
#define ATT_LOADV(KT) { _Pragma("unroll") for (int i = 0; i < VCH; ++i) rv[i] = *(const u32x4*)(vg + (size_t)(32 * i) * SEQ + (KT) * 64); }
#define ATT_STOREK(KT) { unsigned char* kd_ = kl + (((KT) - kt0) % 3) * KBUF; _Pragma("unroll") for (int i = 0; i < KCH; ++i) *(u32x4*)(kd_ + (krow + 32 * i) * KSTR + kcc * 16) = rk[i]; }
#define ATT_STOREV(KT) { unsigned char* vd_ = vl + (((KT) - kt0) & 1) * VBUF; _Pragma("unroll") for (int i = 0; i < VCH; ++i) *(u32x4*)(vd_ + (krow + 32 * i) * VSTR + kcc * 16) = rv[i]; }
            auto s_compute = [&](f32x16 (&sx)[2], const int kt) __attribute__((always_inline)) {
                const unsigned char* kb_ = kl + ((kt - kt0) % 3) * KBUF;
#pragma unroll
                for (int kb = 0; kb < 2; ++kb) {
#pragma unroll
                    for (int i = 0; i < 16; ++i) sx[kb][i] = 0.f;
#pragma unroll
                    for (int ks = 0; ks < 4; ++ks) {
                        const bf16x8 kf = *(const bf16x8*)(kb_ + (kb * 32 + pi_perm(r)) * KSTR + ks * 32 + h * 16);
                        sx[kb] = MFMA(kf, qf[ks], sx[kb]);
                    }
                }
            };
            auto step = [&](f32x16 (&s)[2], f32x16 (&sn)[2], const int kt) __attribute__((always_inline)) {
                const bool more1 = kt + 1 < kt1, more2 = kt + 2 < kt1;
                if (more2) ATT_LOADK(kt + 2)
                if (more1) ATT_LOADV(kt + 1)
                const int key0 = kt * 64;
                bool need_mask = key0 + 63 > qw0;
                if (MODE == 1) need_mask = need_mask || (key0 < qw0 + 31 - 127);
                if (need_mask) {
                    asm volatile("" ::: "memory");
#pragma unroll
                    for (int kb = 0; kb < 2; ++kb)
#pragma unroll
                        for (int i = 0; i < 16; ++i) {
                            const int key = key0 + kb * 32 + 16 * (i >> 3) + 8 * h + (i & 7);
                            bool valid = key <= qpos;
                            if (MODE == 1) valid = valid && (key > qpos - 128);
                            s[kb][i] = valid ? s[kb][i] : NEG_INF;
                        }
                }
                float mx = NEG_INF;
#pragma unroll
                for (int kb = 0; kb < 2; ++kb)
#pragma unroll
                    for (int i = 0; i < 16; ++i) mx = fmaxf(mx, s[kb][i]);
                mx = fmaxf(mx, __shfl_xor(mx, 32));
                if (__builtin_amdgcn_ballot_w64(mx > mrow + 8.0f) != 0ull) {
                    asm volatile("" ::: "memory");
                    const float mnew = fmaxf(mrow, mx);
                    const float alpha = __builtin_amdgcn_exp2f(mrow - mnew);
                    mrow = mnew;
                    lsum *= alpha;
#pragma unroll
                    for (int eb = 0; eb < EB; ++eb)
#pragma unroll
                        for (int i = 0; i < 16; ++i) O[eb][i] *= alpha;
                }
                s_compute(sn, kt + 1);
                f32x2 ps2 = {0.f, 0.f};
#pragma unroll
                for (int kb = 0; kb < 2; ++kb)
#pragma unroll
                    for (int i = 0; i < 16; i += 2) {
                        f32x2 pv = {__builtin_amdgcn_exp2f(s[kb][i] - mrow), __builtin_amdgcn_exp2f(s[kb][i + 1] - mrow)};
                        s[kb][i] = pv.x; s[kb][i + 1] = pv.y; ps2 += pv;
                    }
                lsum += ps2.x + ps2.y;
                bf16x8 pf[2][2];
#pragma unroll
                for (int kb = 0; kb < 2; ++kb)
#pragma unroll
                    for (int s2 = 0; s2 < 2; ++s2) {
                        u32x4 u;
                        u.x = pk_bf16(s[kb][8 * s2 + 0], s[kb][8 * s2 + 1]); u.y = pk_bf16(s[kb][8 * s2 + 2], s[kb][8 * s2 + 3]);
                        u.z = pk_bf16(s[kb][8 * s2 + 4], s[kb][8 * s2 + 5]); u.w = pk_bf16(s[kb][8 * s2 + 6], s[kb][8 * s2 + 7]);
                        pf[kb][s2] = __builtin_bit_cast(bf16x8, u);
                    }
                const unsigned char* vb_ = vl + ((kt - kt0) & 1) * VBUF;
#pragma unroll
                for (int eb = 0; eb < EB; ++eb) {
#pragma unroll
                    for (int kb = 0; kb < 2; ++kb)
#pragma unroll
                        for (int s2 = 0; s2 < 2; ++s2) {
                            const bf16x8 vf = *(const bf16x8*)(vb_ + (eb * 32 + r) * VSTR + (kb * 32 + 16 * s2 + 8 * h) * 2);
                            O[eb] = MFMA(vf, pf[kb][s2], O[eb]);
                        }
                }
                if (more2) ATT_STOREK(kt + 2)
                if (more1) ATT_STOREV(kt + 1)
                __syncthreads();
            };
            ATT_LOADK(kt0) ATT_LOADV(kt0)
            ATT_STOREK(kt0) ATT_STOREV(kt0)
            if (kt0 + 1 < kt1) { ATT_LOADK(kt0 + 1) ATT_STOREK(kt0 + 1) }
            __syncthreads();
            f32x16 sA[2], sB[2];
            s_compute(sA, kt0);
            for (int kt = kt0; kt < kt1; kt += 2) {
                step(sA, sB, kt);
                if (kt + 1 < kt1) step(sB, sA, kt + 1);
            }
#undef ATT_LOADK
#undef ATT_LOADV
#undef ATT_STOREK
#undef ATT_STOREV
            const float inv0 = 1.0f / (lsum + __shfl_xor(lsum, 32));
            bf16_t* op = (MODE == 0) ? a.o + tok * 2048 + qcol0 * 2 + p * 128 : a.o + tok * 1024 + qcol0;
#pragma unroll
            for (int eb = 0; eb < EB; ++eb)
#pragma unroll
                for (int g = 0; g < 4; ++g) {
                    const int e = eb * 32 + 8 * g + 4 * h;
                    u32x2 wv = {pk_bf16(O[eb][4 * g] * inv0, O[eb][4 * g + 1] * inv0), pk_bf16(O[eb][4 * g + 2] * inv0, O[eb][4 * g + 3] * inv0)};
                    *(u32x2*)(op + e) = wv;
                }
        }
    }
}

DI void diff_combine_phase(const bf16_t* __restrict__ op, const float* __restrict__ lam_params, const float* __restrict__ subln_g, bf16_t* __restrict__ o) {
    const int lane = threadIdx.x & 63, w = threadIdx.x >> 6;
    const int gwave = blockIdx.x * 4 + w, nwave = gridDim.x * 4;
    const float p1 = wave_sum(lam_params[lane] * lam_params[64 + lane]);
    const float p2 = wave_sum(lam_params[128 + lane] * lam_params[192 + lane]);
    const float lam = __expf(p1) - __expf(p2) + LAMBDA_INIT0;
    const int hd = lane >> 3, d0 = 16 * (lane & 7);
    f32x4 gg[4];
#pragma unroll
    for (int i = 0; i < 4; ++i) gg[i] = *(const f32x4*)(subln_g + d0 + 4 * i);
    for (int t = gwave; t < T_TOK; t += nwave) {
        const bf16_t* p0 = op + (size_t)t * 2048 + hd * 256 + d0;
        const u32x4 a0 = *(const u32x4*)p0, a1 = *(const u32x4*)(p0 + 8), b0 = *(const u32x4*)(p0 + 128), b1 = *(const u32x4*)(p0 + 136);
        float v[16];
#pragma unroll
        for (int i = 0; i < 4; ++i) {
            v[2 * i] = bf_lo(a0[i]) - lam * bf_lo(b0[i]); v[2 * i + 1] = bf_hi(a0[i]) - lam * bf_hi(b0[i]);
            v[8 + 2 * i] = bf_lo(a1[i]) - lam * bf_lo(b1[i]); v[8 + 2 * i + 1] = bf_hi(a1[i]) - lam * bf_hi(b1[i]);
        }
        float ss = 0.f;
#pragma unroll
        for (int i = 0; i < 16; ++i) ss += v[i] * v[i];
        ss += __shfl_xor(ss, 1); ss += __shfl_xor(ss, 2); ss += __shfl_xor(ss, 4);
        const float rs = rsqrtf(ss * (1.0f / 128.0f) + LN_EPS) * (1.0f - LAMBDA_INIT0);
        u32x4 w0, w1;
#pragma unroll
        for (int i = 0; i < 4; ++i) {
            const int e = (i & 1) * 2;
            w0[i] = pk_bf16(v[2 * i] * rs * gg[i >> 1][e], v[2 * i + 1] * rs * gg[i >> 1][e + 1]);
            w1[i] = pk_bf16(v[8 + 2 * i] * rs * gg[2 + (i >> 1)][e], v[8 + 2 * i + 1] * rs * gg[2 + (i >> 1)][e + 1]);
        }
        bf16_t* dst = o + (size_t)t * 1024 + hd * 128 + d0;
        *(u32x4*)dst = w0; *(u32x4*)(dst + 8) = w1;
    }
}

DI unsigned f2ord(float f) { const unsigned u = __float_as_uint(f); return (u & 0x80000000u) ? ~u : (u | 0x80000000u); }
DI float ord2f(unsigned o) { const unsigned u = (o & 0x80000000u) ? (o & 0x7fffffffu) : ~o; return __uint_as_float(u); }
__host__ __device__ constexpr int combo_row_start(int a) { int s = 0; for (int i = 0; i < a; ++i) s += 16 / (i + 1); return s; }

constexpr int SORT16[63][2] = {{0,1}, {2,3}, {0,2}, {1,3}, {1,2}, {4,5}, {6,7}, {4,6}, {5,7}, {5,6}, {0,4}, {2,6}, {2,4}, {1,5}, {3,7}, {3,5}, {1,2}, {3,4}, {5,6}, {8,9}, {10,11}, {8,10}, {9,11}, {9,10}, {12,13}, {14,15}, {12,14}, {13,15}, {13,14}, {8,12}, {10,14}, {10,12}, {9,13}, {11,15}, {11,13}, {9,10}, {11,12}, {13,14}, {0,8}, {4,12}, {4,8}, {2,10}, {6,14}, {6,10}, {2,4}, {6,8}, {10,12}, {1,9}, {5,13}, {5,9}, {3,11}, {7,15}, {7,11}, {3,5}, {7,9}, {11,13}, {1,2}, {3,4}, {5,6}, {7,8}, {9,10}, {11,12}, {13,14}};
constexpr int BMERGE16[32][2] = {{0,8}, {1,9}, {2,10}, {3,11}, {4,12}, {5,13}, {6,14}, {7,15}, {0,4}, {1,5}, {2,6}, {3,7}, {8,12}, {9,13}, {10,14}, {11,15}, {0,2}, {1,3}, {4,6}, {5,7}, {8,10}, {9,11}, {12,14}, {13,15}, {0,1}, {2,3}, {4,5}, {6,7}, {8,9}, {10,11}, {12,13}, {14,15}};
DI void cex(unsigned& a, unsigned& b) { const unsigned hi = max(a, b), lo = min(a, b); a = hi; b = lo; }
DI void merge_top16(unsigned (&A)[16], const unsigned (&B)[16]) {
#pragma unroll
    for (int i = 0; i < 16; ++i) A[i] = max(A[i], B[15 - i]);
#pragma unroll
    for (int n = 0; n < 32; ++n) cex(A[BMERGE16[n][0]], A[BMERGE16[n][1]]);
}
DI void peer_topk_phase(const bf16_t* __restrict__ qpk, const bf16_t* __restrict__ subk, int* __restrict__ eidx, float* __restrict__ gout) {
    int tidv = threadIdx.x;
    asm volatile("" : "+v"(tidv));
    const int lane = tidv & 63, w = tidv >> 6, r = lane & 31, h = lane >> 5;
    const int gwave = blockIdx.x * 4 + w, nwave = gridDim.x * 4;
    for (int item_ = gwave; item_ < 2048 * 8 * REP_TOPK; item_ += nwave) {
        const int item = (REP_TOPK == 1) ? item_ : item_ % (2048 * 8);
        const int tt = item >> 3, hh = item & 7, t0 = tt * 32;
        unsigned top[2][16];
#pragma unroll
        for (int c = 0; c < 2; ++c) {
            f32x16 acc[4];
#pragma unroll
            for (int nb = 0; nb < 4; ++nb)
#pragma unroll
                for (int i = 0; i < 16; ++i) acc[nb][i] = 0.f;
            const bf16_t* qp = qpk + (size_t)(t0 + r) * 1024 + hh * 128 + c * 64 + h * 8;
            const bf16_t* kp = subk + ((size_t)(hh * 2 + c) * 128 + r) * 64 + h * 8;
#pragma unroll
            for (int ks = 0; ks < 4; ++ks) {
                const bf16x8 qfr = *(const bf16x8*)(qp + ks * 16);
#pragma unroll
                for (int nb = 0; nb < 4; ++nb) {
                    const bf16x8 kf = *(const bf16x8*)(kp + nb * 32 * 64 + ks * 16);
                    acc[nb] = MFMA(kf, qfr, acc[nb]);
                }
            }
            unsigned key[64];
#pragma unroll
            for (int nb = 0; nb < 4; ++nb)
#pragma unroll
                for (int i = 0; i < 16; ++i) {
                    const int n = nb * 32 + (i & 3) + 8 * (i >> 2) + 4 * h;
                    key[nb * 16 + i] = (f2ord(acc[nb][i]) & ~127u) | (unsigned)(127 - n);
                }
            unsigned g0[16], g1[16], g2[16], g3[16];
#pragma unroll
            for (int i = 0; i < 16; ++i) { g0[i] = key[i]; g1[i] = key[16 + i]; g2[i] = key[32 + i]; g3[i] = key[48 + i]; }
#pragma unroll
            for (int n = 0; n < 63; ++n) { cex(g0[SORT16[n][0]], g0[SORT16[n][1]]); cex(g1[SORT16[n][0]], g1[SORT16[n][1]]); cex(g2[SORT16[n][0]], g2[SORT16[n][1]]); cex(g3[SORT16[n][0]], g3[SORT16[n][1]]); }
            merge_top16(g0, g1); merge_top16(g2, g3); merge_top16(g0, g2);
            unsigned pb[16];
#pragma unroll
            for (int i = 0; i < 16; ++i) pb[i] = (unsigned)__shfl_xor((int)g0[i], 32);
            merge_top16(g0, pb);
#pragma unroll
            for (int i = 0; i < 16; ++i) top[c][i] = g0[i];
        }
        unsigned ck[50];
#pragma unroll
        for (int a = 0; a < 16; ++a)
#pragma unroll
            for (int b = 0; b < 16 / (a + 1); ++b) {
                const float cv = ord2f(top[0][a] & ~127u) + ord2f(top[1][b] & ~127u);
                ck[combo_row_start(a) + b] = (f2ord(cv) & ~255u) | (unsigned)(((15 - a) << 4) | (15 - b));
            }
        unsigned c0[16], c1[16], c2[16], c3[16];
#pragma unroll
        for (int i = 0; i < 16; ++i) { c0[i] = ck[i]; c1[i] = ck[16 + i]; c2[i] = ck[32 + i]; c3[i] = (i < 2) ? ck[48 + i] : 0u; }
#pragma unroll
        for (int n = 0; n < 63; ++n) { cex(c1[SORT16[n][0]], c1[SORT16[n][1]]); cex(c2[SORT16[n][0]], c2[SORT16[n][1]]); }
        merge_top16(c0, c1); merge_top16(c2, c3); merge_top16(c0, c2);
        float sv[16]; int se[16];
#pragma unroll
        for (int rd = 0; rd < 16; ++rd) {
            const unsigned m = c0[rd];
            const int asel = 15 - (int)((m >> 4) & 15u), bsel = 15 - (int)(m & 15u);
            unsigned ka = top[0][0], kb = top[1][0];
#pragma unroll
            for (int i = 1; i < 16; ++i) { ka = (asel == i) ? top[0][i] : ka; kb = (bsel == i) ? top[1][i] : kb; }
            sv[rd] = ord2f(ka & ~127u) + ord2f(kb & ~127u);
            se[rd] = (127 - (int)(ka & 127u)) * 128 + (127 - (int)(kb & 127u));
        }
        float den = 0.f;
        const float mx0 = sv[0];
#pragma unroll
        for (int i = 0; i < 16; ++i) { sv[i] = __expf(sv[i] - mx0); den += sv[i]; }
        const float inv = 1.0f / den;
        const size_t ob = (size_t)(t0 + r) * 128 + hh * 16;
        if (h == 0) {
#pragma unroll
            for (int i = 0; i < 4; ++i) { int4 v = make_int4(se[4 * i], se[4 * i + 1], se[4 * i + 2], se[4 * i + 3]); *(int4*)(eidx + ob + 4 * i) = v; }
        } else {
#pragma unroll
            for (int i = 0; i < 4; ++i) { f32x4 v = {sv[4 * i] * inv, sv[4 * i + 1] * inv, sv[4 * i + 2] * inv, sv[4 * i + 3] * inv}; *(f32x4*)(gout + ob + 4 * i) = v; }
        }
    }
}

DI float gelu_exact(float v) { return 0.5f * v * (1.0f + erff(v * 0.70710678118654752f)); }
DI void convert_rows_fp8(const float* __restrict__ src, unsigned char* __restrict__ dst, float* __restrict__ inv, int nrows) {
    const int lane = threadIdx.x & 63, w = threadIdx.x >> 6;
    const int gwave = blockIdx.x * 4 + w, nwave = gridDim.x * 4;
    for (int row_ = gwave; row_ < nrows * REP_P0; row_ += nwave) {
        const int row = (REP_P0 == 1) ? row_ : row_ % nrows;
        const f32x4* p = (const f32x4*)(src + (size_t)row * DM + 16 * lane);
        f32x4 v[4];
#pragma unroll
        for (int i = 0; i < 4; ++i) v[i] = p[i];
        float am = 0.f;
#pragma unroll
        for (int i = 0; i < 4; ++i) am = fmaxf(am, fmaxf(fmaxf(fabsf(v[i].x), fabsf(v[i].y)), fmaxf(fabsf(v[i].z), fabsf(v[i].w))));
#pragma unroll
        for (int o = 32; o >= 1; o >>= 1) am = fmaxf(am, __shfl_xor(am, o));
        const unsigned eb = (__float_as_uint(am) >> 23) & 0xffu;
        float sc = 1.0f, isc = 1.0f;
        if (eb >= 16u && eb <= 250u) { sc = __uint_as_float((261u - eb) << 23); isc = __uint_as_float((eb - 7u) << 23); }
        u32x4 o;
#pragma unroll
        for (int i = 0; i < 4; ++i) {
            int pk = __builtin_amdgcn_cvt_pk_fp8_f32(v[i].x * sc, v[i].y * sc, 0, false);
            pk = __builtin_amdgcn_cvt_pk_fp8_f32(v[i].z * sc, v[i].w * sc, pk, true);
            o[i] = (unsigned)pk;
        }
        *(u32x4*)(dst + (size_t)row * DM + 16 * lane) = o;
        if (lane == 0) inv[row] = isc;
    }
}
DI float dot16(const unsigned (&a)[8], u32x4 b0, u32x4 b1) {
    float acc;
    asm volatile("v_dot2_f32_bf16 %0, %1, %9, 0\n\tv_dot2_f32_bf16 %0, %2, %10, %0\n\tv_dot2_f32_bf16 %0, %3, %11, %0\n\tv_dot2_f32_bf16 %0, %4, %12, %0\n\t"
                 "v_dot2_f32_bf16 %0, %5, %13, %0\n\tv_dot2_f32_bf16 %0, %6, %14, %0\n\tv_dot2_f32_bf16 %0, %7, %15, %0\n\tv_dot2_f32_bf16 %0, %8, %16, %0\n\ts_nop 2"
                 : "=&v"(acc)
                 : "v"(a[0]), "v"(a[1]), "v"(a[2]), "v"(a[3]), "v"(a[4]), "v"(a[5]), "v"(a[6]), "v"(a[7]),
                   "v"(b0.x), "v"(b0.y), "v"(b0.z), "v"(b0.w), "v"(b1.x), "v"(b1.y), "v"(b1.z), "v"(b1.w));
    return acc;
}
DI float dot_fp8_row(u32x4 u, u32x4 xa, u32x4 xb) {
    unsigned a[8];
#pragma unroll
    for (int j = 0; j < 4; ++j) {
        a[2 * j] = __builtin_bit_cast(unsigned, __builtin_amdgcn_cvt_scalef32_pk_bf16_fp8(u[j], 1.0f, false));
        a[2 * j + 1] = __builtin_bit_cast(unsigned, __builtin_amdgcn_cvt_scalef32_pk_bf16_fp8(u[j], 1.0f, true));
    }
    return dot16(a, xa, xb);
}
DI void axpy_fp8_row(f32x2 (&o)[8], float wgt, u32x4 v) {
    const f32x2 w2 = {wgt, wgt};
#pragma unroll
    for (int j = 0; j < 4; ++j) {
        const f32x2 lo = __builtin_amdgcn_cvt_pk_f32_fp8(v[j], false), hi = __builtin_amdgcn_cvt_pk_f32_fp8(v[j], true);
        o[2 * j] = __builtin_elementwise_fma(w2, lo, o[2 * j]);
        o[2 * j + 1] = __builtin_elementwise_fma(w2, hi, o[2 * j + 1]);
    }
}
struct TokMeta { int e0, e1; float su0, su1, gv0, gv1; u32x4 xa, xb; };
DI TokMeta load_meta(int t, int lane, const bf16_t* __restrict__ x1, const int* __restrict__ eidx, const float* __restrict__ gws, const float* __restrict__ su, const float* __restrict__ sv) {
    TokMeta m;
    m.e0 = eidx[(size_t)t * 128 + lane]; m.e1 = eidx[(size_t)t * 128 + 64 + lane];
    const float g0 = gws[(size_t)t * 128 + lane], g1 = gws[(size_t)t * 128 + 64 + lane];
    m.su0 = su[m.e0]; m.su1 = su[m.e1];
    m.gv0 = g0 * sv[m.e0]; m.gv1 = g1 * sv[m.e1];
    m.xa = *(const u32x4*)(x1 + (size_t)t * DM + 16 * lane); m.xb = *(const u32x4*)(x1 + (size_t)t * DM + 16 * lane + 8);
    return m;
}
DI void gather_issue(u32x4 (&bu)[8], u32x4 (&bv)[8], int ev, int lbase, int lane, const unsigned char* __restrict__ U8, const unsigned char* __restrict__ V8) {
#pragma unroll
    for (int i = 0; i < 8; ++i) {
        const int e = __builtin_amdgcn_readlane(ev, lbase + i);
        bu[i] = *(const u32x4*)(U8 + (size_t)e * DM + 16 * lane);
        bv[i] = *(const u32x4*)(V8 + (size_t)e * DM + 16 * lane);
    }
}
DI void gather_compute(const u32x4 (&bu)[8], const u32x4 (&bv)[8], float suv, float gvv, int lbase, int lane_in, u32x4 xa, u32x4 xb, f32x2 (&out)[8]) {
    int lane = lane_in;
    float d[8];
#pragma unroll
    for (int i = 0; i < 8; ++i) { d[i] = dot_fp8_row(bu[i], xa, xb) * __builtin_bit_cast(float, __builtin_amdgcn_readlane(__builtin_bit_cast(int, suv), lbase + i)); __builtin_amdgcn_sched_barrier(0); }
    float d4[4], d2[2], d1;
    asm volatile("" : "+v"(lane));
    {
        const bool hi = (lane & 32) != 0;
#pragma unroll
        for (int i = 0; i < 4; ++i) { const float keep = hi ? d[i + 4] : d[i], send = hi ? d[i] : d[i + 4]; d4[i] = keep + __shfl_xor(send, 32); }
    }
    {
        const bool hi = (lane & 16) != 0;
#pragma unroll
        for (int i = 0; i < 2; ++i) { const float keep = hi ? d4[i + 2] : d4[i], send = hi ? d4[i] : d4[i + 2]; d2[i] = keep + __shfl_xor(send, 16); }
    }
    {
        const bool hi = (lane & 8) != 0;
        const float keep = hi ? d2[1] : d2[0], send = hi ? d2[0] : d2[1];
        d1 = keep + __shfl_xor(send, 8);
    }
    d1 += __shfl_xor(d1, 4); d1 += __shfl_xor(d1, 2); d1 += __shfl_xor(d1, 1);
    const float hv = gelu_exact(d1);
#pragma unroll
    for (int i = 0; i < 8; ++i) {
        const int src = 8 * (i & 1) + 16 * ((i >> 1) & 1) + 32 * ((i >> 2) & 1);
        const float wi = __builtin_bit_cast(float, __builtin_amdgcn_readlane(__builtin_bit_cast(int, gvv), lbase + i)) *
                         __builtin_bit_cast(float, __builtin_amdgcn_readlane(__builtin_bit_cast(int, hv), src));
        axpy_fp8_row(out, wi, bv[i]);
        __builtin_amdgcn_sched_barrier(0);
    }
}
DI void peer_gather_phase(const bf16_t* __restrict__ x1, const int* __restrict__ eidx, const float* __restrict__ gws, const unsigned char* __restrict__ U8,
                          const unsigned char* __restrict__ V8, const float* __restrict__ su, const float* __restrict__ sv, const float* __restrict__ lng,
                          const float* __restrict__ lnb, bf16_t* __restrict__ xo_bf, float* __restrict__ xo_f32) {
    const int lane = threadIdx.x & 63, w = threadIdx.x >> 6;
    const int gwave = blockIdx.x * 4 + w, nwave = gridDim.x * 4;
    if (gwave < T_TOK) {
        TokMeta cur = load_meta(gwave, lane, x1, eidx, gws, su, sv);
        u32x4 au[8], av[8], bu[8], bv[8];
        gather_issue(au, av, cur.e0, 0, lane, U8, V8);
        for (int t_ = gwave; t_ < T_TOK * REP_GATHER; t_ += nwave) {
            const int t = (REP_GATHER == 1) ? t_ : t_ % T_TOK;
            const bool has_next = t_ + nwave < T_TOK * REP_GATHER;
            TokMeta nxt = cur;
            if (has_next) nxt = load_meta((REP_GATHER == 1) ? t_ + nwave : (t_ + nwave) % T_TOK, lane, x1, eidx, gws, su, sv);
            f32x2 out[8];
#pragma unroll
            for (int i = 0; i < 8; ++i) { out[i].x = 0.f; out[i].y = 0.f; }
            for (int jb = 0; jb < 16; jb += 2) {
                const int ev = (jb < 8) ? cur.e0 : cur.e1;
                const float suv = (jb < 8) ? cur.su0 : cur.su1, gvv = (jb < 8) ? cur.gv0 : cur.gv1;
                const int lbase = (jb & 7) * 8;
                gather_issue(bu, bv, ev, lbase + 8, lane, U8, V8);
                gather_compute(au, av, suv, gvv, lbase, lane, cur.xa, cur.xb, out);
                if (jb + 2 < 16) {
                    const int ev2 = (jb + 2 < 8) ? cur.e0 : cur.e1;
                    gather_issue(au, av, ev2, ((jb + 2) & 7) * 8, lane, U8, V8);
                } else if (has_next) {
                    gather_issue(au, av, nxt.e0, 0, lane, U8, V8);
                }
                gather_compute(bu, bv, suv, gvv, lbase + 8, lane, cur.xa, cur.xb, out);
            }
            float y[16];
            {
                const u32x4 xa = cur.xa, xb = cur.xb;
                y[0] = bf_lo(xa.x); y[1] = bf_hi(xa.x); y[2] = bf_lo(xa.y); y[3] = bf_hi(xa.y); y[4] = bf_lo(xa.z); y[5] = bf_hi(xa.z); y[6] = bf_lo(xa.w); y[7] = bf_hi(xa.w);
                y[8] = bf_lo(xb.x); y[9] = bf_hi(xb.x); y[10] = bf_lo(xb.y); y[11] = bf_hi(xb.y); y[12] = bf_lo(xb.z); y[13] = bf_hi(xb.z); y[14] = bf_lo(xb.w); y[15] = bf_hi(xb.w);
            }
            float s = 0.f;
#pragma unroll
            for (int i = 0; i < 8; ++i) { y[2 * i] = DN_ALPHA * y[2 * i] + out[i].x; y[2 * i + 1] = DN_ALPHA * y[2 * i + 1] + out[i].y; s += y[2 * i] + y[2 * i + 1]; }
            const float mu = wave_sum(s) * (1.0f / DM);
            float qq = 0.f;
#pragma unroll
            for (int i = 0; i < 16; ++i) { const float dd = y[i] - mu; qq += dd * dd; }
            const float rstd = rsqrtf(wave_sum(qq) * (1.0f / DM) + LN_EPS);
            const int col = 16 * lane;
            f32x4 o4[4];
#pragma unroll
            for (int q4 = 0; q4 < 4; ++q4) {
                const f32x4 ga = *(const f32x4*)(lng + col + 4 * q4), ba = *(const f32x4*)(lnb + col + 4 * q4);
#pragma unroll
                for (int e = 0; e < 4; ++e) o4[q4][e] = (y[4 * q4 + e] - mu) * rstd * ga[e] + ba[e];
            }
            if (xo_f32) {
#pragma unroll
                for (int q4 = 0; q4 < 4; ++q4) *(f32x4*)(xo_f32 + (size_t)t * DM + col + 4 * q4) = o4[q4];
            }
            if (xo_bf) {
                u32x4 w0 = {pk_bf16(o4[0].x, o4[0].y), pk_bf16(o4[0].z, o4[0].w), pk_bf16(o4[1].x, o4[1].y), pk_bf16(o4[1].z, o4[1].w)};
                u32x4 w1 = {pk_bf16(o4[2].x, o4[2].y), pk_bf16(o4[2].z, o4[2].w), pk_bf16(o4[3].x, o4[3].y), pk_bf16(o4[3].z, o4[3].w)};
                *(u32x4*)(xo_bf + (size_t)t * DM + col) = w0; *(u32x4*)(xo_bf + (size_t)t * DM + col + 8) = w1;
            }
            cur = nxt;
        }
    }
}

struct SliceMap { int j0, jstep, wslot, nslot; };
DI SliceMap slice_map(int w) {
    SliceMap m; const int G = gridDim.x;
    if (G >= 8) { m.j0 = blockIdx.x & 7; m.jstep = 8; m.wslot = (blockIdx.x >> 3) * 4 + w; m.nslot = ((G - m.j0 + 7) >> 3) * 4; }
    else { m.j0 = 0; m.jstep = 1; m.wslot = blockIdx.x * 4 + w; m.nslot = G * 4; }
    return m;
}
DI void peer_u_phase(const bf16_t* __restrict__ x1, const int* __restrict__ eidx, const unsigned char* __restrict__ U8, float* __restrict__ ph) {
    int tidv = threadIdx.x;
    asm volatile("" : "+v"(tidv));
    const int lane = tidv & 63, w = tidv >> 6, grp = lane >> 3, l8 = lane & 7;
    const SliceMap sm = slice_map(w);
    for (int j_ = sm.j0; j_ < 8 * REP_PU; j_ += sm.jstep) {
        const int j = j_ & 7;
        const unsigned char* ub = U8 + 128 * j + 16 * l8;
        const bf16_t* xb_ = x1 + 128 * j + 16 * l8;
        float* pj = ph + (size_t)j * T_TOK * 128;
        const int step = sm.nslot;
        int t = sm.wslot;
        if (t >= T_TOK) continue;
        u32x4 sa[16], sb[16];
        int e0n = 0, e1n = 0;
        u32x4 xa, xb, xan, xbn;
#define U_ISSUE(SEG, E0, E1) { _Pragma("unroll") for (int b = 0; b < 16; ++b) { const int e = __shfl((b < 8) ? (E0) : (E1), (b & 7) * 8 + grp); SEG[b] = *(const u32x4*)(ub + (size_t)e * DM); } }
#define U_COMPUTE(SEG, TT) { float hsum[2]; \
            _Pragma("unroll") for (int hf = 0; hf < 2; ++hf) { float d[8]; \
                _Pragma("unroll") for (int i = 0; i < 8; ++i) { d[i] = dot_fp8_row(SEG[hf * 8 + i], xa, xb); } \
                float d4[4], d2[2]; \
                { const bool hi = (l8 & 4) != 0; _Pragma("unroll") for (int i = 0; i < 4; ++i) { const float keep = hi ? d[i + 4] : d[i], send = hi ? d[i] : d[i + 4]; d4[i] = keep + __shfl_xor(send, 4); } } \
                { const bool hi = (l8 & 2) != 0; _Pragma("unroll") for (int i = 0; i < 2; ++i) { const float keep = hi ? d4[i + 2] : d4[i], send = hi ? d4[i] : d4[i + 2]; d2[i] = keep + __shfl_xor(send, 2); } } \
                { const bool hi = (l8 & 1) != 0; const float keep = hi ? d2[1] : d2[0], send = hi ? d2[0] : d2[1]; hsum[hf] = keep + __shfl_xor(send, 1); } } \
            pj[(size_t)(TT) * 128 + 8 * l8 + grp] = hsum[0]; pj[(size_t)(TT) * 128 + 64 + 8 * l8 + grp] = hsum[1]; }
        {
            const int e0 = eidx[(size_t)t * 128 + lane], e1 = eidx[(size_t)t * 128 + 64 + lane];
            xa = *(const u32x4*)(xb_ + (size_t)t * DM); xb = *(const u32x4*)(xb_ + (size_t)t * DM + 8);
            U_ISSUE(sa, e0, e1)
            if (t + step < T_TOK) { e0n = eidx[(size_t)(t + step) * 128 + lane]; e1n = eidx[(size_t)(t + step) * 128 + 64 + lane]; }
        }
        for (; t < T_TOK; t += 2 * step) {
            int e0nn = 0, e1nn = 0;
            const bool n1 = t + step < T_TOK, n2 = t + 2 * step < T_TOK, n3 = t + 3 * step < T_TOK;
            if (n1) { U_ISSUE(sb, e0n, e1n) xan = *(const u32x4*)(xb_ + (size_t)(t + step) * DM); xbn = *(const u32x4*)(xb_ + (size_t)(t + step) * DM + 8); }
            if (n2) { e0nn = eidx[(size_t)(t + 2 * step) * 128 + lane]; e1nn = eidx[(size_t)(t + 2 * step) * 128 + 64 + lane]; }
            U_COMPUTE(sa, t)
            if (n1) {
                xa = xan; xb = xbn;
                if (n2) { U_ISSUE(sa, e0nn, e1nn) xan = *(const u32x4*)(xb_ + (size_t)(t + 2 * step) * DM); xbn = *(const u32x4*)(xb_ + (size_t)(t + 2 * step) * DM + 8); }
                if (n3) { e0n = eidx[(size_t)(t + 3 * step) * 128 + lane]; e1n = eidx[(size_t)(t + 3 * step) * 128 + 64 + lane]; }
                U_COMPUTE(sb, t + step)
                xa = xan; xb = xbn;
            }
        }
#undef U_ISSUE
#undef U_COMPUTE
    }
}
DI void peer_hw_phase(const float* __restrict__ ph, const int* __restrict__ eidx, const float* __restrict__ su, const float* __restrict__ sv, float* __restrict__ gws) {
    const size_t n = (size_t)T_TOK * 128, nthreads = (size_t)gridDim.x * blockDim.x;
    for (size_t i = (size_t)blockIdx.x * blockDim.x + threadIdx.x; i < n; i += nthreads) {
        float hsum = 0.f;
#pragma unroll
        for (int j = 0; j < 8; ++j) hsum += ph[(size_t)j * n + i];
        const int e = eidx[i];
        gws[i] = gws[i] * gelu_exact(hsum * su[e]) * sv[e];
    }
}
DI void peer_v_phase(const bf16_t* __restrict__ x1, const int* __restrict__ eidx, const float* __restrict__ wgt, const unsigned char* __restrict__ V8, bf16_t* __restrict__ y) {
    int tidv = threadIdx.x;
    asm volatile("" : "+v"(tidv));
    const int lane = tidv & 63, w = tidv >> 6, grp = lane >> 3, l8 = lane & 7;
    const SliceMap sm = slice_map(w);
    for (int j_ = sm.j0; j_ < 8 * REP_PV; j_ += sm.jstep) {
        const int j = j_ & 7;
        const unsigned char* vb = V8 + 128 * j + 16 * l8;
        const int col = 128 * j + 16 * l8 + 2 * grp;
        const int step = sm.nslot;
        int t = sm.wslot;
        if (t >= T_TOK) continue;
        u32x4 sa[16], sb[16];
        int e0n = 0, e1n = 0;
        float w0, w1, w0n = 0.f, w1n = 0.f;
#define V_ISSUE(SEG, E0, E1) { _Pragma("unroll") for (int b = 0; b < 16; ++b) { const int e = __shfl((b < 8) ? (E0) : (E1), (b & 7) * 8 + grp); SEG[b] = *(const u32x4*)(vb + (size_t)e * DM); } }
#define V_COMPUTE(SEG, TT) { f32x2 acc[8]; \
            _Pragma("unroll") for (int i = 0; i < 8; ++i) { acc[i].x = 0.f; acc[i].y = 0.f; } \
            _Pragma("unroll") for (int b = 0; b < 16; ++b) { const float wv = __shfl((b < 8) ? w0 : w1, (b & 7) * 8 + grp); axpy_fp8_row(acc, wv, SEG[b]); } \
            float a8[8], a4[4], a2[2]; \
            { const bool hi = (lane & 32) != 0; _Pragma("unroll") for (int i = 0; i < 8; ++i) { const float lo_ = (i & 1) ? acc[i >> 1].y : acc[i >> 1].x, hi_ = (i & 1) ? acc[4 + (i >> 1)].y : acc[4 + (i >> 1)].x; \
                const float keep = hi ? hi_ : lo_, send = hi ? lo_ : hi_; a8[i] = keep + __shfl_xor(send, 32); } } \
            { const bool hi = (lane & 16) != 0; _Pragma("unroll") for (int i = 0; i < 4; ++i) { const float keep = hi ? a8[i + 4] : a8[i], send = hi ? a8[i] : a8[i + 4]; a4[i] = keep + __shfl_xor(send, 16); } } \
            { const bool hi = (lane & 8) != 0; _Pragma("unroll") for (int i = 0; i < 2; ++i) { const float keep = hi ? a4[i + 2] : a4[i], send = hi ? a4[i] : a4[i + 2]; a2[i] = keep + __shfl_xor(send, 8); } } \
            const unsigned xr = *(const unsigned*)(x1 + (size_t)(TT) * DM + col); \
            *(unsigned*)(y + (size_t)(TT) * DM + col) = pk_bf16(DN_ALPHA * bf_lo(xr) + a2[0], DN_ALPHA * bf_hi(xr) + a2[1]); }
        {
            const int e0 = eidx[(size_t)t * 128 + lane], e1 = eidx[(size_t)t * 128 + 64 + lane];
            w0 = wgt[(size_t)t * 128 + lane]; w1 = wgt[(size_t)t * 128 + 64 + lane];
            V_ISSUE(sa, e0, e1)
            if (t + step < T_TOK) { e0n = eidx[(size_t)(t + step) * 128 + lane]; e1n = eidx[(size_t)(t + step) * 128 + 64 + lane]; }
        }
        for (; t < T_TOK; t += 2 * step) {
            int e0nn = 0, e1nn = 0;
            const bool n1 = t + step < T_TOK, n2 = t + 2 * step < T_TOK, n3 = t + 3 * step < T_TOK;
            if (n1) { V_ISSUE(sb, e0n, e1n) w0n = wgt[(size_t)(t + step) * 128 + lane]; w1n = wgt[(size_t)(t + step) * 128 + 64 + lane]; }
            if (n2) { e0nn = eidx[(size_t)(t + 2 * step) * 128 + lane]; e1nn = eidx[(size_t)(t + 2 * step) * 128 + 64 + lane]; }
            V_COMPUTE(sa, t)
            if (n1) {
                w0 = w0n; w1 = w1n;
                if (n2) { V_ISSUE(sa, e0nn, e1nn) w0n = wgt[(size_t)(t + 2 * step) * 128 + lane]; w1n = wgt[(size_t)(t + 2 * step) * 128 + 64 + lane]; }
                if (n3) { e0n = eidx[(size_t)(t + 3 * step) * 128 + lane]; e1n = eidx[(size_t)(t + 3 * step) * 128 + 64 + lane]; }
                V_COMPUTE(sb, t + step)
                w0 = w0n; w1 = w1n;
            }
        }
#undef V_ISSUE
#undef V_COMPUTE
    }
}

#define XB_TMO      128
#define XB_XCNT(j)  (256  + 64 * (j))
#define XB_XSUB(j)  (1280 + 64 * (j))
#define XB_XGEN(j)  (2304 + 64 * (j))
#define XB_TOP      3328
#define XB_TOPGEN   3392
#define XCD_BAR_WORDS 3456
#define XB_SPIN_CAP (1u << 22)
#define LAS __attribute__((address_space(3)))

__device__ __forceinline__ unsigned xb_ld(unsigned* p)              { return __hip_atomic_load(p, __ATOMIC_RELAXED, __HIP_MEMORY_SCOPE_AGENT); }
__device__ __forceinline__ unsigned xb_add(unsigned* p, unsigned v) { return __hip_atomic_fetch_add(p, v, __ATOMIC_RELAXED, __HIP_MEMORY_SCOPE_AGENT); }
__device__ __forceinline__ unsigned xb_xcc_id() { return (unsigned)__builtin_amdgcn_s_getreg((3 << 11) | 20) & 0xFu; }
#define XB_SPIN(cond, bar) do { unsigned _sp = 0; while (cond) { __builtin_amdgcn_s_sleep(1); \
    if ((++_sp & 255u) == 0u) { if (xb_ld(&(bar)[XB_TMO])) break; if (_sp > XB_SPIN_CAP) { atomicAdd(&(bar)[XB_TMO], 1u); break; } } } } while (0)

struct XcdBarrier {
    unsigned* bar; unsigned x;
    volatile LAS unsigned* st;
};

__device__ __forceinline__ XcdBarrier xcd_barrier_post(unsigned* bar, volatile LAS unsigned* st) {
    XcdBarrier b; b.bar = bar; b.x = xb_xcc_id(); b.st = st;
    if (threadIdx.x == 0) (void)xb_add(&bar[XB_XCNT(b.x)], 1u);
    return b;
}
__device__ __forceinline__ void xcd_barrier_complete(unsigned* bar, unsigned x, unsigned& nloc, unsigned& nx) {
    const unsigned G = gridDim.x * gridDim.y * gridDim.z;
    unsigned sum, cnt, mine, sp = 0u;
    for (;;) {
        sum = 0u; cnt = 0u; mine = 0u;
#pragma unroll
        for (unsigned j = 0; j < 16; ++j) { const unsigned c = xb_ld(&bar[XB_XCNT(j)]); sum += c; cnt += (c > 0u) ? 1u : 0u; mine = (j == x) ? c : mine; }
        if (sum == G) break;
        __builtin_amdgcn_s_sleep(1);
        if ((++sp & 255u) == 0u) { if (xb_ld(&bar[XB_TMO])) break; if (sp > XB_SPIN_CAP) { atomicAdd(&bar[XB_TMO], 1u); break; } }
    }
    nloc = mine > 0u ? mine : 1u; nx = cnt > 0u ? cnt : 1u;
}

__device__ __forceinline__ void xcd_barrier(const XcdBarrier& b) {
    asm volatile("s_waitcnt vmcnt(0)" ::: "memory");
    __syncthreads();
    if (threadIdx.x == 0) {
        unsigned* bar = b.bar;
        __builtin_amdgcn_s_waitcnt(0);
        unsigned nloc = b.st[0], nx = b.st[1];
        if (nloc == 0u) { xcd_barrier_complete(bar, b.x, nloc, nx); b.st[0] = nloc; b.st[1] = nx; }
        const unsigned old = xb_add(&bar[XB_XSUB(b.x)], 1u);
        const unsigned gen = old / nloc;
        if (old + 1u == (gen + 1u) * nloc) {
            __builtin_amdgcn_fence(__ATOMIC_RELEASE, "agent");
            asm volatile("s_waitcnt vmcnt(0)" ::: "memory");
            const unsigned og = xb_add(&bar[XB_TOP], 1u);
            const unsigned tg = og / nx;
            if (og + 1u == (tg + 1u) * nx) xb_add(&bar[XB_TOPGEN], 1u);
            else XB_SPIN(xb_ld(&bar[XB_TOPGEN]) == tg, bar);
            __builtin_amdgcn_fence(__ATOMIC_ACQUIRE, "agent");
            xb_add(&bar[XB_XGEN(b.x)], 1u);
            asm volatile("s_waitcnt vmcnt(0)" ::: "memory");
        } else {
            XB_SPIN(xb_ld(&bar[XB_XGEN(b.x)]) == gen, bar);
            __builtin_amdgcn_fence(__ATOMIC_ACQUIRE, "agent");
            asm volatile("s_waitcnt vmcnt(0)" ::: "memory");
        }
    }
    __syncthreads();
}


DI void gsync(cg::grid_group& g) {
    asm volatile("s_waitcnt vmcnt(0) lgkmcnt(0)" ::: "memory");
    g.sync();
    if (threadIdx.x == 0) { __builtin_amdgcn_fence(__ATOMIC_ACQUIRE, "agent"); asm volatile("s_waitcnt vmcnt(0)" ::: "memory"); }
    __syncthreads();
}

__global__ void __launch_bounds__(256, 2) mega_fwd(Params P) {
    extern __shared__ __attribute__((aligned(16))) unsigned char lds[];
    cg::grid_group grid = cg::this_grid();
    volatile LAS unsigned* xb_st = (volatile LAS unsigned*)(lds + LDS_PHASE_BYTES);
    if (threadIdx.x == 0) { xb_st[0] = 0u; xb_st[1] = 0u; }
    __syncthreads();
    const XcdBarrier xbar = xcd_barrier_post((unsigned*)(P.ws + W_BAR), xb_st);
    unsigned char* ws = P.ws;
    bf16_t* r0 = (bf16_t*)(ws + R0);
    bf16_t* r1 = (bf16_t*)(ws + R1);
    bf16_t* r2 = (bf16_t*)(ws + R2);
    bf16_t* r3 = (bf16_t*)(ws + R3);
    int* eidx = (int*)(ws + R4);
    float* gws = (float*)(ws + R4 + 32 * MBy);
    unsigned char* U8 = ws + R5;
    unsigned char* V8 = ws + R5 + 32 * MBy;
    float* su = (float*)(ws + W_SCALE);
    float* sv = su + 2 * 16384;
    bf16_t* w_daqkv = (bf16_t*)(ws + W_DAQKV);
    bf16_t* w_dawo = (bf16_t*)(ws + W_DAWO);
    bf16_t* w_swqkv = (bf16_t*)(ws + W_SWQKV);
    bf16_t* w_swwo = (bf16_t*)(ws + W_SWWO);
    bf16_t* w_pkq0 = (bf16_t*)(ws + W_PKQ0);
    bf16_t* w_pkq1 = (bf16_t*)(ws + W_PKQ1);
    bf16_t* subk = (bf16_t*)(ws + W_SUBK);
    f32x2* rope = (f32x2*)(ws + W_ROPE);
    float* yf = (float*)(ws + R0);
    bf16_t* yb = (bf16_t*)(ws + R0);
    constexpr size_t TD = (size_t)T_TOK * DM;
    constexpr size_t NE = (size_t)16384 * DM;

    convert_flat(P.x, r1, TD);
    convert_rows_fp8(P.pk_u, U8, su, 2 * 16384);
    convert_rows_fp8(P.pk_v, V8, sv, 2 * 16384);
    convert_flat(P.pk_sub_keys, subk, (size_t)2 * 8 * 2 * 128 * 64);
    transpose_convert(P.da_w_qkv, w_daqkv, 3072, (float*)lds);
    transpose_convert(P.da_w_o, w_dawo, 1024, (float*)lds);
    transpose_convert(P.sw_w_qkv, w_swqkv, 1280, (float*)lds);
    transpose_convert(P.sw_w_o, w_swwo, 1024, (float*)lds);
    transpose_convert(P.pk_w_query, w_pkq0, 1024, (float*)lds);
    transpose_convert(P.pk_w_query + (size_t)1024 * 1024, w_pkq1, 1024, (float*)lds);
    rope_table(rope);
    gsync(grid);

    {
        bf16_t* q = r0; bf16_t* k = r0 + TD; bf16_t* vt = r0 + 2 * TD;
        EpiQKV e{q, k, vt, rope, nullptr, 1024, 1024, 7, 8};
        gemm_phase(r1, w_daqkv, T_TOK, 3072, 1024, lds, e);
        xcd_barrier(xbar);
        AttnArgs a{q, k, vt, r2, P.da_lambda, P.da_subln_g, nullptr, nullptr};
        attn_phase<0>(a, lds);
        xcd_barrier(xbar);
        diff_combine_phase(r2, P.da_lambda, P.da_subln_g, r1);
        xcd_barrier(xbar);
        EpiRes<true> er{(const void*)P.x, nullptr, yb};
        gemm_phase(r1, w_dawo, T_TOK, 1024, 1024, lds, er);
        xcd_barrier(xbar);
        ln_phase(yb, P.ln1_g, P.ln1_b, r2);
        xcd_barrier(xbar);
        EpiBf16 eq{r3};
        gemm_phase(r2, w_pkq0, T_TOK, 1024, 1024, lds, eq);
        xcd_barrier(xbar);
        peer_topk_phase(r3, subk, eidx, gws);
        xcd_barrier(xbar);
        peer_u_phase(r2, eidx, U8, yf);
        xcd_barrier(xbar);
        peer_hw_phase(yf, eidx, su, sv, gws);
        xcd_barrier(xbar);
        peer_v_phase(r2, eidx, gws, V8, yb);
        xcd_barrier(xbar);
        ln_phase(yb, P.ln2_g, P.ln2_b, r1);
        xcd_barrier(xbar);
    }
    {
        bf16_t* q = r0; bf16_t* k = r0 + TD; bf16_t* vt = k + (size_t)T_TOK * 128;
        EpiQKV e{q, k, vt, rope, P.sw_b_qkv, 1024, 128, 6, 2};
        gemm_phase(r1, w_swqkv, T_TOK, 1280, 1024, lds, e);
        xcd_barrier(xbar);
        AttnArgs a{q, k, vt, r2, nullptr, nullptr, P.sw_sinks, nullptr};
        attn_phase<1>(a, lds);
        xcd_barrier(xbar);
        EpiRes<false> er{(const void*)r1, P.sw_b_o, yb};
        gemm_phase(r2, w_swwo, T_TOK, 1024, 1024, lds, er);
        xcd_barrier(xbar);
        ln_phase(yb, P.ln1_g + DM, P.ln1_b + DM, r3);
        xcd_barrier(xbar);
        EpiBf16 eq{r2};
        gemm_phase(r3, w_pkq1, T_TOK, 1024, 1024, lds, eq);
        xcd_barrier(xbar);
        peer_topk_phase(r2, subk + (size_t)8 * 2 * 128 * 64, eidx, gws);
        xcd_barrier(xbar);
        peer_u_phase(r3, eidx, U8 + NE, yf);
        xcd_barrier(xbar);
        peer_hw_phase(yf, eidx, su + 16384, sv + 16384, gws);
        xcd_barrier(xbar);
        peer_v_phase(r3, eidx, gws, V8 + NE, yb);
        xcd_barrier(xbar);
        ln_phase(yb, P.ln2_g + DM, P.ln2_b + DM, nullptr, P.out);
    }
}

extern "C" void kernel_launch(void* const* d_in, const int* in_sizes, int n_in, void* d_out, int out_size, void* d_ws, size_t ws_size, hipStream_t stream) {
    static int grid_blocks = 0;
    if (grid_blocks == 0) {
        if (n_in != 18 || ws_size < WS_END) { fprintf(stderr, "kernel_launch: unexpected n_in %d or ws_size %zu (< %zu)\n", n_in, ws_size, (size_t)WS_END); grid_blocks = -1; return; }
        int dev = 0, cus = 0, per_cu = 0;
        hipGetDevice(&dev);
        hipDeviceGetAttribute(&cus, hipDeviceAttributeMultiprocessorCount, dev);
        if (hipFuncSetAttribute((const void*)mega_fwd, hipFuncAttributeMaxDynamicSharedMemorySize, LDS_BYTES) != hipSuccess) { fprintf(stderr, "kernel_launch: hipFuncSetAttribute failed\n"); grid_blocks = -1; return; }
        if (hipOccupancyMaxActiveBlocksPerMultiprocessor(&per_cu, (const void*)mega_fwd, 256, LDS_BYTES) != hipSuccess || per_cu < 1) { fprintf(stderr, "kernel_launch: occupancy query failed (%d)\n", per_cu); per_cu = 1; (void)hipGetLastError(); }
        grid_blocks = cus * per_cu;
        fprintf(stderr, "kernel_launch: grid %d (%d CUs x %d)\n", grid_blocks, cus, per_cu);
    }
    if (grid_blocks < 0) return;
    Params p{};
    p.x = (const float*)d_in[0]; p.da_w_qkv = (const float*)d_in[1]; p.da_lambda = (const float*)d_in[2]; p.da_subln_g = (const float*)d_in[3]; p.da_w_o = (const float*)d_in[4];
    p.sw_w_qkv = (const float*)d_in[5]; p.sw_b_qkv = (const float*)d_in[6]; p.sw_sinks = (const float*)d_in[7]; p.sw_w_o = (const float*)d_in[8]; p.sw_b_o = (const float*)d_in[9];
    p.pk_w_query = (const float*)d_in[10]; p.pk_sub_keys = (const float*)d_in[11]; p.pk_u = (const float*)d_in[12]; p.pk_v = (const float*)d_in[13];
    p.ln1_g = (const float*)d_in[14]; p.ln1_b = (const float*)d_in[15]; p.ln2_g = (const float*)d_in[16]; p.ln2_b = (const float*)d_in[17];
    p.out = (float*)d_out; p.ws = (unsigned char*)d_ws;
    if (hipMemsetAsync((unsigned char*)d_ws + W_BAR, 0, XCD_BAR_WORDS * sizeof(unsigned), stream) != hipSuccess) { fprintf(stderr, "kernel_launch: hipMemsetAsync failed\n"); return; }
    void* args[] = {&p};
    hipError_t e = hipLaunchCooperativeKernel((const void*)mega_fwd, dim3(grid_blocks), dim3(256), args, LDS_BYTES, stream);
    if (e != hipSuccess) fprintf(stderr, "cooperative launch failed: %s (grid %d)\n", hipGetErrorString(e), grid_blocks);
}
```

```cpp
#include <hip/hip_runtime.h>
#include <hip/hip_cooperative_groups.h>
#include <cstdio>
#include <cstdint>
namespace cg = cooperative_groups;

#define DI __device__ __forceinline__
typedef unsigned short bf16_t;
typedef short bf16x8 __attribute__((ext_vector_type(8)));
typedef float f32x16 __attribute__((ext_vector_type(16)));
typedef float f32x4 __attribute__((ext_vector_type(4)));
typedef float f32x2 __attribute__((ext_vector_type(2)));
typedef unsigned u32x4 __attribute__((ext_vector_type(4)));
typedef unsigned u32x2 __attribute__((ext_vector_type(2)));
typedef __bf16 bf16x2_t __attribute__((ext_vector_type(2)));
#define MFMA(a, b, c) __builtin_amdgcn_mfma_f32_32x32x16_bf16((a), (b), (c), 0, 0, 0)

constexpr int T_TOK = 65536, DM = 1024, SEQ = 8192;
constexpr float DN_ALPHA = 1.41421356237309515f;
constexpr float LN_EPS = 1e-5f;
constexpr float LOG2E = 1.44269504088896341f;
constexpr float LAMBDA_INIT0 = 0.2f;

constexpr size_t MBy = 1u << 20;
constexpr size_t R0 = 0, R1 = 384 * MBy, R2 = 512 * MBy, R3 = 640 * MBy, R4 = 768 * MBy, R5 = 832 * MBy, R6 = 960 * MBy;
constexpr size_t W_DAQKV = R6, W_DAWO = R6 + 6 * MBy, W_SWQKV = R6 + 8 * MBy, W_SWWO = R6 + 11 * MBy, W_PKQ0 = R6 + 13 * MBy, W_PKQ1 = R6 + 15 * MBy,
                 W_SUBK = R6 + 17 * MBy, W_ROPE = R6 + 18 * MBy, W_SCALE = R6 + 20 * MBy, W_BAR = R6 + 21 * MBy, WS_END = R6 + 22 * MBy;
constexpr int LDS_PHASE_BYTES = 73728, LDS_BYTES = LDS_PHASE_BYTES + 16;
#ifndef REP_GEMM
#define REP_GEMM 1
#endif
#ifndef REP_ATT0
#define REP_ATT0 1
#endif
#ifndef REP_ATT1
#define REP_ATT1 1
#endif
#ifndef REP_TOPK
#define REP_TOPK 1
#endif
#ifndef REP_GATHER
#define REP_GATHER 1
#endif
#ifndef REP_P0
#define REP_P0 1
#endif
#ifndef REP_PU
#define REP_PU 1
#endif
#ifndef REP_PV
#define REP_PV 1
#endif

__constant__ float c_inv_freq[32] = {
    1.000000000e+00f, 7.498942018e-01f, 5.623413324e-01f, 4.216965139e-01f, 3.162277639e-01f, 2.371373922e-01f, 1.778279394e-01f, 1.333521456e-01f,
    1.000000015e-01f, 7.498941571e-02f, 5.623412877e-02f, 4.216964915e-02f, 3.162277862e-02f, 2.371373586e-02f, 1.778279431e-02f, 1.333521493e-02f,
    9.999999776e-03f, 7.498942316e-03f, 5.623413250e-03f, 4.216964822e-03f, 3.162277862e-03f, 2.371373819e-03f, 1.778279431e-03f, 1.333521446e-03f,
    1.000000047e-03f, 7.498941850e-04f, 5.623413017e-04f, 4.216965463e-04f, 3.162277862e-04f, 2.371373848e-04f, 1.778279402e-04f, 1.333521504e-04f};

struct Params {
    const float* x; const float* da_w_qkv; const float* da_lambda; const float* da_subln_g; const float* da_w_o;
    const float* sw_w_qkv; const float* sw_b_qkv; const float* sw_sinks; const float* sw_w_o; const float* sw_b_o;
    const float* pk_w_query; const float* pk_sub_keys; const float* pk_u; const float* pk_v;
    const float* ln1_g; const float* ln1_b; const float* ln2_g; const float* ln2_b;
    float* out; unsigned char* ws;
};

DI unsigned pk_bf16(float a, float b) { f32x2 f = {a, b}; return __builtin_bit_cast(unsigned, __builtin_convertvector(f, bf16x2_t)); }
DI bf16_t to_bf16(float a) { return (bf16_t)(pk_bf16(a, a) & 0xffffu); }
DI float bf_lo(unsigned u) { return __uint_as_float(u << 16); }
DI float bf_hi(unsigned u) { return __uint_as_float(u & 0xffff0000u); }
DI float wave_sum(float v) {
#pragma unroll
    for (int o = 32; o >= 1; o >>= 1) v += __shfl_xor(v, o);
    return v;
}

DI void convert_flat(const float* __restrict__ src, bf16_t* __restrict__ dst, size_t n) {
    const size_t nthreads = (size_t)gridDim.x * blockDim.x;
    for (size_t i_ = (size_t)blockIdx.x * blockDim.x + threadIdx.x; i_ < (n / 8) * REP_P0; i_ += nthreads) {
        const size_t i = (REP_P0 == 1) ? i_ : i_ % (n / 8);
        const f32x4 a = ((const f32x4*)src)[2 * i], b = ((const f32x4*)src)[2 * i + 1];
        u32x4 o; o.x = pk_bf16(a.x, a.y); o.y = pk_bf16(a.z, a.w); o.z = pk_bf16(b.x, b.y); o.w = pk_bf16(b.z, b.w);
        ((u32x4*)dst)[i] = o;
    }
}
DI void transpose_convert(const float* __restrict__ src, bf16_t* __restrict__ dst, int N, float* ldsf) {
    const int tilesN = N >> 6, ntiles = 16 * tilesN;
    const int tx = threadIdx.x & 63, ty = threadIdx.x >> 6;
    for (int tile = blockIdx.x; tile < ntiles; tile += gridDim.x) {
        const int tk = tile / tilesN, tn = tile - tk * tilesN;
        __syncthreads();
#pragma unroll
        for (int i = 0; i < 16; ++i) { const int k = ty + 4 * i; ldsf[k * 65 + tx] = src[(size_t)(tk * 64 + k) * N + tn * 64 + tx]; }
        __syncthreads();
#pragma unroll
        for (int i = 0; i < 16; ++i) { const int n = ty + 4 * i; dst[(size_t)(tn * 64 + n) * 1024 + tk * 64 + tx] = to_bf16(ldsf[tx * 65 + n]); }
    }
}
DI void rope_table(f32x2* rope) {
    const int nthreads = gridDim.x * blockDim.x;
    for (int i = blockIdx.x * blockDim.x + threadIdx.x; i < SEQ * 32; i += nthreads) {
        const int pos = i >> 5, j = i & 31;
        const float ang = (float)pos * c_inv_freq[j];
        const float kf = rintf(ang * 0.636619772367581343f);
        float rr = fmaf(-kf, 1.57079637050628662109375f, ang);
        rr = fmaf(-kf, -4.37113882867379294e-8f, rr);
        const float r2 = rr * rr;
        const float sn = rr + rr * r2 * (-1.6666654611e-1f + r2 * (8.3321608736e-3f + r2 * (-1.9515295891e-4f)));
        const float cs = 1.0f - 0.5f * r2 + r2 * r2 * (4.166664568298827e-2f + r2 * (-1.388731625493765e-3f + r2 * 2.443315711809948e-5f));
        const int q = ((int)kf) & 3;
        float c, s;
        if (q == 0) { c = cs; s = sn; } else if (q == 1) { c = -sn; s = cs; } else if (q == 2) { c = -cs; s = -sn; } else { c = sn; s = -cs; }
        f32x2 o = {c, s};
        rope[i] = o;
    }
}

DI void store_row32_bf16(bf16_t* rowp, const u32x2 (&A)[4], int h) {
#pragma unroll
    for (int gp = 0; gp < 2; ++gp) {
        const auto r0 = __builtin_amdgcn_permlane32_swap(A[2 * gp].x, A[2 * gp + 1].x, false, false);
        const auto r1 = __builtin_amdgcn_permlane32_swap(A[2 * gp].y, A[2 * gp + 1].y, false, false);
        u32x4 wv = {(unsigned)r0[0], (unsigned)r1[0], (unsigned)r0[1], (unsigned)r1[1]};
        *(u32x4*)(rowp + 16 * gp + 8 * h) = wv;
    }
}

template <class Epi>
DI void gemm_phase(const bf16_t* __restrict__ A, const bf16_t* __restrict__ Bt, int M, int N, int K, unsigned char* lds, const Epi& epi) {
    constexpr int STR = 144, TB = 128 * STR;
    const int tid = threadIdx.x, lane = tid & 63, w = tid >> 6, wm = w >> 1, wn = w & 1, r = lane & 31, h = lane >> 5;
    const int tilesN = N >> 7, ntiles = (M >> 7) * tilesN, nk = K >> 6;
    const int lrow = tid >> 3, lcol = tid & 7;
    const int G = gridDim.x, tilesM = M >> 7;
    const bool xcd_order = (G & 7) == 0;
    const int nlb = xcd_order ? (G >> 3) : 1, PW = (tilesN & 7) == 0 ? 8 : tilesN;
    const int npad = ((ntiles + G - 1) / G) * G;
    for (int tile_ = blockIdx.x; tile_ < npad * REP_GEMM; tile_ += G) {
        int tile = (REP_GEMM == 1) ? tile_ : tile_ % npad;
        if (xcd_order) {
            const int rd = tile / G, c = tile - rd * G;
            const int lin = ((rd << 3) + (c & 7)) * nlb + (c >> 3);
            tile = lin;
        }
        if (tile >= ntiles) continue;
        const int pnl = tile / (tilesM * PW), rem = tile - pnl * (tilesM * PW);
        const int tm = rem / PW, tn = pnl * PW + (rem - tm * PW);
        const bf16_t* Ag = A + (size_t)(tm * 128 + lrow) * K + lcol * 8;
        const bf16_t* Bg = Bt + (size_t)(tn * 128 + lrow) * K + lcol * 8;
        u32x4 ra0[4], rb0[4], ra1[4], rb1[4];
#define GEMM_LOAD(RA, RB, KT) { _Pragma("unroll") for (int i = 0; i < 4; ++i) { RA[i] = *(const u32x4*)(Ag + (size_t)(32 * i) * K + (KT) * 64); RB[i] = *(const u32x4*)(Bg + (size_t)(32 * i) * K + (KT) * 64); } }
#define GEMM_STORE(RA, RB, BUF) { _Pragma("unroll") for (int i = 0; i < 4; ++i) { *(u32x4*)(lds + (BUF) * TB + (lrow + 32 * i) * STR + lcol * 16) = RA[i]; *(u32x4*)(lds + 2 * TB + (BUF) * TB + (lrow + 32 * i) * STR + lcol * 16) = RB[i]; } }
#define GEMM_COMPUTE(BUF) { \
            const unsigned char* la = lds + (BUF) * TB + (wm * 64 + r) * STR + h * 16; \
            const unsigned char* lb = lds + 2 * TB + (BUF) * TB + (wn * 64 + r) * STR + h * 16; \
            _Pragma("unroll") for (int ks = 0; ks < 4; ++ks) { \
                bf16x8 af[2], bfr[2]; \
                _Pragma("unroll") for (int mi = 0; mi < 2; ++mi) af[mi] = *(const bf16x8*)(la + mi * 32 * STR + ks * 32); \
                _Pragma("unroll") for (int ni = 0; ni < 2; ++ni) bfr[ni] = *(const bf16x8*)(lb + ni * 32 * STR + ks * 32); \
                _Pragma("unroll") for (int mi = 0; mi < 2; ++mi) \
                    _Pragma("unroll") for (int ni = 0; ni < 2; ++ni) acc[mi][ni] = MFMA(bfr[ni], af[mi], acc[mi][ni]); \
            } }
        GEMM_LOAD(ra0, rb0, 0)
        if (nk > 1) GEMM_LOAD(ra1, rb1, 1)
        f32x16 acc[2][2];
#pragma unroll
        for (int mi = 0; mi < 2; ++mi)
#pragma unroll
            for (int ni = 0; ni < 2; ++ni)
#pragma unroll
                for (int i = 0; i < 16; ++i) acc[mi][ni][i] = 0.f;
        GEMM_STORE(ra0, rb0, 0)
        __syncthreads();
        for (int kt = 0; kt < nk; kt += 2) {
            if (kt + 2 < nk) GEMM_LOAD(ra0, rb0, kt + 2)
            GEMM_COMPUTE(0)
            if (kt + 1 < nk) GEMM_STORE(ra1, rb1, 1)
            __syncthreads();
            if (kt + 1 < nk) {
                if (kt + 3 < nk) GEMM_LOAD(ra1, rb1, kt + 3)
                GEMM_COMPUTE(1)
                if (kt + 2 < nk) GEMM_STORE(ra0, rb0, 0)
                __syncthreads();
            }
        }
#undef GEMM_LOAD
#undef GEMM_STORE
#undef GEMM_COMPUTE
        epi(acc, tm * 128 + wm * 64, tn * 128 + wn * 64, r, h);
    }
}

struct EpiQKV {
    bf16_t* q; bf16_t* k; bf16_t* vt; const f32x2* rope; const float* bias; int nq, nk, dv_shift, hv;
    DI void operator()(const f32x16 (&acc)[2][2], int m0, int n0, int r, int h) const {
        if (n0 < nq + nk) {
            const bool isq = n0 < nq;
            bf16_t* dst = isq ? q + n0 : k + (n0 - nq);
            const int ld = isq ? nq : nk;
            const float qs = isq ? 0.125f * LOG2E : 1.0f;
#pragma unroll
            for (int mi = 0; mi < 2; ++mi) {
                const int m = m0 + mi * 32 + r, pos = m & (SEQ - 1);
                const f32x4* rp = (const f32x4*)(rope + pos * 32);
                u32x2 A1[4], A2[4];
#pragma unroll
                for (int g = 0; g < 4; ++g) {
                    const int j0 = 8 * g + 4 * h;
                    const f32x4 cs01 = rp[j0 >> 1], cs23 = rp[(j0 >> 1) + 1];
                    f32x4 b1 = {0.f, 0.f, 0.f, 0.f}, b2 = {0.f, 0.f, 0.f, 0.f};
                    if (bias) { b1 = *(const f32x4*)(bias + n0 + j0); b2 = *(const f32x4*)(bias + n0 + 32 + j0); }
                    const float c[4] = {cs01.x, cs01.z, cs23.x, cs23.z}, s[4] = {cs01.y, cs01.w, cs23.y, cs23.w};
                    float o1[4], o2[4];
#pragma unroll
                    for (int e = 0; e < 4; ++e) {
                        const float t1 = acc[mi][0][4 * g + e] + b1[e], t2 = acc[mi][1][4 * g + e] + b2[e];
                        o1[e] = (t1 * c[e] - t2 * s[e]) * qs; o2[e] = (t2 * c[e] + t1 * s[e]) * qs;
                    }
                    A1[g].x = pk_bf16(o1[0], o1[1]); A1[g].y = pk_bf16(o1[2], o1[3]); A2[g].x = pk_bf16(o2[0], o2[1]); A2[g].y = pk_bf16(o2[2], o2[3]);
                }
                store_row32_bf16(dst + (size_t)m * ld, A1, h);
                store_row32_bf16(dst + (size_t)m * ld + 32, A2, h);
            }
        } else {
            const int nv = n0 - nq - nk;
#pragma unroll
            for (int mi = 0; mi < 2; ++mi) {
                const int m = m0 + mi * 32 + r, b = m >> 13, s = m & (SEQ - 1);
#pragma unroll
                for (int ni = 0; ni < 2; ++ni)
#pragma unroll
                    for (int i = 0; i < 16; ++i) {
                        const int eg = nv + ni * 32 + (i & 3) + 8 * (i >> 2) + 4 * h;
                        const float bv = bias ? bias[nq + nk + eg] : 0.f;
                        const int hh = eg >> dv_shift, e = eg & ((1 << dv_shift) - 1);
                        vt[((size_t)((b * hv + hh) << dv_shift) + e) * SEQ + s] = to_bf16(acc[mi][ni][i] + bv);
                    }
            }
        }
    }
};
template <bool RES_F32> struct EpiRes {
    const void* res; const float* bias; bf16_t* y;
    DI void operator()(const f32x16 (&acc)[2][2], int m0, int n0, int r, int h) const {
#pragma unroll
        for (int mi = 0; mi < 2; ++mi) {
            const int m = m0 + mi * 32 + r;
#pragma unroll
            for (int ni = 0; ni < 2; ++ni) {
                u32x2 A[4];
#pragma unroll
                for (int g = 0; g < 4; ++g) {
                    const int n = n0 + ni * 32 + 8 * g + 4 * h;
                    f32x4 xr;
                    if (RES_F32) xr = *(const f32x4*)((const float*)res + (size_t)m * DM + n);
                    else { const u32x2 u = *(const u32x2*)((const bf16_t*)res + (size_t)m * DM + n); xr.x = bf_lo(u.x); xr.y = bf_hi(u.x); xr.z = bf_lo(u.y); xr.w = bf_hi(u.y); }
                    f32x4 bv = {0.f, 0.f, 0.f, 0.f};
                    if (bias) bv = *(const f32x4*)(bias + n);
                    f32x4 o;
#pragma unroll
                    for (int e = 0; e < 4; ++e) o[e] = DN_ALPHA * xr[e] + acc[mi][ni][4 * g + e] + bv[e];
                    A[g].x = pk_bf16(o[0], o[1]); A[g].y = pk_bf16(o[2], o[3]);
                }
                store_row32_bf16(y + (size_t)m * DM + n0 + ni * 32, A, h);
            }
        }
    }
};
struct EpiBf16 {
    bf16_t* o;
    DI void operator()(const f32x16 (&acc)[2][2], int m0, int n0, int r, int h) const {
#pragma unroll
        for (int mi = 0; mi < 2; ++mi) {
            const int m = m0 + mi * 32 + r;
#pragma unroll
            for (int ni = 0; ni < 2; ++ni) {
                u32x2 A[4];
#pragma unroll
                for (int g = 0; g < 4; ++g) { A[g].x = pk_bf16(acc[mi][ni][4 * g], acc[mi][ni][4 * g + 1]); A[g].y = pk_bf16(acc[mi][ni][4 * g + 2], acc[mi][ni][4 * g + 3]); }
                store_row32_bf16(o + (size_t)m * DM + n0 + ni * 32, A, h);
            }
        }
    }
};

DI void ln_phase(const bf16_t* __restrict__ y, const float* __restrict__ g, const float* __restrict__ b, bf16_t* __restrict__ xo, float* __restrict__ xf = nullptr) {
    const int lane = threadIdx.x & 63, w = threadIdx.x >> 6;
    const int gw = blockIdx.x * 4 + w, nw = gridDim.x * 4;
    f32x4 gv[4], bv[4];
#pragma unroll
    for (int i = 0; i < 4; ++i) { gv[i] = ((const f32x4*)g)[lane + 64 * i]; bv[i] = ((const f32x4*)b)[lane + 64 * i]; }
    for (int row = gw; row < T_TOK; row += nw) {
        const u32x2* yr = (const u32x2*)(y + (size_t)row * DM);
        f32x4 v[4];
#pragma unroll
        for (int i = 0; i < 4; ++i) { const u32x2 u = yr[lane + 64 * i]; v[i].x = bf_lo(u.x); v[i].y = bf_hi(u.x); v[i].z = bf_lo(u.y); v[i].w = bf_hi(u.y); }
        float s = 0.f;
#pragma unroll
        for (int i = 0; i < 4; ++i) s += (v[i].x + v[i].y) + (v[i].z + v[i].w);
        const float mu = wave_sum(s) * (1.0f / DM);
        float q = 0.f;
#pragma unroll
        for (int i = 0; i < 4; ++i) { const f32x4 d = v[i] - mu; q += (d.x * d.x + d.y * d.y) + (d.z * d.z + d.w * d.w); }
        const float rstd = rsqrtf(wave_sum(q) * (1.0f / DM) + LN_EPS);
#pragma unroll
        for (int i = 0; i < 4; ++i) {
            const f32x4 o = (v[i] - mu) * rstd * gv[i] + bv[i];
            if (xf) *(f32x4*)(xf + (size_t)row * DM + 4 * (lane + 64 * i)) = o;
            if (xo) { u32x2 wv = {pk_bf16(o.x, o.y), pk_bf16(o.z, o.w)}; *(u32x2*)(xo + (size_t)row * DM + 4 * (lane + 64 * i)) = wv; }
        }
    }
}

struct AttnArgs {
    const bf16_t* q; const bf16_t* k; const bf16_t* vt; bf16_t* o;
    const float* lam_params; const float* subln_g; const float* sinks; float* scr;
};
DI int pi_perm(int r) { return (r & 0x13) | ((r & 4) << 1) | ((r & 8) >> 1); }

template <int MODE>
DI void attn_phase(const AttnArgs& a, unsigned char* lds) {
    constexpr int DV = MODE == 0 ? 128 : 64, EB = DV / 32;
    constexpr int KSTR = 144, VSTR = 144, KBUF = 64 * KSTR, VBUF = DV * VSTR;
    constexpr int KCH = 2, VCH = DV / 32;
    constexpr int LDK = MODE == 0 ? 1024 : 128, HV = MODE == 0 ? 8 : 2;
    constexpr int NITEMS = 8192;
    const int tid = threadIdx.x, lane = tid & 63, w = tid >> 6, r = lane & 31, h = lane >> 5;
    unsigned char* kl = lds;
    unsigned char* vl = lds + 3 * KBUF;
    const float NEG_INF = -__builtin_inff();
    const int G = gridDim.x;
    const int krow = tid >> 3, kcc = tid & 7;

    constexpr int REPA = MODE == 0 ? REP_ATT0 : REP_ATT1;
    for (int it_ = blockIdx.x; it_ < NITEMS * REPA; it_ += G) {
        const int it = (REPA == 1) ? it_ : it_ % NITEMS;
        int b, qb, qcol0, kcol0, vh, p = 0;
        if (MODE == 0) {
            int bh;
            const int s = it / G, c = it - s * G;
            if (G == 512) { const int jj = c >> 3; bh = (c & 7) + 8 * (s >> 1); p = jj & 1; qb = (s & 1) ? (jj >> 1) : 63 - (jj >> 1); }
            else if (G == 256) { const int jj = c >> 3; bh = (c & 7) + 8 * (s >> 2); p = s & 1; qb = (s & 2) ? jj : 63 - jj; }
            else { bh = it >> 7; p = it & 1; qb = 63 - ((it >> 1) & 63); }
            b = bh >> 3; const int hh = bh & 7; qcol0 = hh * 128; kcol0 = hh * 128; vh = hh;
        } else {
            const int head = it & 15; qb = (it >> 4) & 63; b = it >> 10;
            qcol0 = head * 64; vh = head >> 3; kcol0 = vh * 64;
        }
        const int q0 = qb * 128, qw0 = q0 + 32 * w, qpos = qw0 + r;
        const int kt0 = MODE == 0 ? 0 : ((q0 >= 128 ? q0 - 128 : 0) >> 6), kt1 = (q0 + 128) >> 6;
        const bf16_t* vg = a.vt + (size_t)(b * HV + vh) * DV * SEQ + (size_t)krow * SEQ + kcc * 8;
        const size_t tok = (size_t)b * SEQ + qpos;

        {
            const bf16_t* kg = a.k + (size_t)b * SEQ * LDK + kcol0 + p * 64 + (size_t)krow * LDK + kcc * 8;
            bf16x8 qf[4];
            {
                const bf16_t* qp = a.q + tok * 1024 + qcol0 + p * 64 + h * 8;
#pragma unroll
                for (int ks = 0; ks < 4; ++ks) qf[ks] = *(const bf16x8*)(qp + ks * 16);
            }
            f32x16 O[EB];
#pragma unroll
            for (int eb = 0; eb < EB; ++eb)
#pragma unroll
                for (int i = 0; i < 16; ++i) O[eb][i] = 0.f;
            float mrow = NEG_INF, lsum = 0.f;
            if (MODE == 1) { mrow = a.sinks[it & 15] * LOG2E; lsum = (h == 0) ? 1.0f : 0.0f; }

            u32x4 rk[KCH], rv[VCH];
#define ATT_LOADK(KT) { _Pragma("unroll") for (int i = 0; i < KCH; ++i) rk[i] = *(const u32x4*)(kg + (size_t)((KT) * 64 + 32 * i) * LDK); }
#define ATT_LOADV(KT) { _Pragma("unroll") for (int i = 0; i < VCH; ++i) rv[i] = *(const u32x4*)(vg + (size_t)(32 * i) * SEQ + (KT) * 64); }
#define ATT_STOREK(KT) { unsigned char* kd_ = kl + (((KT) - kt0) % 3) * KBUF; _Pragma("unroll") for (int i = 0; i < KCH; ++i) *(u32x4*)(kd_ + (krow + 32 * i) * KSTR + kcc * 16) = rk[i]; }
#define ATT_STOREV(KT) { unsigned char* vd_ = vl + (((KT) - kt0) & 1) * VBUF; _Pragma("unroll") for (int i = 0; i < VCH; ++i) *(u32x4*)(vd_ + (krow + 32 * i) * VSTR + kcc * 16) = rv[i]; }
            auto s_compute = [&](f32x16 (&sx)[2], const int kt) __attribute__((always_inline)) {
                const unsigned char* kb_ = kl + ((kt - kt0) % 3) * KBUF;
#pragma unroll
                for (int kb = 0; kb < 2; ++kb) {
#pragma unroll
                    for (int i = 0; i < 16; ++i) sx[kb][i] = 0.f;
#pragma unroll
                    for (int ks = 0; ks < 4; ++ks) {
                        const bf16x8 kf = *(const bf16x8*)(kb_ + (kb * 32 + pi_perm(r)) * KSTR + ks * 32 + h * 16);
                        sx[kb] = MFMA(kf, qf[ks], sx[kb]);
                    }
                }
            };
            auto step = [&](f32x16 (&s)[2], f32x16 (&sn)[2], const int kt) __attribute__((always_inline)) {
                const bool more1 = kt + 1 < kt1, more2 = kt + 2 < kt1;
                if (more2) ATT_LOADK(kt + 2)
                if (more1) ATT_LOADV(kt + 1)
                const int key0 = kt * 64;
                bool need_mask = key0 + 63 > qw0;
                if (MODE == 1) need_mask = need_mask || (key0 < qw0 + 31 - 127);
                if (need_mask) {
                    asm volatile("" ::: "memory");
#pragma unroll
                    for (int kb = 0; kb < 2; ++kb)
#pragma unroll
                        for (int i = 0; i < 16; ++i) {
                            const int key = key0 + kb * 32 + 16 * (i >> 3) + 8 * h + (i & 7);
                            bool valid = key <= qpos;
                            if (MODE == 1) valid = valid && (key > qpos - 128);
                            s[kb][i] = valid ? s[kb][i] : NEG_INF;
                        }
                }
                float mx = NEG_INF;
#pragma unroll
                for (int kb = 0; kb < 2; ++kb)
#pragma unroll
                    for (int i = 0; i < 16; ++i) mx = fmaxf(mx, s[kb][i]);
                mx = fmaxf(mx, __shfl_xor(mx, 32));
                if (__builtin_amdgcn_ballot_w64(mx > mrow + 8.0f) != 0ull) {
                    asm volatile("" ::: "memory");
                    const float mnew = fmaxf(mrow, mx);
                    const float alpha = __builtin_amdgcn_exp2f(mrow - mnew);
                    mrow = mnew;
                    lsum *= alpha;
#pragma unroll
                    for (int eb = 0; eb < EB; ++eb)
#pragma unroll
                        for (int i = 0; i < 16; ++i) O[eb][i] *= alpha;
                }
                s_compute(sn, kt + 1);
                f32x2 ps2 = {0.f, 0.f};
#pragma unroll
                for (int kb = 0; kb < 2; ++kb)
#pragma unroll
                    for (int i = 0; i < 16; i += 2) {
                        f32x2 pv = {__builtin_amdgcn_exp2f(s[kb][i] - mrow), __builtin_amdgcn_exp2f(s[kb][i + 1] - mrow)};
                        s[kb][i] = pv.x; s[kb][i + 1] = pv.y; ps2 += pv;
                    }
                lsum += ps2.x + ps2.y;
                bf16x8 pf[2][2];
#pragma unroll
                for (int kb = 0; kb < 2; ++kb)
#pragma unroll
                    for (int s2 = 0; s2 < 2; ++s2) {
                        u32x4 u;
                        u.x = pk_bf16(s[kb][8 * s2 + 0], s[kb][8 * s2 + 1]); u.y = pk_bf16(s[kb][8 * s2 + 2], s[kb][8 * s2 + 3]);
                        u.z = pk_bf16(s[kb][8 * s2 + 4], s[kb][8 * s2 + 5]); u.w = pk_bf16(s[kb][8 * s2 + 6], s[kb][8 * s2 + 7]);
                        pf[kb][s2] = __builtin_bit_cast(bf16x8, u);
                    }
                const unsigned char* vb_ = vl + ((kt - kt0) & 1) * VBUF;
#pragma unroll
                for (int eb = 0; eb < EB; ++eb) {
#pragma unroll
                    for (int kb = 0; kb < 2; ++kb)
#pragma unroll
                        for (int s2 = 0; s2 < 2; ++s2) {
                            const bf16x8 vf = *(const bf16x8*)(vb_ + (eb * 32 + r) * VSTR + (kb * 32 + 16 * s2 + 8 * h) * 2);
                            O[eb] = MFMA(vf, pf[kb][s2], O[eb]);
                        }
                }
                if (more2) ATT_STOREK(kt + 2)
                if (more1) ATT_STOREV(kt + 1)
                __syncthreads();
            };
            ATT_LOADK(kt0) ATT_LOADV(kt0)
            ATT_STOREK(kt0) ATT_STOREV(kt0)
            if (kt0 + 1 < kt1) { ATT_LOADK(kt0 + 1) ATT_STOREK(kt0 + 1) }
            __syncthreads();
            f32x16 sA[2], sB[2];
            s_compute(sA, kt0);
            for (int kt = kt0; kt < kt1; kt += 2) {
                step(sA, sB, kt);
                if (kt + 1 < kt1) step(sB, sA, kt + 1);
            }
#undef ATT_LOADK
#undef ATT_LOADV
#undef ATT_STOREK
#undef ATT_STOREV
            const float inv0 = 1.0f / (lsum + __shfl_xor(lsum, 32));
            bf16_t* op = (MODE == 0) ? a.o + tok * 2048 + qcol0 * 2 + p * 128 : a.o + tok * 1024 + qcol0;
#pragma unroll
            for (int eb = 0; eb < EB; ++eb) {
                u32x2 A[4];
#pragma unroll
                for (int g = 0; g < 4; ++g) { A[g].x = pk_bf16(O[eb][4 * g] * inv0, O[eb][4 * g + 1] * inv0); A[g].y = pk_bf16(O[eb][4 * g + 2] * inv0, O[eb][4 * g + 3] * inv0); }
                store_row32_bf16(op + eb * 32, A, h);
            }
        }
    }
}

DI void diff_combine_phase(const bf16_t* __restrict__ op, const float* __restrict__ lam_params, const float* __restrict__ subln_g, bf16_t* __restrict__ o) {
    const int lane = threadIdx.x & 63, w = threadIdx.x >> 6;
    const int gwave = blockIdx.x * 4 + w, nwave = gridDim.x * 4;
    const float p1 = wave_sum(lam_params[lane] * lam_params[64 + lane]);
    const float p2 = wave_sum(lam_params[128 + lane] * lam_params[192 + lane]);
    const float lam = __expf(p1) - __expf(p2) + LAMBDA_INIT0;
    const int hd = lane >> 3, d0 = 16 * (lane & 7);
    f32x4 gg[4];
#pragma unroll
    for (int i = 0; i < 4; ++i) gg[i] = *(const f32x4*)(subln_g + d0 + 4 * i);
    for (int t = gwave; t < T_TOK; t += nwave) {
        const bf16_t* p0 = op + (size_t)t * 2048 + hd * 256 + d0;
        const u32x4 a0 = *(const u32x4*)p0, a1 = *(const u32x4*)(p0 + 8), b0 = *(const u32x4*)(p0 + 128), b1 = *(const u32x4*)(p0 + 136);
        float v[16];
#pragma unroll
        for (int i = 0; i < 4; ++i) {
            v[2 * i] = bf_lo(a0[i]) - lam * bf_lo(b0[i]); v[2 * i + 1] = bf_hi(a0[i]) - lam * bf_hi(b0[i]);
            v[8 + 2 * i] = bf_lo(a1[i]) - lam * bf_lo(b1[i]); v[8 + 2 * i + 1] = bf_hi(a1[i]) - lam * bf_hi(b1[i]);
        }
        float ss = 0.f;
#pragma unroll
        for (int i = 0; i < 16; ++i) ss += v[i] * v[i];
        ss += __shfl_xor(ss, 1); ss += __shfl_xor(ss, 2); ss += __shfl_xor(ss, 4);
        const float rs = rsqrtf(ss * (1.0f / 128.0f) + LN_EPS) * (1.0f - LAMBDA_INIT0);
        u32x4 w0, w1;
#pragma unroll
        for (int i = 0; i < 4; ++i) {
            const int e = (i & 1) * 2;
            w0[i] = pk_bf16(v[2 * i] * rs * gg[i >> 1][e], v[2 * i + 1] * rs * gg[i >> 1][e + 1]);
            w1[i] = pk_bf16(v[8 + 2 * i] * rs * gg[2 + (i >> 1)][e], v[8 + 2 * i + 1] * rs * gg[2 + (i >> 1)][e + 1]);
        }
        bf16_t* dst = o + (size_t)t * 1024 + hd * 128 + d0;
        *(u32x4*)dst = w0; *(u32x4*)(dst + 8) = w1;
    }
}

DI unsigned f2ord(float f) { const unsigned u = __float_as_uint(f); return (u & 0x80000000u) ? ~u : (u | 0x80000000u); }
DI float ord2f(unsigned o) { const unsigned u = (o & 0x80000000u) ? (o & 0x7fffffffu) : ~o; return __uint_as_float(u); }
__host__ __device__ constexpr int combo_row_start(int a) { int s = 0; for (int i = 0; i < a; ++i) s += 16 / (i + 1); return s; }

constexpr int SORT16[63][2] = {{0,1}, {2,3}, {0,2}, {1,3}, {1,2}, {4,5}, {6,7}, {4,6}, {5,7}, {5,6}, {0,4}, {2,6}, {2,4}, {1,5}, {3,7}, {3,5}, {1,2}, {3,4}, {5,6}, {8,9}, {10,11}, {8,10}, {9,11}, {9,10}, {12,13}, {14,15}, {12,14}, {13,15}, {13,14}, {8,12}, {10,14}, {10,12}, {9,13}, {11,15}, {11,13}, {9,10}, {11,12}, {13,14}, {0,8}, {4,12}, {4,8}, {2,10}, {6,14}, {6,10}, {2,4}, {6,8}, {10,12}, {1,9}, {5,13}, {5,9}, {3,11}, {7,15}, {7,11}, {3,5}, {7,9}, {11,13}, {1,2}, {3,4}, {5,6}, {7,8}, {9,10}, {11,12}, {13,14}};
constexpr int BMERGE16[32][2] = {{0,8}, {1,9}, {2,10}, {3,11}, {4,12}, {5,13}, {6,14}, {7,15}, {0,4}, {1,5}, {2,6}, {3,7}, {8,12}, {9,13}, {10,14}, {11,15}, {0,2}, {1,3}, {4,6}, {5,7}, {8,10}, {9,11}, {12,14}, {13,15}, {0,1}, {2,3}, {4,5}, {6,7}, {8,9}, {10,11}, {12,13}, {14,15}};
DI void cex(unsigned& a, unsigned& b) { const unsigned hi = max(a, b), lo = min(a, b); a = hi; b = lo; }
DI void merge_top16(unsigned (&A)[16], const unsigned (&B)[16]) {
#pragma unroll
    for (int i = 0; i < 16; ++i) A[i] = max(A[i], B[15 - i]);
#pragma unroll
    for (int n = 0; n < 32; ++n) cex(A[BMERGE16[n][0]], A[BMERGE16[n][1]]);
}
DI void peer_topk_phase(const bf16_t* __restrict__ qpk, const bf16_t* __restrict__ subk, int* __restrict__ eidx, float* __restrict__ gout) {
    int tidv = threadIdx.x;
    asm volatile("" : "+v"(tidv));
    const int lane = tidv & 63, w = tidv >> 6, r = lane & 31, h = lane >> 5;
    const int gwave = blockIdx.x * 4 + w, nwave = gridDim.x * 4;
    for (int item_ = gwave; item_ < 2048 * 8 * REP_TOPK; item_ += nwave) {
        const int item = (REP_TOPK == 1) ? item_ : item_ % (2048 * 8);
        const int tt = item >> 3, hh = item & 7, t0 = tt * 32;
        unsigned top[2][16];
#pragma unroll
        for (int c = 0; c < 2; ++c) {
            f32x16 acc[4];
#pragma unroll
            for (int nb = 0; nb < 4; ++nb)
#pragma unroll
                for (int i = 0; i < 16; ++i) acc[nb][i] = 0.f;
            const bf16_t* qp = qpk + (size_t)(t0 + r) * 1024 + hh * 128 + c * 64 + h * 8;
            const bf16_t* kp = subk + ((size_t)(hh * 2 + c) * 128 + r) * 64 + h * 8;
#pragma unroll
            for (int ks = 0; ks < 4; ++ks) {
                const bf16x8 qfr = *(const bf16x8*)(qp + ks * 16);
#pragma unroll
                for (int nb = 0; nb < 4; ++nb) {
                    const bf16x8 kf = *(const bf16x8*)(kp + nb * 32 * 64 + ks * 16);
                    acc[nb] = MFMA(kf, qfr, acc[nb]);
                }
            }
            unsigned key[64];
#pragma unroll
            for (int nb = 0; nb < 4; ++nb)
#pragma unroll
                for (int i = 0; i < 16; ++i) {
                    const int n = nb * 32 + (i & 3) + 8 * (i >> 2) + 4 * h;
                    key[nb * 16 + i] = (f2ord(acc[nb][i]) & ~127u) | (unsigned)(127 - n);
                }
            unsigned g0[16], g1[16], g2[16], g3[16];
#pragma unroll
            for (int i = 0; i < 16; ++i) { g0[i] = key[i]; g1[i] = key[16 + i]; g2[i] = key[32 + i]; g3[i] = key[48 + i]; }
#pragma unroll
            for (int n = 0; n < 63; ++n) { cex(g0[SORT16[n][0]], g0[SORT16[n][1]]); cex(g1[SORT16[n][0]], g1[SORT16[n][1]]); cex(g2[SORT16[n][0]], g2[SORT16[n][1]]); cex(g3[SORT16[n][0]], g3[SORT16[n][1]]); }
            merge_top16(g0, g1); merge_top16(g2, g3); merge_top16(g0, g2);
            unsigned pb[16];
#pragma unroll
            for (int i = 0; i < 16; ++i) pb[i] = (unsigned)__shfl_xor((int)g0[i], 32);
            merge_top16(g0, pb);
#pragma unroll
            for (int i = 0; i < 16; ++i) top[c][i] = g0[i];
        }
        unsigned ck[50];
#pragma unroll
        for (int a = 0; a < 16; ++a)
#pragma unroll
            for (int b = 0; b < 16 / (a + 1); ++b) {
                const float cv = ord2f(top[0][a] & ~127u) + ord2f(top[1][b] & ~127u);
                ck[combo_row_start(a) + b] = (f2ord(cv) & ~255u) | (unsigned)(((15 - a) << 4) | (15 - b));
            }
        unsigned c0[16], c1[16], c2[16], c3[16];
#pragma unroll
        for (int i = 0; i < 16; ++i) { c0[i] = ck[i]; c1[i] = ck[16 + i]; c2[i] = ck[32 + i]; c3[i] = (i < 2) ? ck[48 + i] : 0u; }
#pragma unroll
        for (int n = 0; n < 63; ++n) { cex(c1[SORT16[n][0]], c1[SORT16[n][1]]); cex(c2[SORT16[n][0]], c2[SORT16[n][1]]); }
        merge_top16(c0, c1); merge_top16(c2, c3); merge_top16(c0, c2);
        float sv[16]; int se[16];
#pragma unroll
        for (int rd = 0; rd < 16; ++rd) {
            const unsigned m = c0[rd];
            const int asel = 15 - (int)((m >> 4) & 15u), bsel = 15 - (int)(m & 15u);
            unsigned ka = top[0][0], kb = top[1][0];
#pragma unroll
            for (int i = 1; i < 16; ++i) { ka = (asel == i) ? top[0][i] : ka; kb = (bsel == i) ? top[1][i] : kb; }
            sv[rd] = ord2f(ka & ~127u) + ord2f(kb & ~127u);
            se[rd] = (127 - (int)(ka & 127u)) * 128 + (127 - (int)(kb & 127u));
        }
        float den = 0.f;
        const float mx0 = sv[0];
#pragma unroll
        for (int i = 0; i < 16; ++i) { sv[i] = __expf(sv[i] - mx0); den += sv[i]; }
        const float inv = 1.0f / den;
        const size_t ob = (size_t)(t0 + r) * 128 + hh * 16;
        if (h == 0) {
#pragma unroll
            for (int i = 0; i < 4; ++i) { int4 v = make_int4(se[4 * i], se[4 * i + 1], se[4 * i + 2], se[4 * i + 3]); *(int4*)(eidx + ob + 4 * i) = v; }
        } else {
#pragma unroll
            for (int i = 0; i < 4; ++i) { f32x4 v = {sv[4 * i] * inv, sv[4 * i + 1] * inv, sv[4 * i + 2] * inv, sv[4 * i + 3] * inv}; *(f32x4*)(gout + ob + 4 * i) = v; }
        }
    }
}

DI float gelu_exact(float v) { return 0.5f * v * (1.0f + erff(v * 0.70710678118654752f)); }
DI void convert_rows_fp8(const float* __restrict__ src, unsigned char* __restrict__ dst, float* __restrict__ inv, int nrows) {
    const int lane = threadIdx.x & 63, w = threadIdx.x >> 6;
    const int gwave = blockIdx.x * 4 + w, nwave = gridDim.x * 4;
    for (int row_ = gwave; row_ < nrows * REP_P0; row_ += nwave) {
        const int row = (REP_P0 == 1) ? row_ : row_ % nrows;
        const f32x4* p = (const f32x4*)(src + (size_t)row * DM + 16 * lane);
        f32x4 v[4];
#pragma unroll
        for (int i = 0; i < 4; ++i) v[i] = p[i];
        float am = 0.f;
#pragma unroll
        for (int i = 0; i < 4; ++i) am = fmaxf(am, fmaxf(fmaxf(fabsf(v[i].x), fabsf(v[i].y)), fmaxf(fabsf(v[i].z), fabsf(v[i].w))));
#pragma unroll
        for (int o = 32; o >= 1; o >>= 1) am = fmaxf(am, __shfl_xor(am, o));
        const unsigned eb = (__float_as_uint(am) >> 23) & 0xffu;
        float sc = 1.0f, isc = 1.0f;
        if (eb >= 16u && eb <= 250u) { sc = __uint_as_float((261u - eb) << 23); isc = __uint_as_float((eb - 7u) << 23); }
        u32x4 o;
#pragma unroll
        for (int i = 0; i < 4; ++i) {
            int pk = __builtin_amdgcn_cvt_pk_fp8_f32(v[i].x * sc, v[i].y * sc, 0, false);
            pk = __builtin_amdgcn_cvt_pk_fp8_f32(v[i].z * sc, v[i].w * sc, pk, true);
            o[i] = (unsigned)pk;
        }
        *(u32x4*)(dst + (size_t)row * DM + 16 * lane) = o;
        if (lane == 0) inv[row] = isc;
    }
}
DI float dot16(const unsigned (&a)[8], u32x4 b0, u32x4 b1) {
    float acc;
    asm volatile("v_dot2_f32_bf16 %0, %1, %9, 0\n\tv_dot2_f32_bf16 %0, %2, %10, %0\n\tv_dot2_f32_bf16 %0, %3, %11, %0\n\tv_dot2_f32_bf16 %0, %4, %12, %0\n\t"
                 "v_dot2_f32_bf16 %0, %5, %13, %0\n\tv_dot2_f32_bf16 %0, %6, %14, %0\n\tv_dot2_f32_bf16 %0, %7, %15, %0\n\tv_dot2_f32_bf16 %0, %8, %16, %0\n\ts_nop 2"
                 : "=&v"(acc)
                 : "v"(a[0]), "v"(a[1]), "v"(a[2]), "v"(a[3]), "v"(a[4]), "v"(a[5]), "v"(a[6]), "v"(a[7]),
                   "v"(b0.x), "v"(b0.y), "v"(b0.z), "v"(b0.w), "v"(b1.x), "v"(b1.y), "v"(b1.z), "v"(b1.w));
    return acc;
}
DI float dot_fp8_row(u32x4 u, u32x4 xa, u32x4 xb) {
    unsigned a[8];
#pragma unroll
    for (int j = 0; j < 4; ++j) {
        a[2 * j] = __builtin_bit_cast(unsigned, __builtin_amdgcn_cvt_scalef32_pk_bf16_fp8(u[j], 1.0f, false));
        a[2 * j + 1] = __builtin_bit_cast(unsigned, __builtin_amdgcn_cvt_scalef32_pk_bf16_fp8(u[j], 1.0f, true));
    }
    return dot16(a, xa, xb);
}
DI void axpy_fp8_row(f32x2 (&o)[8], float wgt, u32x4 v) {
    const f32x2 w2 = {wgt, wgt};
#pragma unroll
    for (int j = 0; j < 4; ++j) {
        const f32x2 lo = __builtin_amdgcn_cvt_pk_f32_fp8(v[j], false), hi = __builtin_amdgcn_cvt_pk_f32_fp8(v[j], true);
        o[2 * j] = __builtin_elementwise_fma(w2, lo, o[2 * j]);
        o[2 * j + 1] = __builtin_elementwise_fma(w2, hi, o[2 * j + 1]);
    }
}
struct TokMeta { int e0, e1; float su0, su1, gv0, gv1; u32x4 xa, xb; };
DI TokMeta load_meta(int t, int lane, const bf16_t* __restrict__ x1, const int* __restrict__ eidx, const float* __restrict__ gws, const float* __restrict__ su, const float* __restrict__ sv) {
    TokMeta m;
    m.e0 = eidx[(size_t)t * 128 + lane]; m.e1 = eidx[(size_t)t * 128 + 64 + lane];
    const float g0 = gws[(size_t)t * 128 + lane], g1 = gws[(size_t)t * 128 + 64 + lane];
    m.su0 = su[m.e0]; m.su1 = su[m.e1];
    m.gv0 = g0 * sv[m.e0]; m.gv1 = g1 * sv[m.e1];
    m.xa = *(const u32x4*)(x1 + (size_t)t * DM + 16 * lane); m.xb = *(const u32x4*)(x1 + (size_t)t * DM + 16 * lane + 8);
    return m;
}
DI void gather_issue(u32x4 (&bu)[8], u32x4 (&bv)[8], int ev, int lbase, int lane, const unsigned char* __restrict__ U8, const unsigned char* __restrict__ V8) {
#pragma unroll
    for (int i = 0; i < 8; ++i) {
        const int e = __builtin_amdgcn_readlane(ev, lbase + i);
        bu[i] = *(const u32x4*)(U8 + (size_t)e * DM + 16 * lane);
        bv[i] = *(const u32x4*)(V8 + (size_t)e * DM + 16 * lane);
    }
}
DI void gather_compute(const u32x4 (&bu)[8], const u32x4 (&bv)[8], float suv, float gvv, int lbase, int lane_in, u32x4 xa, u32x4 xb, f32x2 (&out)[8]) {
    int lane = lane_in;
    float d[8];
#pragma unroll
    for (int i = 0; i < 8; ++i) { d[i] = dot_fp8_row(bu[i], xa, xb) * __builtin_bit_cast(float, __builtin_amdgcn_readlane(__builtin_bit_cast(int, suv), lbase + i)); __builtin_amdgcn_sched_barrier(0); }
    float d4[4], d2[2], d1;
    asm volatile("" : "+v"(lane));
    {
        const bool hi = (lane & 32) != 0;
#pragma unroll
        for (int i = 0; i < 4; ++i) { const float keep = hi ? d[i + 4] : d[i], send = hi ? d[i] : d[i + 4]; d4[i] = keep + __shfl_xor(send, 32); }
    }
    {
        const bool hi = (lane & 16) != 0;
#pragma unroll
        for (int i = 0; i < 2; ++i) { const float keep = hi ? d4[i + 2] : d4[i], send = hi ? d4[i] : d4[i + 2]; d2[i] = keep + __shfl_xor(send, 16); }
    }
    {
        const bool hi = (lane & 8) != 0;
        const float keep = hi ? d2[1] : d2[0], send = hi ? d2[0] : d2[1];
        d1 = keep + __shfl_xor(send, 8);
    }
    d1 += __shfl_xor(d1, 4); d1 += __shfl_xor(d1, 2); d1 += __shfl_xor(d1, 1);
    const float hv = gelu_exact(d1);
#pragma unroll
    for (int i = 0; i < 8; ++i) {
        const int src = 8 * (i & 1) + 16 * ((i >> 1) & 1) + 32 * ((i >> 2) & 1);
        const float wi = __builtin_bit_cast(float, __builtin_amdgcn_readlane(__builtin_bit_cast(int, gvv), lbase + i)) *
                         __builtin_bit_cast(float, __builtin_amdgcn_readlane(__builtin_bit_cast(int, hv), src));
        axpy_fp8_row(out, wi, bv[i]);
        __builtin_amdgcn_sched_barrier(0);
    }
}
DI void peer_gather_phase(const bf16_t* __restrict__ x1, const int* __restrict__ eidx, const float* __restrict__ gws, const unsigned char* __restrict__ U8,
                          const unsigned char* __restrict__ V8, const float* __restrict__ su, const float* __restrict__ sv, const float* __restrict__ lng,
                          const float* __restrict__ lnb, bf16_t* __restrict__ xo_bf, float* __restrict__ xo_f32) {
    const int lane = threadIdx.x & 63, w = threadIdx.x >> 6;
    const int gwave = blockIdx.x * 4 + w, nwave = gridDim.x * 4;
    if (gwave < T_TOK) {
        TokMeta cur = load_meta(gwave, lane, x1, eidx, gws, su, sv);
        u32x4 au[8], av[8], bu[8], bv[8];
        gather_issue(au, av, cur.e0, 0, lane, U8, V8);
        for (int t_ = gwave; t_ < T_TOK * REP_GATHER; t_ += nwave) {
            const int t = (REP_GATHER == 1) ? t_ : t_ % T_TOK;
            const bool has_next = t_ + nwave < T_TOK * REP_GATHER;
            TokMeta nxt = cur;
            if (has_next) nxt = load_meta((REP_GATHER == 1) ? t_ + nwave : (t_ + nwave) % T_TOK, lane, x1, eidx, gws, su, sv);
            f32x2 out[8];
#pragma unroll
            for (int i = 0; i < 8; ++i) { out[i].x = 0.f; out[i].y = 0.f; }
            for (int jb = 0; jb < 16; jb += 2) {
                const int ev = (jb < 8) ? cur.e0 : cur.e1;
                const float suv = (jb < 8) ? cur.su0 : cur.su1, gvv = (jb < 8) ? cur.gv0 : cur.gv1;
                const int lbase = (jb & 7) * 8;
                gather_issue(bu, bv, ev, lbase + 8, lane, U8, V8);
                gather_compute(au, av, suv, gvv, lbase, lane, cur.xa, cur.xb, out);
                if (jb + 2 < 16) {
                    const int ev2 = (jb + 2 < 8) ? cur.e0 : cur.e1;
                    gather_issue(au, av, ev2, ((jb + 2) & 7) * 8, lane, U8, V8);
                } else if (has_next) {
                    gather_issue(au, av, nxt.e0, 0, lane, U8, V8);
                }
                gather_compute(bu, bv, suv, gvv, lbase + 8, lane, cur.xa, cur.xb, out);
            }
            float y[16];
            {
                const u32x4 xa = cur.xa, xb = cur.xb;
                y[0] = bf_lo(xa.x); y[1] = bf_hi(xa.x); y[2] = bf_lo(xa.y); y[3] = bf_hi(xa.y); y[4] = bf_lo(xa.z); y[5] = bf_hi(xa.z); y[6] = bf_lo(xa.w); y[7] = bf_hi(xa.w);
                y[8] = bf_lo(xb.x); y[9] = bf_hi(xb.x); y[10] = bf_lo(xb.y); y[11] = bf_hi(xb.y); y[12] = bf_lo(xb.z); y[13] = bf_hi(xb.z); y[14] = bf_lo(xb.w); y[15] = bf_hi(xb.w);
            }
            float s = 0.f;
#pragma unroll
            for (int i = 0; i < 8; ++i) { y[2 * i] = DN_ALPHA * y[2 * i] + out[i].x; y[2 * i + 1] = DN_ALPHA * y[2 * i + 1] + out[i].y; s += y[2 * i] + y[2 * i + 1]; }
            const float mu = wave_sum(s) * (1.0f / DM);
            float qq = 0.f;
#pragma unroll
            for (int i = 0; i < 16; ++i) { const float dd = y[i] - mu; qq += dd * dd; }
            const float rstd = rsqrtf(wave_sum(qq) * (1.0f / DM) + LN_EPS);
            const int col = 16 * lane;
            f32x4 o4[4];
#pragma unroll
            for (int q4 = 0; q4 < 4; ++q4) {
                const f32x4 ga = *(const f32x4*)(lng + col + 4 * q4), ba = *(const f32x4*)(lnb + col + 4 * q4);
#pragma unroll
                for (int e = 0; e < 4; ++e) o4[q4][e] = (y[4 * q4 + e] - mu) * rstd * ga[e] + ba[e];
            }
            if (xo_f32) {
#pragma unroll
                for (int q4 = 0; q4 < 4; ++q4) *(f32x4*)(xo_f32 + (size_t)t * DM + col + 4 * q4) = o4[q4];
            }
            if (xo_bf) {
                u32x4 w0 = {pk_bf16(o4[0].x, o4[0].y), pk_bf16(o4[0].z, o4[0].w), pk_bf16(o4[1].x, o4[1].y), pk_bf16(o4[1].z, o4[1].w)};
                u32x4 w1 = {pk_bf16(o4[2].x, o4[2].y), pk_bf16(o4[2].z, o4[2].w), pk_bf16(o4[3].x, o4[3].y), pk_bf16(o4[3].z, o4[3].w)};
                *(u32x4*)(xo_bf + (size_t)t * DM + col) = w0; *(u32x4*)(xo_bf + (size_t)t * DM + col + 8) = w1;
            }
            cur = nxt;
        }
    }
}

struct SliceMap { int j0, jstep, wslot, nslot; };
DI SliceMap slice_map(int w) {
    SliceMap m; const int G = gridDim.x;
    if (G >= 8) { m.j0 = blockIdx.x & 7; m.jstep = 8; m.wslot = (blockIdx.x >> 3) * 4 + w; m.nslot = ((G - m.j0 + 7) >> 3) * 4; }
    else { m.j0 = 0; m.jstep = 1; m.wslot = blockIdx.x * 4 + w; m.nslot = G * 4; }
    return m;
}
DI void peer_u_phase(const bf16_t* __restrict__ x1, const int* __restrict__ eidx, const unsigned char* __restrict__ U8, float* __restrict__ ph) {
    int tidv = threadIdx.x;
    asm volatile("" : "+v"(tidv));
    const int lane = tidv & 63, w = tidv >> 6, grp = lane >> 3, l8 = lane & 7;
    const SliceMap sm = slice_map(w);
    for (int j_ = sm.j0; j_ < 8 * REP_PU; j_ += sm.jstep) {
        const int j = j_ & 7;
        const unsigned char* ub = U8 + 128 * j + 16 * l8;
        const bf16_t* xb_ = x1 + 128 * j + 16 * l8;
        float* pj = ph + (size_t)j * T_TOK * 128;
        const int step = sm.nslot;
        int t = sm.wslot;
        if (t >= T_TOK) continue;
        u32x4 sa[16], sb[16];
        int e0n = 0, e1n = 0;
        u32x4 xa, xb, xan, xbn;
#define U_ISSUE(SEG, E0, E1) { _Pragma("unroll") for (int b = 0; b < 16; ++b) { const int e = __shfl((b < 8) ? (E0) : (E1), (b & 7) * 8 + grp); SEG[b] = *(const u32x4*)(ub + (size_t)e * DM); } }
#define U_COMPUTE(SEG, TT) { float hsum[2]; \
            _Pragma("unroll") for (int hf = 0; hf < 2; ++hf) { float d[8]; \
                _Pragma("unroll") for (int i = 0; i < 8; ++i) { d[i] = dot_fp8_row(SEG[hf * 8 + i], xa, xb); } \
                float d4[4], d2[2]; \
                { const bool hi = (l8 & 4) != 0; _Pragma("unroll") for (int i = 0; i < 4; ++i) { const float keep = hi ? d[i + 4] : d[i], send = hi ? d[i] : d[i + 4]; d4[i] = keep + __shfl_xor(send, 4); } } \
                { const bool hi = (l8 & 2) != 0; _Pragma("unroll") for (int i = 0; i < 2; ++i) { const float keep = hi ? d4[i + 2] : d4[i], send = hi ? d4[i] : d4[i + 2]; d2[i] = keep + __shfl_xor(send, 2); } } \
                { const bool hi = (l8 & 1) != 0; const float keep = hi ? d2[1] : d2[0], send = hi ? d2[0] : d2[1]; hsum[hf] = keep + __shfl_xor(send, 1); } } \
            pj[(size_t)(TT) * 128 + 8 * l8 + grp] = hsum[0]; pj[(size_t)(TT) * 128 + 64 + 8 * l8 + grp] = hsum[1]; }
        {
            const int e0 = eidx[(size_t)t * 128 + lane], e1 = eidx[(size_t)t * 128 + 64 + lane];
            xa = *(const u32x4*)(xb_ + (size_t)t * DM); xb = *(const u32x4*)(xb_ + (size_t)t * DM + 8);
            U_ISSUE(sa, e0, e1)
            if (t + step < T_TOK) { e0n = eidx[(size_t)(t + step) * 128 + lane]; e1n = eidx[(size_t)(t + step) * 128 + 64 + lane]; }
        }
        for (; t < T_TOK; t += 2 * step) {
            int e0nn = 0, e1nn = 0;
            const bool n1 = t + step < T_TOK, n2 = t + 2 * step < T_TOK, n3 = t + 3 * step < T_TOK;
            if (n1) { U_ISSUE(sb, e0n, e1n) xan = *(const u32x4*)(xb_ + (size_t)(t + step) * DM); xbn = *(const u32x4*)(xb_ + (size_t)(t + step) * DM + 8); }
            if (n2) { e0nn = eidx[(size_t)(t + 2 * step) * 128 + lane]; e1nn = eidx[(size_t)(t + 2 * step) * 128 + 64 + lane]; }
            U_COMPUTE(sa, t)
            if (n1) {
                xa = xan; xb = xbn;
                if (n2) { U_ISSUE(sa, e0nn, e1nn) xan = *(const u32x4*)(xb_ + (size_t)(t + 2 * step) * DM); xbn = *(const u32x4*)(xb_ + (size_t)(t + 2 * step) * DM + 8); }
                if (n3) { e0n = eidx[(size_t)(t + 3 * step) * 128 + lane]; e1n = eidx[(size_t)(t + 3 * step) * 128 + 64 + lane]; }
                U_COMPUTE(sb, t + step)
                xa = xan; xb = xbn;
            }
        }
#undef U_ISSUE
#undef U_COMPUTE
    }
}
DI void peer_hw_phase(const float* __restrict__ ph, const int* __restrict__ eidx, const float* __restrict__ su, const float* __restrict__ sv, float* __restrict__ gws) {
    const size_t n = (size_t)T_TOK * 128, nthreads = (size_t)gridDim.x * blockDim.x;
    for (size_t i = (size_t)blockIdx.x * blockDim.x + threadIdx.x; i < n; i += nthreads) {
        float hsum = 0.f;
#pragma unroll
        for (int j = 0; j < 8; ++j) hsum += ph[(size_t)j * n + i];
        const int e = eidx[i];
        gws[i] = gws[i] * gelu_exact(hsum * su[e]) * sv[e];
    }
}
DI void peer_v_phase(const bf16_t* __restrict__ x1, const int* __restrict__ eidx, const float* __restrict__ wgt, const unsigned char* __restrict__ V8, bf16_t* __restrict__ y) {
    int tidv = threadIdx.x;
    asm volatile("" : "+v"(tidv));
    const int lane = tidv & 63, w = tidv >> 6, grp = lane >> 3, l8 = lane & 7;
    const SliceMap sm = slice_map(w);
    for (int j_ = sm.j0; j_ < 8 * REP_PV; j_ += sm.jstep) {
        const int j = j_ & 7;
        const unsigned char* vb = V8 + 128 * j + 16 * l8;
        const int col = 128 * j + 16 * l8 + 2 * grp;
        const int step = sm.nslot;
        int t = sm.wslot;
        if (t >= T_TOK) continue;
        u32x4 sa[16], sb[16];
        int e0n = 0, e1n = 0;
        float w0, w1, w0n = 0.f, w1n = 0.f;
#define V_ISSUE(SEG, E0, E1) { _Pragma("unroll") for (int b = 0; b < 16; ++b) { const int e = __shfl((b < 8) ? (E0) : (E1), (b & 7) * 8 + grp); SEG[b] = *(const u32x4*)(vb + (size_t)e * DM); } }
#define V_COMPUTE(SEG, TT) { f32x2 acc[8]; \
            _Pragma("unroll") for (int i = 0; i < 8; ++i) { acc[i].x = 0.f; acc[i].y = 0.f; } \
            _Pragma("unroll") for (int b = 0; b < 16; ++b) { const float wv = __shfl((b < 8) ? w0 : w1, (b & 7) * 8 + grp); axpy_fp8_row(acc, wv, SEG[b]); } \
            float a8[8], a4[4], a2[2]; \
            { const bool hi = (lane & 32) != 0; _Pragma("unroll") for (int i = 0; i < 8; ++i) { const float lo_ = (i & 1) ? acc[i >> 1].y : acc[i >> 1].x, hi_ = (i & 1) ? acc[4 + (i >> 1)].y : acc[4 + (i >> 1)].x; \
                const float keep = hi ? hi_ : lo_, send = hi ? lo_ : hi_; a8[i] = keep + __shfl_xor(send, 32); } } \
            { const bool hi = (lane & 16) != 0; _Pragma("unroll") for (int i = 0; i < 4; ++i) { const float keep = hi ? a8[i + 4] : a8[i], send = hi ? a8[i] : a8[i + 4]; a4[i] = keep + __shfl_xor(send, 16); } } \
            { const bool hi = (lane & 8) != 0; _Pragma("unroll") for (int i = 0; i < 2; ++i) { const float keep = hi ? a4[i + 2] : a4[i], send = hi ? a4[i] : a4[i + 2]; a2[i] = keep + __shfl_xor(send, 8); } } \
            const unsigned xr = *(const unsigned*)(x1 + (size_t)(TT) * DM + col); \
            *(unsigned*)(y + (size_t)(TT) * DM + col) = pk_bf16(DN_ALPHA * bf_lo(xr) + a2[0], DN_ALPHA * bf_hi(xr) + a2[1]); }
        {
            const int e0 = eidx[(size_t)t * 128 + lane], e1 = eidx[(size_t)t * 128 + 64 + lane];
            w0 = wgt[(size_t)t * 128 + lane]; w1 = wgt[(size_t)t * 128 + 64 + lane];
            V_ISSUE(sa, e0, e1)
            if (t + step < T_TOK) { e0n = eidx[(size_t)(t + step) * 128 + lane]; e1n = eidx[(size_t)(t + step) * 128 + 64 + lane]; }
        }
        for (; t < T_TOK; t += 2 * step) {
            int e0nn = 0, e1nn = 0;
            const bool n1 = t + step < T_TOK, n2 = t + 2 * step < T_TOK, n3 = t + 3 * step < T_TOK;
            if (n1) { V_ISSUE(sb, e0n, e1n) w0n = wgt[(size_t)(t + step) * 128 + lane]; w1n = wgt[(size_t)(t + step) * 128 + 64 + lane]; }
            if (n2) { e0nn = eidx[(size_t)(t + 2 * step) * 128 + lane]; e1nn = eidx[(size_t)(t + 2 * step) * 128 + 64 + lane]; }
            V_COMPUTE(sa, t)
            if (n1) {
                w0 = w0n; w1 = w1n;
                if (n2) { V_ISSUE(sa, e0nn, e1nn) w0n = wgt[(size_t)(t + 2 * step) * 128 + lane]; w1n = wgt[(size_t)(t + 2 * step) * 128 + 64 + lane]; }
                if (n3) { e0n = eidx[(size_t)(t + 3 * step) * 128 + lane]; e1n = eidx[(size_t)(t + 3 * step) * 128 + 64 + lane]; }
                V_COMPUTE(sb, t + step)
                w0 = w0n; w1 = w1n;
            }
        }
#undef V_ISSUE
#undef V_COMPUTE
    }
}

#define XB_TMO      128
#define XB_XCNT(j)  (256  + 64 * (j))
#define XB_XSUB(j)  (1280 + 64 * (j))
#define XB_XGEN(j)  (2304 + 64 * (j))
#define XB_TOP      3328
#define XB_TOPGEN   3392
#define XCD_BAR_WORDS 3456
#define XB_SPIN_CAP (1u << 22)
#define LAS __attribute__((address_space(3)))

__device__ __forceinline__ unsigned xb_ld(unsigned* p)              { return __hip_atomic_load(p, __ATOMIC_RELAXED, __HIP_MEMORY_SCOPE_AGENT); }
__device__ __forceinline__ unsigned xb_add(unsigned* p, unsigned v) { return __hip_atomic_fetch_add(p, v, __ATOMIC_RELAXED, __HIP_MEMORY_SCOPE_AGENT); }
__device__ __forceinline__ unsigned xb_xcc_id() { return (unsigned)__builtin_amdgcn_s_getreg((3 << 11) | 20) & 0xFu; }
#define XB_SPIN(cond, bar) do { unsigned _sp = 0; while (cond) { __builtin_amdgcn_s_sleep(1); \
    if ((++_sp & 255u) == 0u) { if (xb_ld(&(bar)[XB_TMO])) break; if (_sp > XB_SPIN_CAP) { atomicAdd(&(bar)[XB_TMO], 1u); break; } } } } while (0)

struct XcdBarrier {
    unsigned* bar; unsigned x;
    volatile LAS unsigned* st;
};

__device__ __forceinline__ XcdBarrier xcd_barrier_post(unsigned* bar, volatile LAS unsigned* st) {
    XcdBarrier b; b.bar = bar; b.x = xb_xcc_id(); b.st = st;
    if (threadIdx.x == 0) (void)xb_add(&bar[XB_XCNT(b.x)], 1u);
    return b;
}
__device__ __forceinline__ void xcd_barrier_complete(unsigned* bar, unsigned x, unsigned& nloc, unsigned& nx) {
    const unsigned G = gridDim.x * gridDim.y * gridDim.z;
    unsigned sum, cnt, mine, sp = 0u;
    for (;;) {
        sum = 0u; cnt = 0u; mine = 0u;
#pragma unroll
        for (unsigned j = 0; j < 16; ++j) { const unsigned c = xb_ld(&bar[XB_XCNT(j)]); sum += c; cnt += (c > 0u) ? 1u : 0u; mine = (j == x) ? c : mine; }
        if (sum == G) break;
        __builtin_amdgcn_s_sleep(1);
        if ((++sp & 255u) == 0u) { if (xb_ld(&bar[XB_TMO])) break; if (sp > XB_SPIN_CAP) { atomicAdd(&bar[XB_TMO], 1u); break; } }
    }
    nloc = mine > 0u ? mine : 1u; nx = cnt > 0u ? cnt : 1u;
}

__device__ __forceinline__ void xcd_barrier(const XcdBarrier& b) {
    asm volatile("s_waitcnt vmcnt(0)" ::: "memory");
    __syncthreads();
    if (threadIdx.x == 0) {
        unsigned* bar = b.bar;
        __builtin_amdgcn_s_waitcnt(0);
        unsigned nloc = b.st[0], nx = b.st[1];
        if (nloc == 0u) { xcd_barrier_complete(bar, b.x, nloc, nx); b.st[0] = nloc; b.st[1] = nx; }
        const unsigned old = xb_add(&bar[XB_XSUB(b.x)], 1u);
        const unsigned gen = old / nloc;
        if (old + 1u == (gen + 1u) * nloc) {
            __builtin_amdgcn_fence(__ATOMIC_RELEASE, "agent");
            asm volatile("s_waitcnt vmcnt(0)" ::: "memory");
            const unsigned og = xb_add(&bar[XB_TOP], 1u);
            const unsigned tg = og / nx;
            if (og + 1u == (tg + 1u) * nx) xb_add(&bar[XB_TOPGEN], 1u);
            else XB_SPIN(xb_ld(&bar[XB_TOPGEN]) == tg, bar);
            __builtin_amdgcn_fence(__ATOMIC_ACQUIRE, "agent");
            xb_add(&bar[XB_XGEN(b.x)], 1u);
            asm volatile("s_waitcnt vmcnt(0)" ::: "memory");
        } else {
            XB_SPIN(xb_ld(&bar[XB_XGEN(b.x)]) == gen, bar);
            __builtin_amdgcn_fence(__ATOMIC_ACQUIRE, "agent");
            asm volatile("s_waitcnt vmcnt(0)" ::: "memory");
        }
    }
    __syncthreads();
}


DI void gsync(cg::grid_group& g) {
    asm volatile("s_waitcnt vmcnt(0) lgkmcnt(0)" ::: "memory");
    g.sync();
    if (threadIdx.x == 0) { __builtin_amdgcn_fence(__ATOMIC_ACQUIRE, "agent"); asm volatile("s_waitcnt vmcnt(0)" ::: "memory"); }
    __syncthreads();
}

__global__ void __launch_bounds__(256, 2) mega_fwd(Params P) {
    extern __shared__ __attribute__((aligned(16))) unsigned char lds[];
    cg::grid_group grid = cg::this_grid();
    volatile LAS unsigned* xb_st = (volatile LAS unsigned*)(lds + LDS_PHASE_BYTES);
    if (threadIdx.x == 0) { xb_st[0] = 0u; xb_st[1] = 0u; }
    __syncthreads();
    const XcdBarrier xbar = xcd_barrier_post((unsigned*)(P.ws + W_BAR), xb_st);
    unsigned char* ws = P.ws;
    bf16_t* r0 = (bf16_t*)(ws + R0);
    bf16_t* r1 = (bf16_t*)(ws + R1);
    bf16_t* r2 = (bf16_t*)(ws + R2);
    bf16_t* r3 = (bf16_t*)(ws + R3);
    int* eidx = (int*)(ws + R4);
    float* gws = (float*)(ws + R4 + 32 * MBy);
    unsigned char* U8 = ws + R5;
    unsigned char* V8 = ws + R5 + 32 * MBy;
    float* su = (float*)(ws + W_SCALE);
    float* sv = su + 2 * 16384;
    bf16_t* w_daqkv = (bf16_t*)(ws + W_DAQKV);
    bf16_t* w_dawo = (bf16_t*)(ws + W_DAWO);
    bf16_t* w_swqkv = (bf16_t*)(ws + W_SWQKV);
    bf16_t* w_swwo = (bf16_t*)(ws + W_SWWO);
    bf16_t* w_pkq0 = (bf16_t*)(ws + W_PKQ0);
    bf16_t* w_pkq1 = (bf16_t*)(ws + W_PKQ1);
    bf16_t* subk = (bf16_t*)(ws + W_SUBK);
    f32x2* rope = (f32x2*)(ws + W_ROPE);
    float* yf = (float*)(ws + R0);
    bf16_t* yb = (bf16_t*)(ws + R0);
    constexpr size_t TD = (size_t)T_TOK * DM;
    constexpr size_t NE = (size_t)16384 * DM;

    convert_flat(P.x, r1, TD);
    convert_rows_fp8(P.pk_u, U8, su, 2 * 16384);
    convert_rows_fp8(P.pk_v, V8, sv, 2 * 16384);
    convert_flat(P.pk_sub_keys, subk, (size_t)2 * 8 * 2 * 128 * 64);
    transpose_convert(P.da_w_qkv, w_daqkv, 3072, (float*)lds);
    transpose_convert(P.da_w_o, w_dawo, 1024, (float*)lds);
    transpose_convert(P.sw_w_qkv, w_swqkv, 1280, (float*)lds);
    transpose_convert(P.sw_w_o, w_swwo, 1024, (float*)lds);
    transpose_convert(P.pk_w_query, w_pkq0, 1024, (float*)lds);
    transpose_convert(P.pk_w_query + (size_t)1024 * 1024, w_pkq1, 1024, (float*)lds);
    rope_table(rope);
    gsync(grid);

    {
        bf16_t* q = r0; bf16_t* k = r0 + TD; bf16_t* vt = r0 + 2 * TD;
        EpiQKV e{q, k, vt, rope, nullptr, 1024, 1024, 7, 8};
        gemm_phase(r1, w_daqkv, T_TOK, 3072, 1024, lds, e);
        xcd_barrier(xbar);
        AttnArgs a{q, k, vt, r2, P.da_lambda, P.da_subln_g, nullptr, nullptr};
        attn_phase<0>(a, lds);
        xcd_barrier(xbar);
        diff_combine_phase(r2, P.da_lambda, P.da_subln_g, r1);
        xcd_barrier(xbar);
        EpiRes<true> er{(const void*)P.x, nullptr, yb};
        gemm_phase(r1, w_dawo, T_TOK, 1024, 1024, lds, er);
        xcd_barrier(xbar);
        ln_phase(yb, P.ln1_g, P.ln1_b, r2);
        xcd_barrier(xbar);
        EpiBf16 eq{r3};
        gemm_phase(r2, w_pkq0, T_TOK, 1024, 1024, lds, eq);
        xcd_barrier(xbar);
        peer_topk_phase(r3, subk, eidx, gws);
        xcd_barrier(xbar);
        peer_u_phase(r2, eidx, U8, yf);
        xcd_barrier(xbar);
        peer_hw_phase(yf, eidx, su, sv, gws);
        xcd_barrier(xbar);
        peer_v_phase(r2, eidx, gws, V8, yb);
        xcd_barrier(xbar);
        ln_phase(yb, P.ln2_g, P.ln2_b, r1);
        xcd_barrier(xbar);
    }
    {
        bf16_t* q = r0; bf16_t* k = r0 + TD; bf16_t* vt = k + (size_t)T_TOK * 128;
        EpiQKV e{q, k, vt, rope, P.sw_b_qkv, 1024, 128, 6, 2};
        gemm_phase(r1, w_swqkv, T_TOK, 1280, 1024, lds, e);
        xcd_barrier(xbar);
        AttnArgs a{q, k, vt, r2, nullptr, nullptr, P.sw_sinks, nullptr};
        attn_phase<1>(a, lds);
        xcd_barrier(xbar);
        EpiRes<false> er{(const void*)r1, P.sw_b_o, yb};
        gemm_phase(r2, w_swwo, T_TOK, 1024, 1024, lds, er);
        xcd_barrier(xbar);
        ln_phase(yb, P.ln1_g + DM, P.ln1_b + DM, r3);
        xcd_barrier(xbar);
        EpiBf16 eq{r2};
        gemm_phase(r3, w_pkq1, T_TOK, 1024, 1024, lds, eq);
        xcd_barrier(xbar);
        peer_topk_phase(r2, subk + (size_t)8 * 2 * 128 * 64, eidx, gws);
        xcd_barrier(xbar);
        peer_u_phase(r3, eidx, U8 + NE, yf);
        xcd_barrier(xbar);
        peer_hw_phase(yf, eidx, su + 16384, sv + 16384, gws);
        xcd_barrier(xbar);
        peer_v_phase(r3, eidx, gws, V8 + NE, yb);
        xcd_barrier(xbar);
        ln_phase(yb, P.ln2_g + DM, P.ln2_b + DM, nullptr, P.out);
    }
}

extern "C" void kernel_launch(void* const* d_in, const int* in_sizes, int n_in, void* d_out, int out_size, void* d_ws, size_t ws_size, hipStream_t stream) {
    static int grid_blocks = 0;
    if (grid_blocks == 0) {
        if (n_in != 18 || ws_size < WS_END) { fprintf(stderr, "kernel_launch: unexpected n_in %d or ws_size %zu (< %zu)\n", n_in, ws_size, (size_t)WS_END); grid_blocks = -1; return; }
        int dev = 0, cus = 0, per_cu = 0;
        hipGetDevice(&dev);
        hipDeviceGetAttribute(&cus, hipDeviceAttributeMultiprocessorCount, dev);
        if (hipFuncSetAttribute((const void*)mega_fwd, hipFuncAttributeMaxDynamicSharedMemorySize, LDS_BYTES) != hipSuccess) { fprintf(stderr, "kernel_launch: hipFuncSetAttribute failed\n"); grid_blocks = -1; return; }
        if (hipOccupancyMaxActiveBlocksPerMultiprocessor(&per_cu, (const void*)mega_fwd, 256, LDS_BYTES) != hipSuccess || per_cu < 1) { fprintf(stderr, "kernel_launch: occupancy query failed (%d)\n", per_cu); per_cu = 1; (void)hipGetLastError(); }
        grid_blocks = cus * per_cu;
        fprintf(stderr, "kernel_launch: grid %d (%d CUs x %d)\n", grid_blocks, cus, per_cu);
    }
    if (grid_blocks < 0) return;
    Params p{};
    p.x = (const float*)d_in[0]; p.da_w_qkv = (const float*)d_in[1]; p.da_lambda = (const float*)d_in[2]; p.da_subln_g = (const float*)d_in[3]; p.da_w_o = (const float*)d_in[4];
    p.sw_w_qkv = (const float*)d_in[5]; p.sw_b_qkv = (const float*)d_in[6]; p.sw_sinks = (const float*)d_in[7]; p.sw_w_o = (const float*)d_in[8]; p.sw_b_o = (const float*)d_in[9];
    p.pk_w_query = (const float*)d_in[10]; p.pk_sub_keys = (const float*)d_in[11]; p.pk_u = (const float*)d_in[12]; p.pk_v = (const float*)d_in[13];
    p.ln1_g = (const float*)d_in[14]; p.ln1_b = (const float*)d_in[15]; p.ln2_g = (const float*)d_in[16]; p.ln2_b = (const float*)d_in[17];
    p.out = (float*)d_out; p.ws = (unsigned char*)d_ws;
    if (hipMemsetAsync((unsigned char*)d_ws + W_BAR, 0, XCD_BAR_WORDS * sizeof(unsigned), stream) != hipSuccess) { fprintf(stderr, "kernel_launch: hipMemsetAsync failed\n"); return; }
    void* args[] = {&p};
    hipError_t e = hipLaunchCooperativeKernel((const void*)mega_fwd, dim3(grid_blocks), dim3(256), args, LDS_BYTES, stream);
    if (e != hipSuccess) fprintf(stderr, "cooperative launch failed: %s (grid %d)\n", hipGetErrorString(e), grid_blocks);
}
```

```cpp
#include <hip/hip_runtime.h>
#include <hip/hip_cooperative_groups.h>
#include <cstdio>
#include <cstdint>
namespace cg = cooperative_groups;

#define DI __device__ __forceinline__
typedef unsigned short bf16_t;
typedef short bf16x8 __attribute__((ext_vector_type(8)));
typedef float f32x16 __attribute__((ext_vector_type(16)));
typedef float f32x4 __attribute__((ext_vector_type(4)));
typedef float f32x2 __attribute__((ext_vector_type(2)));
typedef unsigned u32x4 __attribute__((ext_vector_type(4)));
typedef unsigned u32x2 __attribute__((ext_vector_type(2)));
typedef __bf16 bf16x2_t __attribute__((ext_vector_type(2)));
#define MFMA(a, b, c) __builtin_amdgcn_mfma_f32_32x32x16_bf16((a), (b), (c), 0, 0, 0)

constexpr int T_TOK = 65536, DM = 1024, SEQ = 8192;
constexpr float DN_ALPHA = 1.41421356237309515f;
constexpr float LN_EPS = 1e-5f;
constexpr float LOG2E = 1.44269504088896341f;
constexpr float LAMBDA_INIT0 = 0.2f;

constexpr size_t MBy = 1u << 20;
constexpr size_t R0 = 0, R1 = 384 * MBy, R2 = 512 * MBy, R3 = 640 * MBy, R4 = 768 * MBy, R5 = 832 * MBy, R6 = 960 * MBy;
constexpr size_t W_DAQKV = R6, W_DAWO = R6 + 6 * MBy, W_SWQKV = R6 + 8 * MBy, W_SWWO = R6 + 11 * MBy, W_PKQ0 = R6 + 13 * MBy, W_PKQ1 = R6 + 15 * MBy,
                 W_SUBK = R6 + 17 * MBy, W_ROPE = R6 + 18 * MBy, W_SCALE = R6 + 20 * MBy, W_BAR = R6 + 21 * MBy, WS_END = R6 + 22 * MBy;
constexpr int LDS_PHASE_BYTES = 73728, LDS_BYTES = LDS_PHASE_BYTES + 16;
#ifndef REP_GEMM
#define REP_GEMM 1
#endif
#ifndef REP_ATT0
#define REP_ATT0 1
#endif
#ifndef REP_ATT1
#define REP_ATT1 1
#endif
#ifndef REP_TOPK
#define REP_TOPK 1
#endif
#ifndef REP_GATHER
#define REP_GATHER 1
#endif
#ifndef REP_P0
#define REP_P0 1
#endif
#ifndef REP_PU
#define REP_PU 1
#endif
#ifndef REP_PV
#define REP_PV 1
#endif

__constant__ float c_inv_freq[32] = {
    1.000000000e+00f, 7.498942018e-01f, 5.623413324e-01f, 4.216965139e-01f, 3.162277639e-01f, 2.371373922e-01f, 1.778279394e-01f, 1.333521456e-01f,
    1.000000015e-01f, 7.498941571e-02f, 5.623412877e-02f, 4.216964915e-02f, 3.162277862e-02f, 2.371373586e-02f, 1.778279431e-02f, 1.333521493e-02f,
    9.999999776e-03f, 7.498942316e-03f, 5.623413250e-03f, 4.216964822e-03f, 3.162277862e-03f, 2.371373819e-03f, 1.778279431e-03f, 1.333521446e-03f,
    1.000000047e-03f, 7.498941850e-04f, 5.623413017e-04f, 4.216965463e-04f, 3.162277862e-04f, 2.371373848e-04f, 1.778279402e-04f, 1.333521504e-04f};

struct Params {
    const float* x; const float* da_w_qkv; const float* da_lambda; const float* da_subln_g; const float* da_w_o;
    const float* sw_w_qkv; const float* sw_b_qkv; const float* sw_sinks; const float* sw_w_o; const float* sw_b_o;
    const float* pk_w_query; const float* pk_sub_keys; const float* pk_u; const float* pk_v;
    const float* ln1_g; const float* ln1_b; const float* ln2_g; const float* ln2_b;
    float* out; unsigned char* ws;
};

DI unsigned pk_bf16(float a, float b) { f32x2 f = {a, b}; return __builtin_bit_cast(unsigned, __builtin_convertvector(f, bf16x2_t)); }
DI bf16_t to_bf16(float a) { return (bf16_t)(pk_bf16(a, a) & 0xffffu); }
DI float bf_lo(unsigned u) { return __uint_as_float(u << 16); }
DI float bf_hi(unsigned u) { return __uint_as_float(u & 0xffff0000u); }
DI float wave_sum(float v) {
#pragma unroll
    for (int o = 32; o >= 1; o >>= 1) v += __shfl_xor(v, o);
    return v;
}

DI void convert_flat(const float* __restrict__ src, bf16_t* __restrict__ dst, size_t n) {
    const size_t nthreads = (size_t)gridDim.x * blockDim.x;
    for (size_t i_ = (size_t)blockIdx.x * blockDim.x + threadIdx.x; i_ < (n / 8) * REP_P0; i_ += nthreads) {
        const size_t i = (REP_P0 == 1) ? i_ : i_ % (n / 8);
        const f32x4 a = ((const f32x4*)src)[2 * i], b = ((const f32x4*)src)[2 * i + 1];
        u32x4 o; o.x = pk_bf16(a.x, a.y); o.y = pk_bf16(a.z, a.w); o.z = pk_bf16(b.x, b.y); o.w = pk_bf16(b.z, b.w);
        ((u32x4*)dst)[i] = o;
    }
}
DI void transpose_convert(const float* __restrict__ src, bf16_t* __restrict__ dst, int N, float* ldsf) {
    const int tilesN = N >> 6, ntiles = 16 * tilesN;
    const int tx = threadIdx.x & 63, ty = threadIdx.x >> 6;
    for (int tile = blockIdx.x; tile < ntiles; tile += gridDim.x) {
        const int tk = tile / tilesN, tn = tile - tk * tilesN;
        __syncthreads();
#pragma unroll
        for (int i = 0; i < 16; ++i) { const int k = ty + 4 * i; ldsf[k * 65 + tx] = src[(size_t)(tk * 64 + k) * N + tn * 64 + tx]; }
        __syncthreads();
#pragma unroll
        for (int i = 0; i < 16; ++i) { const int n = ty + 4 * i; dst[(size_t)(tn * 64 + n) * 1024 + tk * 64 + tx] = to_bf16(ldsf[tx * 65 + n]); }
    }
}
DI void rope_table(f32x2* rope) {
    const int nthreads = gridDim.x * blockDim.x;
    for (int i = blockIdx.x * blockDim.x + threadIdx.x; i < SEQ * 32; i += nthreads) {
        const int pos = i >> 5, j = i & 31;
        const float ang = (float)pos * c_inv_freq[j];
        const float kf = rintf(ang * 0.636619772367581343f);
        float rr = fmaf(-kf, 1.57079637050628662109375f, ang);
        rr = fmaf(-kf, -4.37113882867379294e-8f, rr);
        const float r2 = rr * rr;
        const float sn = rr + rr * r2 * (-1.6666654611e-1f + r2 * (8.3321608736e-3f + r2 * (-1.9515295891e-4f)));
        const float cs = 1.0f - 0.5f * r2 + r2 * r2 * (4.166664568298827e-2f + r2 * (-1.388731625493765e-3f + r2 * 2.443315711809948e-5f));
        const int q = ((int)kf) & 3;
        float c, s;
        if (q == 0) { c = cs; s = sn; } else if (q == 1) { c = -sn; s = cs; } else if (q == 2) { c = -cs; s = -sn; } else { c = sn; s = -cs; }
        f32x2 o = {c, s};
        rope[i] = o;
    }
}

DI void store_row32_bf16(bf16_t* rowp, const u32x2 (&A)[4], int h) {
#pragma unroll
    for (int gp = 0; gp < 2; ++gp) {
        const auto r0 = __builtin_amdgcn_permlane32_swap(A[2 * gp].x, A[2 * gp + 1].x, false, false);
        const auto r1 = __builtin_amdgcn_permlane32_swap(A[2 * gp].y, A[2 * gp + 1].y, false, false);
        u32x4 wv = {(unsigned)r0[0], (unsigned)r1[0], (unsigned)r0[1], (unsigned)r1[1]};
        *(u32x4*)(rowp + 16 * gp + 8 * h) = wv;
    }
}

template <class Epi, bool SW = false>
DI void gemm_phase(const bf16_t* __restrict__ A, const bf16_t* __restrict__ Bt, int M, int N, int K, unsigned char* lds, const Epi& epi) {
    constexpr int STR = 144, TB = 128 * STR;
    const int tid = threadIdx.x, lane = tid & 63, w = tid >> 6, wm = w >> 1, wn = w & 1, r = lane & 31, h = lane >> 5;
    const int tilesN = N >> 7, ntiles = (M >> 7) * tilesN, nk = K >> 6;
    const int lrow = tid >> 3, lcol = tid & 7;
    const int G = gridDim.x, tilesM = M >> 7;
    const bool xcd_order = (G & 7) == 0;
    const int nlb = xcd_order ? (G >> 3) : 1, PW = (tilesN & 7) == 0 ? 8 : tilesN;
    const int npad = ((ntiles + G - 1) / G) * G;
    for (int tile_ = blockIdx.x; tile_ < npad * REP_GEMM; tile_ += G) {
        int tile = (REP_GEMM == 1) ? tile_ : tile_ % npad;
        if (xcd_order) {
            const int rd = tile / G, c = tile - rd * G;
            const int lin = ((rd << 3) + (c & 7)) * nlb + (c >> 3);
            tile = lin;
        }
        if (tile >= ntiles) continue;
        const int pnl = tile / (tilesM * PW), rem = tile - pnl * (tilesM * PW);
        const int tm = rem / PW, tn = pnl * PW + (rem - tm * PW);
        const bf16_t* Ag = A + (size_t)(tm * 128 + lrow) * K + lcol * 8;
        const bf16_t* Bg = Bt + (size_t)(tn * 128 + lrow) * K + lcol * 8;
        u32x4 ra0[4], rb0[4], ra1[4], rb1[4];
#define GEMM_LOAD(RA, RB, KT) { _Pragma("unroll") for (int i = 0; i < 4; ++i) { RA[i] = *(const u32x4*)(Ag + (size_t)(32 * i) * K + (KT) * 64); RB[i] = *(const u32x4*)(Bg + (size_t)(32 * i) * K + (KT) * 64); } }
#define GEMM_STORE(RA, RB, BUF) { _Pragma("unroll") for (int i = 0; i < 4; ++i) { *(u32x4*)(lds + (BUF) * TB + (lrow + 32 * i) * STR + lcol * 16) = RA[i]; *(u32x4*)(lds + 2 * TB + (BUF) * TB + (lrow + 32 * i) * STR + lcol * 16) = RB[i]; } }
#define GEMM_COMPUTE(BUF) { \
            const unsigned char* la = lds + (BUF) * TB + (wm * 64 + r) * STR + h * 16; \
            const unsigned char* lb = lds + 2 * TB + (BUF) * TB + (wn * 64 + r) * STR + h * 16; \
            _Pragma("unroll") for (int ks = 0; ks < 4; ++ks) { \
                bf16x8 af[2], bfr[2]; \
                _Pragma("unroll") for (int mi = 0; mi < 2; ++mi) af[mi] = *(const bf16x8*)(la + mi * 32 * STR + ks * 32); \
                _Pragma("unroll") for (int ni = 0; ni < 2; ++ni) bfr[ni] = *(const bf16x8*)(lb + ni * 32 * STR + ks * 32); \
                _Pragma("unroll") for (int mi = 0; mi < 2; ++mi) \
                    _Pragma("unroll") for (int ni = 0; ni < 2; ++ni) acc[mi][ni] = SW ? MFMA(af[mi], bfr[ni], acc[mi][ni]) : MFMA(bfr[ni], af[mi], acc[mi][ni]); \
            } }
        GEMM_LOAD(ra0, rb0, 0)
        if (nk > 1) GEMM_LOAD(ra1, rb1, 1)
        f32x16 acc[2][2];
#pragma unroll
        for (int mi = 0; mi < 2; ++mi)
#pragma unroll
            for (int ni = 0; ni < 2; ++ni)
#pragma unroll
                for (int i = 0; i < 16; ++i) acc[mi][ni][i] = 0.f;
        GEMM_STORE(ra0, rb0, 0)
        __syncthreads();
        for (int kt = 0; kt < nk; kt += 2) {
            if (kt + 2 < nk) GEMM_LOAD(ra0, rb0, kt + 2)
            GEMM_COMPUTE(0)
            if (kt + 1 < nk) GEMM_STORE(ra1, rb1, 1)
            __syncthreads();
            if (kt + 1 < nk) {
                if (kt + 3 < nk) GEMM_LOAD(ra1, rb1, kt + 3)
                GEMM_COMPUTE(1)
                if (kt + 2 < nk) GEMM_STORE(ra0, rb0, 0)
                __syncthreads();
            }
        }
#undef GEMM_LOAD
#undef GEMM_STORE
#undef GEMM_COMPUTE
        epi(acc, tm * 128 + wm * 64, tn * 128 + wn * 64, r, h);
    }
}

struct EpiQKV {
    bf16_t* q; bf16_t* k; bf16_t* vt; const f32x2* rope; const float* bias; int nq, nk, dv_shift, hv;
    DI void operator()(const f32x16 (&acc)[2][2], int m0, int n0, int r, int h) const {
        if (n0 < nq + nk) {
            const bool isq = n0 < nq;
            bf16_t* dst = isq ? q + n0 : k + (n0 - nq);
            const int ld = isq ? nq : nk;
            const float qs = isq ? 0.125f * LOG2E : 1.0f;
#pragma unroll
            for (int mi = 0; mi < 2; ++mi) {
                const int m = m0 + mi * 32 + r, pos = m & (SEQ - 1);
                const f32x4* rp = (const f32x4*)(rope + pos * 32);
                u32x2 A1[4], A2[4];
#pragma unroll
                for (int g = 0; g < 4; ++g) {
                    const int j0 = 8 * g + 4 * h;
                    const f32x4 cs01 = rp[j0 >> 1], cs23 = rp[(j0 >> 1) + 1];
                    f32x4 b1 = {0.f, 0.f, 0.f, 0.f}, b2 = {0.f, 0.f, 0.f, 0.f};
                    if (bias) { b1 = *(const f32x4*)(bias + n0 + j0); b2 = *(const f32x4*)(bias + n0 + 32 + j0); }
                    const float c[4] = {cs01.x, cs01.z, cs23.x, cs23.z}, s[4] = {cs01.y, cs01.w, cs23.y, cs23.w};
                    float o1[4], o2[4];
#pragma unroll
                    for (int e = 0; e < 4; ++e) {
                        const float t1 = acc[mi][0][4 * g + e] + b1[e], t2 = acc[mi][1][4 * g + e] + b2[e];
                        o1[e] = (t1 * c[e] - t2 * s[e]) * qs; o2[e] = (t2 * c[e] + t1 * s[e]) * qs;
                    }
                    A1[g].x = pk_bf16(o1[0], o1[1]); A1[g].y = pk_bf16(o1[2], o1[3]); A2[g].x = pk_bf16(o2[0], o2[1]); A2[g].y = pk_bf16(o2[2], o2[3]);
                }
                store_row32_bf16(dst + (size_t)m * ld, A1, h);
                store_row32_bf16(dst + (size_t)m * ld + 32, A2, h);
            }
        }
    }
};
struct EpiVt {
    bf16_t* vt; const float* bias; int dv_shift, hv;
    DI void operator()(const f32x16 (&acc)[2][2], int m0, int n0, int r, int h) const {
        const int b = m0 >> 13, s0 = m0 & (SEQ - 1);
#pragma unroll
        for (int ni = 0; ni < 2; ++ni) {
            const int eg = n0 + ni * 32 + r;
            const float bv = bias ? bias[eg] : 0.f;
            const int hh = eg >> dv_shift, e = eg & ((1 << dv_shift) - 1);
            bf16_t* rowp = vt + ((size_t)((b * hv + hh) << dv_shift) + e) * SEQ + s0;
#pragma unroll
            for (int mi = 0; mi < 2; ++mi) {
                u32x2 A[4];
#pragma unroll
                for (int g = 0; g < 4; ++g) { A[g].x = pk_bf16(acc[mi][ni][4 * g] + bv, acc[mi][ni][4 * g + 1] + bv); A[g].y = pk_bf16(acc[mi][ni][4 * g + 2] + bv, acc[mi][ni][4 * g + 3] + bv); }
                store_row32_bf16(rowp + mi * 32, A, h);
            }
        }
    }
};
template <bool RES_F32> struct EpiRes {
    const void* res; const float* bias; bf16_t* y;
    DI void operator()(const f32x16 (&acc)[2][2], int m0, int n0, int r, int h) const {
#pragma unroll
        for (int mi = 0; mi < 2; ++mi) {
            const int m = m0 + mi * 32 + r;
#pragma unroll
            for (int ni = 0; ni < 2; ++ni) {
                u32x2 A[4];
#pragma unroll
                for (int g = 0; g < 4; ++g) {
                    const int n = n0 + ni * 32 + 8 * g + 4 * h;
                    f32x4 xr;
                    if (RES_F32) xr = *(const f32x4*)((const float*)res + (size_t)m * DM + n);
                    else { const u32x2 u = *(const u32x2*)((const bf16_t*)res + (size_t)m * DM + n); xr.x = bf_lo(u.x); xr.y = bf_hi(u.x); xr.z = bf_lo(u.y); xr.w = bf_hi(u.y); }
                    f32x4 bv = {0.f, 0.f, 0.f, 0.f};
                    if (bias) bv = *(const f32x4*)(bias + n);
                    f32x4 o;
#pragma unroll
                    for (int e = 0; e < 4; ++e) o[e] = DN_ALPHA * xr[e] + acc[mi][ni][4 * g + e] + bv[e];
                    A[g].x = pk_bf16(o[0], o[1]); A[g].y = pk_bf16(o[2], o[3]);
                }
                store_row32_bf16(y + (size_t)m * DM + n0 + ni * 32, A, h);
            }
        }
    }
};
struct EpiBf16 {
    bf16_t* o;
    DI void operator()(const f32x16 (&acc)[2][2], int m0, int n0, int r, int h) const {
#pragma unroll
        for (int mi = 0; mi < 2; ++mi) {
            const int m = m0 + mi * 32 + r;
#pragma unroll
            for (int ni = 0; ni < 2; ++ni) {
                u32x2 A[4];
#pragma unroll
                for (int g = 0; g < 4; ++g) { A[g].x = pk_bf16(acc[mi][ni][4 * g], acc[mi][ni][4 * g + 1]); A[g].y = pk_bf16(acc[mi][ni][4 * g + 2], acc[mi][ni][4 * g + 3]); }
                store_row32_bf16(o + (size_t)m * DM + n0 + ni * 32, A, h);
            }
        }
    }
};

DI void ln_phase(const bf16_t* __restrict__ y, const float* __restrict__ g, const float* __restrict__ b, bf16_t* __restrict__ xo, float* __restrict__ xf = nullptr) {
    const int lane = threadIdx.x & 63, w = threadIdx.x >> 6;
    const int gw = blockIdx.x * 4 + w, nw = gridDim.x * 4;
    f32x4 gv[4], bv[4];
#pragma unroll
    for (int i = 0; i < 4; ++i) { gv[i] = ((const f32x4*)g)[lane + 64 * i]; bv[i] = ((const f32x4*)b)[lane + 64 * i]; }
    for (int row = gw; row < T_TOK; row += nw) {
        const u32x2* yr = (const u32x2*)(y + (size_t)row * DM);
        f32x4 v[4];
#pragma unroll
        for (int i = 0; i < 4; ++i) { const u32x2 u = yr[lane + 64 * i]; v[i].x = bf_lo(u.x); v[i].y = bf_hi(u.x); v[i].z = bf_lo(u.y); v[i].w = bf_hi(u.y); }
        float s = 0.f;
#pragma unroll
        for (int i = 0; i < 4; ++i) s += (v[i].x + v[i].y) + (v[i].z + v[i].w);
        const float mu = wave_sum(s) * (1.0f / DM);
        float q = 0.f;
#pragma unroll
        for (int i = 0; i < 4; ++i) { const f32x4 d = v[i] - mu; q += (d.x * d.x + d.y * d.y) + (d.z * d.z + d.w * d.w); }
        const float rstd = rsqrtf(wave_sum(q) * (1.0f / DM) + LN_EPS);
#pragma unroll
        for (int i = 0; i < 4; ++i) {
            const f32x4 o = (v[i] - mu) * rstd * gv[i] + bv[i];
            if (xf) *(f32x4*)(xf + (size_t)row * DM + 4 * (lane + 64 * i)) = o;
            if (xo) { u32x2 wv = {pk_bf16(o.x, o.y), pk_bf16(o.z, o.w)}; *(u32x2*)(xo + (size_t)row * DM + 4 * (lane + 64 * i)) = wv; }
        }
    }
}

struct AttnArgs {
    const bf16_t* q; const bf16_t* k; const bf16_t* vt; bf16_t* o;
    const float* lam_params; const float* subln_g; const float* sinks; float* scr;
};
DI int pi_perm(int r) { return (r & 0x13) | ((r & 4) << 1) | ((r & 8) >> 1); }

template <int MODE>
DI void attn_phase(const AttnArgs& a, unsigned char* lds) {
    constexpr int DV = MODE == 0 ? 128 : 64, EB = DV / 32;
    constexpr int KSTR = 144, VSTR = 144, KBUF = 64 * KSTR, VBUF = DV * VSTR;
    constexpr int KCH = 2, VCH = DV / 32;
    constexpr int LDK = MODE == 0 ? 1024 : 128, HV = MODE == 0 ? 8 : 2;
    constexpr int NITEMS = 8192;
    const int tid = threadIdx.x, lane = tid & 63, w = tid >> 6, r = lane & 31, h = lane >> 5;
    unsigned char* kl = lds;
    unsigned char* vl = lds + 3 * KBUF;
    const float NEG_INF = -__builtin_inff();
    const int G = gridDim.x;
    const int krow = tid >> 3, kcc = tid & 7;

    constexpr int REPA = MODE == 0 ? REP_ATT0 : REP_ATT1;
    for (int it_ = blockIdx.x; it_ < NITEMS * REPA; it_ += G) {
        const int it = (REPA == 1) ? it_ : it_ % NITEMS;
        int b, qb, qcol0, kcol0, vh, p = 0;
        if (MODE == 0) {
            int bh;
            const int s = it / G, c = it - s * G;
            if (G == 512) { const int jj = c >> 3; bh = (c & 7) + 8 * (s >> 1); p = jj & 1; qb = (s & 1) ? (jj >> 1) : 63 - (jj >> 1); }
            else if (G == 256) { const int jj = c >> 3; bh = (c & 7) + 8 * (s >> 2); p = s & 1; qb = (s & 2) ? jj : 63 - jj; }
            else { bh = it >> 7; p = it & 1; qb = 63 - ((it >> 1) & 63); }
            b = bh >> 3; const int hh = bh & 7; qcol0 = hh * 128; kcol0 = hh * 128; vh = hh;
        } else {
            const int head = it & 15; qb = (it >> 4) & 63; b = it >> 10;
            qcol0 = head * 64; vh = head >> 3; kcol0 = vh * 64;
        }
        const int q0 = qb * 128, qw0 = q0 + 32 * w, qpos = qw0 + r;
        const int kt0 = MODE == 0 ? 0 : ((q0 >= 128 ? q0 - 128 : 0) >> 6), kt1 = (q0 + 128) >> 6;
        const bf16_t* vg = a.vt + (size_t)(b * HV + vh) * DV * SEQ + (size_t)krow * SEQ + kcc * 8;
        const size_t tok = (size_t)b * SEQ + qpos;

        {
            const bf16_t* kg = a.k + (size_t)b * SEQ * LDK + kcol0 + p * 64 + (size_t)krow * LDK + kcc * 8;
            bf16x8 qf[4];
            {
                const bf16_t* qp = a.q + tok * 1024 + qcol0 + p * 64 + h * 8;
#pragma unroll
                for (int ks = 0; ks < 4; ++ks) qf[ks] = *(const bf16x8*)(qp + ks * 16);
            }
            f32x16 O[EB];
#pragma unroll
            for (int eb = 0; eb < EB; ++eb)
#pragma unroll
                for (int i = 0; i < 16; ++i) O[eb][i] = 0.f;
            float mrow = NEG_INF, lsum = 0.f;
            if (MODE == 1) { mrow = a.sinks[it & 15] * LOG2E; lsum = (h == 0) ? 1.0f : 0.0f; }

            u32x4 rk[KCH], rv[VCH];
#define ATT_LOADK(KT) { _Pragma("unroll") for (int i = 0; i < KCH; ++i) rk[i] = *(const u32x4*)(kg + (size_t)((KT) * 64 + 32 * i) * LDK); }
#define ATT_LOADV(KT) { _Pragma("unroll") for (int i = 0; i < VCH; ++i) rv[i] = *(const u32x4*)(vg + (size_t)(32 * i) * SEQ + (KT) * 64); }
#define ATT_STOREK(KT) { unsigned char* kd_ = kl + (((KT) - kt0) % 3) * KBUF; _Pragma("unroll") for (int i = 0; i < KCH; ++i) *(u32x4*)(kd_ + (krow + 32 * i) * KSTR + kcc * 16) = rk[i]; }
#define ATT_STOREV(KT) { unsigned char* vd_ = vl + (((KT) - kt0) & 1) * VBUF; _Pragma("unroll") for (int i = 0; i < VCH; ++i) *(u32x4*)(vd_ + (krow + 32 * i) * VSTR + kcc * 16) = rv[i]; }
            auto s_compute = [&](f32x16 (&sx)[2], const int kt) __attribute__((always_inline)) {
                const unsigned char* kb_ = kl + ((kt - kt0) % 3) * KBUF;
#pragma unroll
                for (int kb = 0; kb < 2; ++kb) {
#pragma unroll
                    for (int i = 0; i < 16; ++i) sx[kb][i] = 0.f;
#pragma unroll
                    for (int ks = 0; ks < 4; ++ks) {
                        const bf16x8 kf = *(const bf16x8*)(kb_ + (kb * 32 + pi_perm(r)) * KSTR + ks * 32 + h * 16);
                        sx[kb] = MFMA(kf, qf[ks], sx[kb]);
                    }
                }
            };
            auto step = [&](f32x16 (&s)[2], f32x16 (&sn)[2], const int kt) __attribute__((always_inline)) {
                const bool more1 = kt + 1 < kt1, more2 = kt + 2 < kt1;
                if (more2) ATT_LOADK(kt + 2)
                if (more1) ATT_LOADV(kt + 1)
                const int key0 = kt * 64;
                bool need_mask = key0 + 63 > qw0;
                if (MODE == 1) need_mask = need_mask || (key0 < qw0 + 31 - 127);
                if (need_mask) {
                    asm volatile("" ::: "memory");
#pragma unroll
                    for (int kb = 0; kb < 2; ++kb)
#pragma unroll
                        for (int i = 0; i < 16; ++i) {
                            const int key = key0 + kb * 32 + 16 * (i >> 3) + 8 * h + (i & 7);
                            bool valid = key <= qpos;
                            if (MODE == 1) valid = valid && (key > qpos - 128);
                            s[kb][i] = valid ? s[kb][i] : NEG_INF;
                        }
                }
                float mx = NEG_INF;
#pragma unroll
                for (int kb = 0; kb < 2; ++kb)
#pragma unroll
                    for (int i = 0; i < 16; ++i) mx = fmaxf(mx, s[kb][i]);
                mx = fmaxf(mx, __shfl_xor(mx, 32));
                if (__builtin_amdgcn_ballot_w64(mx > mrow + 8.0f) != 0ull) {
                    asm volatile("" ::: "memory");
                    const float mnew = fmaxf(mrow, mx);
                    const float alpha = __builtin_amdgcn_exp2f(mrow - mnew);
                    mrow = mnew;
                    lsum *= alpha;
#pragma unroll
                    for (int eb = 0; eb < EB; ++eb)
#pragma unroll
                        for (int i = 0; i < 16; ++i) O[eb][i] *= alpha;
                }
                s_compute(sn, kt + 1);
                f32x2 ps2 = {0.f, 0.f};
#pragma unroll
                for (int kb = 0; kb < 2; ++kb)
#pragma unroll
                    for (int i = 0; i < 16; i += 2) {
                        f32x2 pv = {__builtin_amdgcn_exp2f(s[kb][i] - mrow), __builtin_amdgcn_exp2f(s[kb][i + 1] - mrow)};
                        s[kb][i] = pv.x; s[kb][i + 1] = pv.y; ps2 += pv;
                    }
                lsum += ps2.x + ps2.y;
                bf16x8 pf[2][2];
#pragma unroll
                for (int kb = 0; kb < 2; ++kb)
#pragma unroll
                    for (int s2 = 0; s2 < 2; ++s2) {
                        u32x4 u;
                        u.x = pk_bf16(s[kb][8 * s2 + 0], s[kb][8 * s2 + 1]); u.y = pk_bf16(s[kb][8 * s2 + 2], s[kb][8 * s2 + 3]);
                        u.z = pk_bf16(s[kb][8 * s2 + 4], s[kb][8 * s2 + 5]); u.w = pk_bf16(s[kb][8 * s2 + 6], s[kb][8 * s2 + 7]);
                        pf[kb][s2] = __builtin_bit_cast(bf16x8, u);
                    }
                const unsigned char* vb_ = vl + ((kt - kt0) & 1) * VBUF;
#pragma unroll
                for (int eb = 0; eb < EB; ++eb) {
#pragma unroll
                    for (int kb = 0; kb < 2; ++kb)
#pragma unroll
                        for (int s2 = 0; s2 < 2; ++s2) {
                            const bf16x8 vf = *(const bf16x8*)(vb_ + (eb * 32 + r) * VSTR + (kb * 32 + 16 * s2 + 8 * h) * 2);
                            O[eb] = MFMA(vf, pf[kb][s2], O[eb]);
                        }
                }
                if (more2) ATT_STOREK(kt + 2)
                if (more1) ATT_STOREV(kt + 1)
                __syncthreads();
            };
            ATT_LOADK(kt0) ATT_LOADV(kt0)
            ATT_STOREK(kt0) ATT_STOREV(kt0)
            if (kt0 + 1 < kt1) { ATT_LOADK(kt0 + 1) ATT_STOREK(kt0 + 1) }
            __syncthreads();
            f32x16 sA[2], sB[2];
            s_compute(sA, kt0);
            for (int kt = kt0; kt < kt1; kt += 2) {
                step(sA, sB, kt);
                if (kt + 1 < kt1) step(sB, sA, kt + 1);
            }
#undef ATT_LOADK
#undef ATT_LOADV
#undef ATT_STOREK
#undef ATT_STOREV
            const float inv0 = 1.0f / (lsum + __shfl_xor(lsum, 32));
            bf16_t* op = (MODE == 0) ? a.o + tok * 2048 + qcol0 * 2 + p * 128 : a.o + tok * 1024 + qcol0;
#pragma unroll
            for (int eb = 0; eb < EB; ++eb) {
                u32x2 A[4];
#pragma unroll
                for (int g = 0; g < 4; ++g) { A[g].x = pk_bf16(O[eb][4 * g] * inv0, O[eb][4 * g + 1] * inv0); A[g].y = pk_bf16(O[eb][4 * g + 2] * inv0, O[eb][4 * g + 3] * inv0); }
                store_row32_bf16(op + eb * 32, A, h);
            }
        }
    }
}

DI void diff_combine_phase(const bf16_t* __restrict__ op, const float* __restrict__ lam_params, const float* __restrict__ subln_g, bf16_t* __restrict__ o) {
    const int lane = threadIdx.x & 63, w = threadIdx.x >> 6;
    const int gwave = blockIdx.x * 4 + w, nwave = gridDim.x * 4;
    const float p1 = wave_sum(lam_params[lane] * lam_params[64 + lane]);
    const float p2 = wave_sum(lam_params[128 + lane] * lam_params[192 + lane]);
    const float lam = __expf(p1) - __expf(p2) + LAMBDA_INIT0;
    const int hd = lane >> 3, d0 = 16 * (lane & 7);
    f32x4 gg[4];
#pragma unroll
    for (int i = 0; i < 4; ++i) gg[i] = *(const f32x4*)(subln_g + d0 + 4 * i);
    for (int t = gwave; t < T_TOK; t += nwave) {
        const bf16_t* p0 = op + (size_t)t * 2048 + hd * 256 + d0;
        const u32x4 a0 = *(const u32x4*)p0, a1 = *(const u32x4*)(p0 + 8), b0 = *(const u32x4*)(p0 + 128), b1 = *(const u32x4*)(p0 + 136);
        float v[16];
#pragma unroll
        for (int i = 0; i < 4; ++i) {
            v[2 * i] = bf_lo(a0[i]) - lam * bf_lo(b0[i]); v[2 * i + 1] = bf_hi(a0[i]) - lam * bf_hi(b0[i]);
            v[8 + 2 * i] = bf_lo(a1[i]) - lam * bf_lo(b1[i]); v[8 + 2 * i + 1] = bf_hi(a1[i]) - lam * bf_hi(b1[i]);
        }
        float ss = 0.f;
#pragma unroll
        for (int i = 0; i < 16; ++i) ss += v[i] * v[i];
        ss += __shfl_xor(ss, 1); ss += __shfl_xor(ss, 2); ss += __shfl_xor(ss, 4);
        const float rs = rsqrtf(ss * (1.0f / 128.0f) + LN_EPS) * (1.0f - LAMBDA_INIT0);
        u32x4 w0, w1;
#pragma unroll
        for (int i = 0; i < 4; ++i) {
            const int e = (i & 1) * 2;
            w0[i] = pk_bf16(v[2 * i] * rs * gg[i >> 1][e], v[2 * i + 1] * rs * gg[i >> 1][e + 1]);
            w1[i] = pk_bf16(v[8 + 2 * i] * rs * gg[2 + (i >> 1)][e], v[8 + 2 * i + 1] * rs * gg[2 + (i >> 1)][e + 1]);
        }
        bf16_t* dst = o + (size_t)t * 1024 + hd * 128 + d0;
        *(u32x4*)dst = w0; *(u32x4*)(dst + 8) = w1;
    }
}

DI unsigned f2ord(float f) { const unsigned u = __float_as_uint(f); return (u & 0x80000000u) ? ~u : (u | 0x80000000u); }
DI float ord2f(unsigned o) { const unsigned u = (o & 0x80000000u) ? (o & 0x7fffffffu) : ~o; return __uint_as_float(u); }
__host__ __device__ constexpr int combo_row_start(int a) { int s = 0; for (int i = 0; i < a; ++i) s += 16 / (i + 1); return s; }

constexpr int SORT16[63][2] = {{0,1}, {2,3}, {0,2}, {1,3}, {1,2}, {4,5}, {6,7}, {4,6}, {5,7}, {5,6}, {0,4}, {2,6}, {2,4}, {1,5}, {3,7}, {3,5}, {1,2}, {3,4}, {5,6}, {8,9}, {10,11}, {8,10}, {9,11}, {9,10}, {12,13}, {14,15}, {12,14}, {13,15}, {13,14}, {8,12}, {10,14}, {10,12}, {9,13}, {11,15}, {11,13}, {9,10}, {11,12}, {13,14}, {0,8}, {4,12}, {4,8}, {2,10}, {6,14}, {6,10}, {2,4}, {6,8}, {10,12}, {1,9}, {5,13}, {5,9}, {3,11}, {7,15}, {7,11}, {3,5}, {7,9}, {11,13}, {1,2}, {3,4}, {5,6}, {7,8}, {9,10}, {11,12}, {13,14}};
constexpr int BMERGE16[32][2] = {{0,8}, {1,9}, {2,10}, {3,11}, {4,12}, {5,13}, {6,14}, {7,15}, {0,4}, {1,5}, {2,6}, {3,7}, {8,12}, {9,13}, {10,14}, {11,15}, {0,2}, {1,3}, {4,6}, {5,7}, {8,10}, {9,11}, {12,14}, {13,15}, {0,1}, {2,3}, {4,5}, {6,7}, {8,9}, {10,11}, {12,13}, {14,15}};
DI void cex(unsigned& a, unsigned& b) { const unsigned hi = max(a, b), lo = min(a, b); a = hi; b = lo; }
DI void merge_top16(unsigned (&A)[16], const unsigned (&B)[16]) {
#pragma unroll
    for (int i = 0; i < 16; ++i) A[i] = max(A[i], B[15 - i]);
#pragma unroll
    for (int n = 0; n < 32; ++n) cex(A[BMERGE16[n][0]], A[BMERGE16[n][1]]);
}
DI void peer_topk_phase(const bf16_t* __restrict__ qpk, const bf16_t* __restrict__ subk, int* __restrict__ eidx, float* __restrict__ gout) {
    int tidv = threadIdx.x;
    asm volatile("" : "+v"(tidv));
    const int lane = tidv & 63, w = tidv >> 6, r = lane & 31, h = lane >> 5;
    const int gwave = blockIdx.x * 4 + w, nwave = gridDim.x * 4;
    for (int item_ = gwave; item_ < 2048 * 8 * REP_TOPK; item_ += nwave) {
        const int item = (REP_TOPK == 1) ? item_ : item_ % (2048 * 8);
        const int tt = item >> 3, hh = item & 7, t0 = tt * 32;
        unsigned top[2][16];
#pragma unroll
        for (int c = 0; c < 2; ++c) {
            f32x16 acc[4];
#pragma unroll
            for (int nb = 0; nb < 4; ++nb)
#pragma unroll
                for (int i = 0; i < 16; ++i) acc[nb][i] = 0.f;
            const bf16_t* qp = qpk + (size_t)(t0 + r) * 1024 + hh * 128 + c * 64 + h * 8;
            const bf16_t* kp = subk + ((size_t)(hh * 2 + c) * 128 + r) * 64 + h * 8;
#pragma unroll
            for (int ks = 0; ks < 4; ++ks) {
                const bf16x8 qfr = *(const bf16x8*)(qp + ks * 16);
#pragma unroll
                for (int nb = 0; nb < 4; ++nb) {
                    const bf16x8 kf = *(const bf16x8*)(kp + nb * 32 * 64 + ks * 16);
                    acc[nb] = MFMA(kf, qfr, acc[nb]);
                }
            }
            unsigned key[64];
#pragma unroll
            for (int nb = 0; nb < 4; ++nb)
#pragma unroll
                for (int i = 0; i < 16; ++i) {
                    const int n = nb * 32 + (i & 3) + 8 * (i >> 2) + 4 * h;
                    key[nb * 16 + i] = (f2ord(acc[nb][i]) & ~127u) | (unsigned)(127 - n);
                }
            unsigned g0[16], g1[16], g2[16], g3[16];
#pragma unroll
            for (int i = 0; i < 16; ++i) { g0[i] = key[i]; g1[i] = key[16 + i]; g2[i] = key[32 + i]; g3[i] = key[48 + i]; }
#pragma unroll
            for (int n = 0; n < 63; ++n) { cex(g0[SORT16[n][0]], g0[SORT16[n][1]]); cex(g1[SORT16[n][0]], g1[SORT16[n][1]]); cex(g2[SORT16[n][0]], g2[SORT16[n][1]]); cex(g3[SORT16[n][0]], g3[SORT16[n][1]]); }
            merge_top16(g0, g1); merge_top16(g2, g3); merge_top16(g0, g2);
            unsigned pb[16];
#pragma unroll
            for (int i = 0; i < 16; ++i) pb[i] = (unsigned)__shfl_xor((int)g0[i], 32);
            merge_top16(g0, pb);
#pragma unroll
            for (int i = 0; i < 16; ++i) top[c][i] = g0[i];
        }
        unsigned ck[50];
#pragma unroll
        for (int a = 0; a < 16; ++a)
#pragma unroll
            for (int b = 0; b < 16 / (a + 1); ++b) {
                const float cv = ord2f(top[0][a] & ~127u) + ord2f(top[1][b] & ~127u);
                ck[combo_row_start(a) + b] = (f2ord(cv) & ~255u) | (unsigned)(((15 - a) << 4) | (15 - b));
            }
        unsigned c0[16], c1[16], c2[16], c3[16];
#pragma unroll
        for (int i = 0; i < 16; ++i) { c0[i] = ck[i]; c1[i] = ck[16 + i]; c2[i] = ck[32 + i]; c3[i] = (i < 2) ? ck[48 + i] : 0u; }
#pragma unroll
        for (int n = 0; n < 63; ++n) { cex(c1[SORT16[n][0]], c1[SORT16[n][1]]); cex(c2[SORT16[n][0]], c2[SORT16[n][1]]); }
        merge_top16(c0, c1); merge_top16(c2, c3); merge_top16(c0, c2);
        float sv[16]; int se[16];
#pragma unroll
        for (int rd = 0; rd < 16; ++rd) {
            const unsigned m = c0[rd];
            const int asel = 15 - (int)((m >> 4) & 15u), bsel = 15 - (int)(m & 15u);
            unsigned ka = top[0][0], kb = top[1][0];
#pragma unroll
            for (int i = 1; i < 16; ++i) { ka = (asel == i) ? top[0][i] : ka; kb = (bsel == i) ? top[1][i] : kb; }
            sv[rd] = ord2f(ka & ~127u) + ord2f(kb & ~127u);
            se[rd] = (127 - (int)(ka & 127u)) * 128 + (127 - (int)(kb & 127u));
        }
        float den = 0.f;
        const float mx0 = sv[0];
#pragma unroll
        for (int i = 0; i < 16; ++i) { sv[i] = __expf(sv[i] - mx0); den += sv[i]; }
        const float inv = 1.0f / den;
        const size_t ob = (size_t)(t0 + r) * 128 + hh * 16;
        if (h == 0) {
#pragma unroll
            for (int i = 0; i < 4; ++i) { int4 v = make_int4(se[4 * i], se[4 * i + 1], se[4 * i + 2], se[4 * i + 3]); *(int4*)(eidx + ob + 4 * i) = v; }
        } else {
#pragma unroll
            for (int i = 0; i < 4; ++i) { f32x4 v = {sv[4 * i] * inv, sv[4 * i + 1] * inv, sv[4 * i + 2] * inv, sv[4 * i + 3] * inv}; *(f32x4*)(gout + ob + 4 * i) = v; }
        }
    }
}

DI float gelu_exact(float v) { return 0.5f * v * (1.0f + erff(v * 0.70710678118654752f)); }
DI void convert_rows_fp8(const float* __restrict__ src, unsigned char* __restrict__ dst, float* __restrict__ inv, int nrows) {
    const int lane = threadIdx.x & 63, w = threadIdx.x >> 6;
    const int gwave = blockIdx.x * 4 + w, nwave = gridDim.x * 4;
    for (int row_ = gwave; row_ < nrows * REP_P0; row_ += nwave) {
        const int row = (REP_P0 == 1) ? row_ : row_ % nrows;
        const f32x4* p = (const f32x4*)(src + (size_t)row * DM + 16 * lane);
        f32x4 v[4];
#pragma unroll
        for (int i = 0; i < 4; ++i) v[i] = p[i];
        float am = 0.f;
#pragma unroll
        for (int i = 0; i < 4; ++i) am = fmaxf(am, fmaxf(fmaxf(fabsf(v[i].x), fabsf(v[i].y)), fmaxf(fabsf(v[i].z), fabsf(v[i].w))));
#pragma unroll
        for (int o = 32; o >= 1; o >>= 1) am = fmaxf(am, __shfl_xor(am, o));
        const unsigned eb = (__float_as_uint(am) >> 23) & 0xffu;
        float sc = 1.0f, isc = 1.0f;
        if (eb >= 16u && eb <= 250u) { sc = __uint_as_float((261u - eb) << 23); isc = __uint_as_float((eb - 7u) << 23); }
        u32x4 o;
#pragma unroll
        for (int i = 0; i < 4; ++i) {
            int pk = __builtin_amdgcn_cvt_pk_fp8_f32(v[i].x * sc, v[i].y * sc, 0, false);
            pk = __builtin_amdgcn_cvt_pk_fp8_f32(v[i].z * sc, v[i].w * sc, pk, true);
            o[i] = (unsigned)pk;
        }
        *(u32x4*)(dst + (size_t)row * DM + 16 * lane) = o;
        if (lane == 0) inv[row] = isc;
    }
}
DI float dot16(const unsigned (&a)[8], u32x4 b0, u32x4 b1) {
    float acc;
    asm volatile("v_dot2_f32_bf16 %0, %1, %9, 0\n\tv_dot2_f32_bf16 %0, %2, %10, %0\n\tv_dot2_f32_bf16 %0, %3, %11, %0\n\tv_dot2_f32_bf16 %0, %4, %12, %0\n\t"
                 "v_dot2_f32_bf16 %0, %5, %13, %0\n\tv_dot2_f32_bf16 %0, %6, %14, %0\n\tv_dot2_f32_bf16 %0, %7, %15, %0\n\tv_dot2_f32_bf16 %0, %8, %16, %0\n\ts_nop 2"
                 : "=&v"(acc)
                 : "v"(a[0]), "v"(a[1]), "v"(a[2]), "v"(a[3]), "v"(a[4]), "v"(a[5]), "v"(a[6]), "v"(a[7]),
                   "v"(b0.x), "v"(b0.y), "v"(b0.z), "v"(b0.w), "v"(b1.x), "v"(b1.y), "v"(b1.z), "v"(b1.w));
    return acc;
}
DI float dot_fp8_row(u32x4 u, u32x4 xa, u32x4 xb) {
    unsigned a[8];
#pragma unroll
    for (int j = 0; j < 4; ++j) {
        a[2 * j] = __builtin_bit_cast(unsigned, __builtin_amdgcn_cvt_scalef32_pk_bf16_fp8(u[j], 1.0f, false));
        a[2 * j + 1] = __builtin_bit_cast(unsigned, __builtin_amdgcn_cvt_scalef32_pk_bf16_fp8(u[j], 1.0f, true));
    }
    return dot16(a, xa, xb);
}
DI void axpy_fp8_row(f32x2 (&o)[8], float wgt, u32x4 v) {
    const f32x2 w2 = {wgt, wgt};
#pragma unroll
    for (int j = 0; j < 4; ++j) {
        const f32x2 lo = __builtin_amdgcn_cvt_pk_f32_fp8(v[j], false), hi = __builtin_amdgcn_cvt_pk_f32_fp8(v[j], true);
        o[2 * j] = __builtin_elementwise_fma(w2, lo, o[2 * j]);
        o[2 * j + 1] = __builtin_elementwise_fma(w2, hi, o[2 * j + 1]);
    }
}
struct TokMeta { int e0, e1; float su0, su1, gv0, gv1; u32x4 xa, xb; };
DI TokMeta load_meta(int t, int lane, const bf16_t* __restrict__ x1, const int* __restrict__ eidx, const float* __restrict__ gws, const float* __restrict__ su, const float* __restrict__ sv) {
    TokMeta m;
    m.e0 = eidx[(size_t)t * 128 + lane]; m.e1 = eidx[(size_t)t * 128 + 64 + lane];
    const float g0 = gws[(size_t)t * 128 + lane], g1 = gws[(size_t)t * 128 + 64 + lane];
    m.su0 = su[m.e0]; m.su1 = su[m.e1];
    m.gv0 = g0 * sv[m.e0]; m.gv1 = g1 * sv[m.e1];
    m.xa = *(const u32x4*)(x1 + (size_t)t * DM + 16 * lane); m.xb = *(const u32x4*)(x1 + (size_t)t * DM + 16 * lane + 8);
    return m;
}
DI void gather_issue(u32x4 (&bu)[8], u32x4 (&bv)[8], int ev, int lbase, int lane, const unsigned char* __restrict__ U8, const unsigned char* __restrict__ V8) {
#pragma unroll
    for (int i = 0; i < 8; ++i) {
        const int e = __builtin_amdgcn_readlane(ev, lbase + i);
        bu[i] = *(const u32x4*)(U8 + (size_t)e * DM + 16 * lane);
        bv[i] = *(const u32x4*)(V8 + (size_t)e * DM + 16 * lane);
    }
}
DI void gather_compute(const u32x4 (&bu)[8], const u32x4 (&bv)[8], float suv, float gvv, int lbase, int lane_in, u32x4 xa, u32x4 xb, f32x2 (&out)[8]) {
    int lane = lane_in;
    float d[8];
#pragma unroll
    for (int i = 0; i < 8; ++i) { d[i] = dot_fp8_row(bu[i], xa, xb) * __builtin_bit_cast(float, __builtin_amdgcn_readlane(__builtin_bit_cast(int, suv), lbase + i)); __builtin_amdgcn_sched_barrier(0); }
    float d4[4], d2[2], d1;
    asm volatile("" : "+v"(lane));
    {
        const bool hi = (lane & 32) != 0;
#pragma unroll
        for (int i = 0; i < 4; ++i) { const float keep = hi ? d[i + 4] : d[i], send = hi ? d[i] : d[i + 4]; d4[i] = keep + __shfl_xor(send, 32); }
    }
    {
        const bool hi = (lane & 16) != 0;
#pragma unroll
        for (int i = 0; i < 2; ++i) { const float keep = hi ? d4[i + 2] : d4[i], send = hi ? d4[i] : d4[i + 2]; d2[i] = keep + __shfl_xor(send, 16); }
    }
    {
        const bool hi = (lane & 8) != 0;
        const float keep = hi ? d2[1] : d2[0], send = hi ? d2[0] : d2[1];
        d1 = keep + __shfl_xor(send, 8);
    }
    d1 += __shfl_xor(d1, 4); d1 += __shfl_xor(d1, 2); d1 += __shfl_xor(d1, 1);
    const float hv = gelu_exact(d1);
#pragma unroll
    for (int i = 0; i < 8; ++i) {
        const int src = 8 * (i & 1) + 16 * ((i >> 1) & 1) + 32 * ((i >> 2) & 1);
        const float wi = __builtin_bit_cast(float, __builtin_amdgcn_readlane(__builtin_bit_cast(int, gvv), lbase + i)) *
                         __builtin_bit_cast(float, __builtin_amdgcn_readlane(__builtin_bit_cast(int, hv), src));
        axpy_fp8_row(out, wi, bv[i]);
        __builtin_amdgcn_sched_barrier(0);
    }
}
DI void peer_gather_phase(const bf16_t* __restrict__ x1, const int* __restrict__ eidx, const float* __restrict__ gws, const unsigned char* __restrict__ U8,
                          const unsigned char* __restrict__ V8, const float* __restrict__ su, const float* __restrict__ sv, const float* __restrict__ lng,
                          const float* __restrict__ lnb, bf16_t* __restrict__ xo_bf, float* __restrict__ xo_f32) {
    const int lane = threadIdx.x & 63, w = threadIdx.x >> 6;
    const int gwave = blockIdx.x * 4 + w, nwave = gridDim.x * 4;
    if (gwave < T_TOK) {
        TokMeta cur = load_meta(gwave, lane, x1, eidx, gws, su, sv);
        u32x4 au[8], av[8], bu[8], bv[8];
        gather_issue(au, av, cur.e0, 0, lane, U8, V8);
        for (int t_ = gwave; t_ < T_TOK * REP_GATHER; t_ += nwave) {
            const int t = (REP_GATHER == 1) ? t_ : t_ % T_TOK;
            const bool has_next = t_ + nwave < T_TOK * REP_GATHER;
            TokMeta nxt = cur;
            if (has_next) nxt = load_meta((REP_GATHER == 1) ? t_ + nwave : (t_ + nwave) % T_TOK, lane, x1, eidx, gws, su, sv);
            f32x2 out[8];
#pragma unroll
            for (int i = 0; i < 8; ++i) { out[i].x = 0.f; out[i].y = 0.f; }
            for (int jb = 0; jb < 16; jb += 2) {
                const int ev = (jb < 8) ? cur.e0 : cur.e1;
                const float suv = (jb < 8) ? cur.su0 : cur.su1, gvv = (jb < 8) ? cur.gv0 : cur.gv1;
                const int lbase = (jb & 7) * 8;
                gather_issue(bu, bv, ev, lbase + 8, lane, U8, V8);
                gather_compute(au, av, suv, gvv, lbase, lane, cur.xa, cur.xb, out);
                if (jb + 2 < 16) {
                    const int ev2 = (jb + 2 < 8) ? cur.e0 : cur.e1;
                    gather_issue(au, av, ev2, ((jb + 2) & 7) * 8, lane, U8, V8);
                } else if (has_next) {
                    gather_issue(au, av, nxt.e0, 0, lane, U8, V8);
                }
                gather_compute(bu, bv, suv, gvv, lbase + 8, lane, cur.xa, cur.xb, out);
            }
            float y[16];
            {
                const u32x4 xa = cur.xa, xb = cur.xb;
                y[0] = bf_lo(xa.x); y[1] = bf_hi(xa.x); y[2] = bf_lo(xa.y); y[3] = bf_hi(xa.y); y[4] = bf_lo(xa.z); y[5] = bf_hi(xa.z); y[6] = bf_lo(xa.w); y[7] = bf_hi(xa.w);
                y[8] = bf_lo(xb.x); y[9] = bf_hi(xb.x); y[10] = bf_lo(xb.y); y[11] = bf_hi(xb.y); y[12] = bf_lo(xb.z); y[13] = bf_hi(xb.z); y[14] = bf_lo(xb.w); y[15] = bf_hi(xb.w);
            }
            float s = 0.f;
#pragma unroll
            for (int i = 0; i < 8; ++i) { y[2 * i] = DN_ALPHA * y[2 * i] + out[i].x; y[2 * i + 1] = DN_ALPHA * y[2 * i + 1] + out[i].y; s += y[2 * i] + y[2 * i + 1]; }
            const float mu = wave_sum(s) * (1.0f / DM);
            float qq = 0.f;
#pragma unroll
            for (int i = 0; i < 16; ++i) { const float dd = y[i] - mu; qq += dd * dd; }
            const float rstd = rsqrtf(wave_sum(qq) * (1.0f / DM) + LN_EPS);
            const int col = 16 * lane;
            f32x4 o4[4];
#pragma unroll
            for (int q4 = 0; q4 < 4; ++q4) {
                const f32x4 ga = *(const f32x4*)(lng + col + 4 * q4), ba = *(const f32x4*)(lnb + col + 4 * q4);
#pragma unroll
                for (int e = 0; e < 4; ++e) o4[q4][e] = (y[4 * q4 + e] - mu) * rstd * ga[e] + ba[e];
            }
            if (xo_f32) {
#pragma unroll
                for (int q4 = 0; q4 < 4; ++q4) *(f32x4*)(xo_f32 + (size_t)t * DM + col + 4 * q4) = o4[q4];
            }
            if (xo_bf) {
                u32x4 w0 = {pk_bf16(o4[0].x, o4[0].y), pk_bf16(o4[0].z, o4[0].w), pk_bf16(o4[1].x, o4[1].y), pk_bf16(o4[1].z, o4[1].w)};
                u32x4 w1 = {pk_bf16(o4[2].x, o4[2].y), pk_bf16(o4[2].z, o4[2].w), pk_bf16(o4[3].x, o4[3].y), pk_bf16(o4[3].z, o4[3].w)};
                *(u32x4*)(xo_bf + (size_t)t * DM + col) = w0; *(u32x4*)(xo_bf + (size_t)t * DM + col + 8) = w1;
            }
            cur = nxt;
        }
    }
}

struct SliceMap { int j0, jstep, wslot, nslot; };
DI SliceMap slice_map(int w) {
    SliceMap m; const int G = gridDim.x;
    if (G >= 8) { m.j0 = blockIdx.x & 7; m.jstep = 8; m.wslot = (blockIdx.x >> 3) * 4 + w; m.nslot = ((G - m.j0 + 7) >> 3) * 4; }
    else { m.j0 = 0; m.jstep = 1; m.wslot = blockIdx.x * 4 + w; m.nslot = G * 4; }
    return m;
}
DI void peer_u_phase(const bf16_t* __restrict__ x1, const int* __restrict__ eidx, const unsigned char* __restrict__ U8, float* __restrict__ ph) {
    int tidv = threadIdx.x;
    asm volatile("" : "+v"(tidv));
    const int lane = tidv & 63, w = tidv >> 6, grp = lane >> 3, l8 = lane & 7;
    const SliceMap sm = slice_map(w);
    for (int j_ = sm.j0; j_ < 8 * REP_PU; j_ += sm.jstep) {
        const int j = j_ & 7;
        const unsigned char* ub = U8 + 128 * j + 16 * l8;
        const bf16_t* xb_ = x1 + 128 * j + 16 * l8;
        float* pj = ph + (size_t)j * T_TOK * 128;
        const int step = sm.nslot;
        int t = sm.wslot;
        if (t >= T_TOK) continue;
        u32x4 sa[16], sb[16];
        int e0n = 0, e1n = 0;
        u32x4 xa, xb, xan, xbn;
#define U_ISSUE(SEG, E0, E1) { _Pragma("unroll") for (int b = 0; b < 16; ++b) { const int e = __shfl((b < 8) ? (E0) : (E1), (b & 7) * 8 + grp); SEG[b] = *(const u32x4*)(ub + (size_t)e * DM); } }
#define U_COMPUTE(SEG, TT) { float hsum[2]; \
            _Pragma("unroll") for (int hf = 0; hf < 2; ++hf) { float d[8]; \
                _Pragma("unroll") for (int i = 0; i < 8; ++i) { d[i] = dot_fp8_row(SEG[hf * 8 + i], xa, xb); } \
                float d4[4], d2[2]; \
                { const bool hi = (l8 & 4) != 0; _Pragma("unroll") for (int i = 0; i < 4; ++i) { const float keep = hi ? d[i + 4] : d[i], send = hi ? d[i] : d[i + 4]; d4[i] = keep + __shfl_xor(send, 4); } } \
                { const bool hi = (l8 & 2) != 0; _Pragma("unroll") for (int i = 0; i < 2; ++i) { const float keep = hi ? d4[i + 2] : d4[i], send = hi ? d4[i] : d4[i + 2]; d2[i] = keep + __shfl_xor(send, 2); } } \
                { const bool hi = (l8 & 1) != 0; const float keep = hi ? d2[1] : d2[0], send = hi ? d2[0] : d2[1]; hsum[hf] = keep + __shfl_xor(send, 1); } } \
            pj[(size_t)(TT) * 128 + 8 * l8 + grp] = hsum[0]; pj[(size_t)(TT) * 128 + 64 + 8 * l8 + grp] = hsum[1]; }
        {
            const int e0 = eidx[(size_t)t * 128 + lane], e1 = eidx[(size_t)t * 128 + 64 + lane];
            xa = *(const u32x4*)(xb_ + (size_t)t * DM); xb = *(const u32x4*)(xb_ + (size_t)t * DM + 8);
            U_ISSUE(sa, e0, e1)
            if (t + step < T_TOK) { e0n = eidx[(size_t)(t + step) * 128 + lane]; e1n = eidx[(size_t)(t + step) * 128 + 64 + lane]; }
        }
        for (; t < T_TOK; t += 2 * step) {
            int e0nn = 0, e1nn = 0;
            const bool n1 = t + step < T_TOK, n2 = t + 2 * step < T_TOK, n3 = t + 3 * step < T_TOK;
            if (n1) { U_ISSUE(sb, e0n, e1n) xan = *(const u32x4*)(xb_ + (size_t)(t + step) * DM); xbn = *(const u32x4*)(xb_ + (size_t)(t + step) * DM + 8); }
            if (n2) { e0nn = eidx[(size_t)(t + 2 * step) * 128 + lane]; e1nn = eidx[(size_t)(t + 2 * step) * 128 + 64 + lane]; }
            U_COMPUTE(sa, t)
            if (n1) {
                xa = xan; xb = xbn;
                if (n2) { U_ISSUE(sa, e0nn, e1nn) xan = *(const u32x4*)(xb_ + (size_t)(t + 2 * step) * DM); xbn = *(const u32x4*)(xb_ + (size_t)(t + 2 * step) * DM + 8); }
                if (n3) { e0n = eidx[(size_t)(t + 3 * step) * 128 + lane]; e1n = eidx[(size_t)(t + 3 * step) * 128 + 64 + lane]; }
                U_COMPUTE(sb, t + step)
                xa = xan; xb = xbn;
            }
        }
#undef U_ISSUE
#undef U_COMPUTE
    }
}
DI void peer_hw_phase(const float* __restrict__ ph, const int* __restrict__ eidx, const float* __restrict__ su, const float* __restrict__ sv, float* __restrict__ gws) {
    const size_t n = (size_t)T_TOK * 128, nthreads = (size_t)gridDim.x * blockDim.x;
    for (size_t i = (size_t)blockIdx.x * blockDim.x + threadIdx.x; i < n; i += nthreads) {
        float hsum = 0.f;
#pragma unroll
        for (int j = 0; j < 8; ++j) hsum += ph[(size_t)j * n + i];
        const int e = eidx[i];
        gws[i] = gws[i] * gelu_exact(hsum * su[e]) * sv[e];
    }
}
DI void peer_v_phase(const bf16_t* __restrict__ x1, const int* __restrict__ eidx, const float* __restrict__ wgt, const unsigned char* __restrict__ V8, bf16_t* __restrict__ y) {
    int tidv = threadIdx.x;
    asm volatile("" : "+v"(tidv));
    const int lane = tidv & 63, w = tidv >> 6, grp = lane >> 3, l8 = lane & 7;
    const SliceMap sm = slice_map(w);
    for (int j_ = sm.j0; j_ < 8 * REP_PV; j_ += sm.jstep) {
        const int j = j_ & 7;
        const unsigned char* vb = V8 + 128 * j + 16 * l8;
        const int col = 128 * j + 16 * l8 + 2 * grp;
        const int step = sm.nslot;
        int t = sm.wslot;
        if (t >= T_TOK) continue;
        u32x4 sa[16], sb[16];
        int e0n = 0, e1n = 0;
        float w0, w1, w0n = 0.f, w1n = 0.f;
#define V_ISSUE(SEG, E0, E1) { _Pragma("unroll") for (int b = 0; b < 16; ++b) { const int e = __shfl((b < 8) ? (E0) : (E1), (b & 7) * 8 + grp); SEG[b] = *(const u32x4*)(vb + (size_t)e * DM); } }
#define V_COMPUTE(SEG, TT) { f32x2 acc[8]; \
            _Pragma("unroll") for (int i = 0; i < 8; ++i) { acc[i].x = 0.f; acc[i].y = 0.f; } \
            _Pragma("unroll") for (int b = 0; b < 16; ++b) { const float wv = __shfl((b < 8) ? w0 : w1, (b & 7) * 8 + grp); axpy_fp8_row(acc, wv, SEG[b]); } \
            float a8[8], a4[4], a2[2]; \
            { const bool hi = (lane & 32) != 0; _Pragma("unroll") for (int i = 0; i < 8; ++i) { const float lo_ = (i & 1) ? acc[i >> 1].y : acc[i >> 1].x, hi_ = (i & 1) ? acc[4 + (i >> 1)].y : acc[4 + (i >> 1)].x; \
                const float keep = hi ? hi_ : lo_, send = hi ? lo_ : hi_; a8[i] = keep + __shfl_xor(send, 32); } } \
            { const bool hi = (lane & 16) != 0; _Pragma("unroll") for (int i = 0; i < 4; ++i) { const float keep = hi ? a8[i + 4] : a8[i], send = hi ? a8[i] : a8[i + 4]; a4[i] = keep + __shfl_xor(send, 16); } } \
            { const bool hi = (lane & 8) != 0; _Pragma("unroll") for (int i = 0; i < 2; ++i) { const float keep = hi ? a4[i + 2] : a4[i], send = hi ? a4[i] : a4[i + 2]; a2[i] = keep + __shfl_xor(send, 8); } } \
            const unsigned xr = *(const unsigned*)(x1 + (size_t)(TT) * DM + col); \
            *(unsigned*)(y + (size_t)(TT) * DM + col) = pk_bf16(DN_ALPHA * bf_lo(xr) + a2[0], DN_ALPHA * bf_hi(xr) + a2[1]); }
        {
            const int e0 = eidx[(size_t)t * 128 + lane], e1 = eidx[(size_t)t * 128 + 64 + lane];
            w0 = wgt[(size_t)t * 128 + lane]; w1 = wgt[(size_t)t * 128 + 64 + lane];
            V_ISSUE(sa, e0, e1)
            if (t + step < T_TOK) { e0n = eidx[(size_t)(t + step) * 128 + lane]; e1n = eidx[(size_t)(t + step) * 128 + 64 + lane]; }
        }
        for (; t < T_TOK; t += 2 * step) {
            int e0nn = 0, e1nn = 0;
            const bool n1 = t + step < T_TOK, n2 = t + 2 * step < T_TOK, n3 = t + 3 * step < T_TOK;
            if (n1) { V_ISSUE(sb, e0n, e1n) w0n = wgt[(size_t)(t + step) * 128 + lane]; w1n = wgt[(size_t)(t + step) * 128 + 64 + lane]; }
            if (n2) { e0nn = eidx[(size_t)(t + 2 * step) * 128 + lane]; e1nn = eidx[(size_t)(t + 2 * step) * 128 + 64 + lane]; }
            V_COMPUTE(sa, t)
            if (n1) {
                w0 = w0n; w1 = w1n;
                if (n2) { V_ISSUE(sa, e0nn, e1nn) w0n = wgt[(size_t)(t + 2 * step) * 128 + lane]; w1n = wgt[(size_t)(t + 2 * step) * 128 + 64 + lane]; }
                if (n3) { e0n = eidx[(size_t)(t + 3 * step) * 128 + lane]; e1n = eidx[(size_t)(t + 3 * step) * 128 + 64 + lane]; }
                V_COMPUTE(sb, t + step)
                w0 = w0n; w1 = w1n;
            }
        }
#undef V_ISSUE
#undef V_COMPUTE
    }
}

#define XB_TMO      128
#define XB_XCNT(j)  (256  + 64 * (j))
#define XB_XSUB(j)  (1280 + 64 * (j))
#define XB_XGEN(j)  (2304 + 64 * (j))
#define XB_TOP      3328
#define XB_TOPGEN   3392
#define XCD_BAR_WORDS 3456
#define XB_SPIN_CAP (1u << 22)
#define LAS __attribute__((address_space(3)))

__device__ __forceinline__ unsigned xb_ld(unsigned* p)              { return __hip_atomic_load(p, __ATOMIC_RELAXED, __HIP_MEMORY_SCOPE_AGENT); }
__device__ __forceinline__ unsigned xb_add(unsigned* p, unsigned v) { return __hip_atomic_fetch_add(p, v, __ATOMIC_RELAXED, __HIP_MEMORY_SCOPE_AGENT); }
__device__ __forceinline__ unsigned xb_xcc_id() { return (unsigned)__builtin_amdgcn_s_getreg((3 << 11) | 20) & 0xFu; }
#define XB_SPIN(cond, bar) do { unsigned _sp = 0; while (cond) { __builtin_amdgcn_s_sleep(1); \
    if ((++_sp & 255u) == 0u) { if (xb_ld(&(bar)[XB_TMO])) break; if (_sp > XB_SPIN_CAP) { atomicAdd(&(bar)[XB_TMO], 1u); break; } } } } while (0)

struct XcdBarrier {
    unsigned* bar; unsigned x;
    volatile LAS unsigned* st;
};

__device__ __forceinline__ XcdBarrier xcd_barrier_post(unsigned* bar, volatile LAS unsigned* st) {
    XcdBarrier b; b.bar = bar; b.x = xb_xcc_id(); b.st = st;
    if (threadIdx.x == 0) (void)xb_add(&bar[XB_XCNT(b.x)], 1u);
    return b;
}
__device__ __forceinline__ void xcd_barrier_complete(unsigned* bar, unsigned x, unsigned& nloc, unsigned& nx) {
    const unsigned G = gridDim.x * gridDim.y * gridDim.z;
    unsigned sum, cnt, mine, sp = 0u;
    for (;;) {
        sum = 0u; cnt = 0u; mine = 0u;
#pragma unroll
        for (unsigned j = 0; j < 16; ++j) { const unsigned c = xb_ld(&bar[XB_XCNT(j)]); sum += c; cnt += (c > 0u) ? 1u : 0u; mine = (j == x) ? c : mine; }
        if (sum == G) break;
        __builtin_amdgcn_s_sleep(1);
        if ((++sp & 255u) == 0u) { if (xb_ld(&bar[XB_TMO])) break; if (sp > XB_SPIN_CAP) { atomicAdd(&bar[XB_TMO], 1u); break; } }
    }
    nloc = mine > 0u ? mine : 1u; nx = cnt > 0u ? cnt : 1u;
}

__device__ __forceinline__ void xcd_barrier(const XcdBarrier& b) {
    asm volatile("s_waitcnt vmcnt(0)" ::: "memory");
    __syncthreads();
    if (threadIdx.x == 0) {
        unsigned* bar = b.bar;
        __builtin_amdgcn_s_waitcnt(0);
        unsigned nloc = b.st[0], nx = b.st[1];
        if (nloc == 0u) { xcd_barrier_complete(bar, b.x, nloc, nx); b.st[0] = nloc; b.st[1] = nx; }
        const unsigned old = xb_add(&bar[XB_XSUB(b.x)], 1u);
        const unsigned gen = old / nloc;
        if (old + 1u == (gen + 1u) * nloc) {
            __builtin_amdgcn_fence(__ATOMIC_RELEASE, "agent");
            asm volatile("s_waitcnt vmcnt(0)" ::: "memory");
            const unsigned og = xb_add(&bar[XB_TOP], 1u);
            const unsigned tg = og / nx;
            if (og + 1u == (tg + 1u) * nx) xb_add(&bar[XB_TOPGEN], 1u);
            else XB_SPIN(xb_ld(&bar[XB_TOPGEN]) == tg, bar);
            __builtin_amdgcn_fence(__ATOMIC_ACQUIRE, "agent");
            xb_add(&bar[XB_XGEN(b.x)], 1u);
            asm volatile("s_waitcnt vmcnt(0)" ::: "memory");
        } else {
            XB_SPIN(xb_ld(&bar[XB_XGEN(b.x)]) == gen, bar);
            __builtin_amdgcn_fence(__ATOMIC_ACQUIRE, "agent");
            asm volatile("s_waitcnt vmcnt(0)" ::: "memory");
        }
    }
    __syncthreads();
}


DI void gsync(cg::grid_group& g) {
    asm volatile("s_waitcnt vmcnt(0) lgkmcnt(0)" ::: "memory");
    g.sync();
    if (threadIdx.x == 0) { __builtin_amdgcn_fence(__ATOMIC_ACQUIRE, "agent"); asm volatile("s_waitcnt vmcnt(0)" ::: "memory"); }
    __syncthreads();
}

__global__ void __launch_bounds__(256, 2) mega_fwd(Params P) {
    extern __shared__ __attribute__((aligned(16))) unsigned char lds[];
    cg::grid_group grid = cg::this_grid();
    volatile LAS unsigned* xb_st = (volatile LAS unsigned*)(lds + LDS_PHASE_BYTES);
    if (threadIdx.x == 0) { xb_st[0] = 0u; xb_st[1] = 0u; }
    __syncthreads();
    const XcdBarrier xbar = xcd_barrier_post((unsigned*)(P.ws + W_BAR), xb_st);
    unsigned char* ws = P.ws;
    bf16_t* r0 = (bf16_t*)(ws + R0);
    bf16_t* r1 = (bf16_t*)(ws + R1);
    bf16_t* r2 = (bf16_t*)(ws + R2);
    bf16_t* r3 = (bf16_t*)(ws + R3);
    int* eidx = (int*)(ws + R4);
    float* gws = (float*)(ws + R4 + 32 * MBy);
    unsigned char* U8 = ws + R5;
    unsigned char* V8 = ws + R5 + 32 * MBy;
    float* su = (float*)(ws + W_SCALE);
    float* sv = su + 2 * 16384;
    bf16_t* w_daqkv = (bf16_t*)(ws + W_DAQKV);
    bf16_t* w_dawo = (bf16_t*)(ws + W_DAWO);
    bf16_t* w_swqkv = (bf16_t*)(ws + W_SWQKV);
    bf16_t* w_swwo = (bf16_t*)(ws + W_SWWO);
    bf16_t* w_pkq0 = (bf16_t*)(ws + W_PKQ0);
    bf16_t* w_pkq1 = (bf16_t*)(ws + W_PKQ1);
    bf16_t* subk = (bf16_t*)(ws + W_SUBK);
    f32x2* rope = (f32x2*)(ws + W_ROPE);
    float* yf = (float*)(ws + R0);
    bf16_t* yb = (bf16_t*)(ws + R0);
    constexpr size_t TD = (size_t)T_TOK * DM;
    constexpr size_t NE = (size_t)16384 * DM;

    convert_flat(P.x, r1, TD);
    convert_rows_fp8(P.pk_u, U8, su, 2 * 16384);
    convert_rows_fp8(P.pk_v, V8, sv, 2 * 16384);
    convert_flat(P.pk_sub_keys, subk, (size_t)2 * 8 * 2 * 128 * 64);
    transpose_convert(P.da_w_qkv, w_daqkv, 3072, (float*)lds);
    transpose_convert(P.da_w_o, w_dawo, 1024, (float*)lds);
    transpose_convert(P.sw_w_qkv, w_swqkv, 1280, (float*)lds);
    transpose_convert(P.sw_w_o, w_swwo, 1024, (float*)lds);
    transpose_convert(P.pk_w_query, w_pkq0, 1024, (float*)lds);
    transpose_convert(P.pk_w_query + (size_t)1024 * 1024, w_pkq1, 1024, (float*)lds);
    rope_table(rope);
    gsync(grid);

    {
        bf16_t* q = r0; bf16_t* k = r0 + TD; bf16_t* vt = r0 + 2 * TD;
        EpiQKV e{q, k, vt, rope, nullptr, 1024, 1024, 7, 8};
        gemm_phase(r1, w_daqkv, T_TOK, 2048, 1024, lds, e);
        { EpiVt ev{vt, nullptr, 7, 8}; gemm_phase<EpiVt, true>(r1, w_daqkv + (size_t)2048 * 1024, T_TOK, 1024, 1024, lds, ev); }
        xcd_barrier(xbar);
        AttnArgs a{q, k, vt, r2, P.da_lambda, P.da_subln_g, nullptr, nullptr};
        attn_phase<0>(a, lds);
        xcd_barrier(xbar);
        diff_combine_phase(r2, P.da_lambda, P.da_subln_g, r1);
        xcd_barrier(xbar);
        EpiRes<true> er{(const void*)P.x, nullptr, yb};
        gemm_phase(r1, w_dawo, T_TOK, 1024, 1024, lds, er);
        xcd_barrier(xbar);
        ln_phase(yb, P.ln1_g, P.ln1_b, r2);
        xcd_barrier(xbar);
        EpiBf16 eq{r3};
        gemm_phase(r2, w_pkq0, T_TOK, 1024, 1024, lds, eq);
        xcd_barrier(xbar);
        peer_topk_phase(r3, subk, eidx, gws);
        xcd_barrier(xbar);
        peer_u_phase(r2, eidx, U8, yf);
        xcd_barrier(xbar);
        peer_hw_phase(yf, eidx, su, sv, gws);
        xcd_barrier(xbar);
        peer_v_phase(r2, eidx, gws, V8, yb);
        xcd_barrier(xbar);
        ln_phase(yb, P.ln2_g, P.ln2_b, r1);
        xcd_barrier(xbar);
    }
    {
        bf16_t* q = r0; bf16_t* k = r0 + TD; bf16_t* vt = k + (size_t)T_TOK * 128;
        EpiQKV e{q, k, vt, rope, P.sw_b_qkv, 1024, 128, 6, 2};
        gemm_phase(r1, w_swqkv, T_TOK, 1152, 1024, lds, e);
        { EpiVt ev{vt, P.sw_b_qkv + 1152, 6, 2}; gemm_phase<EpiVt, true>(r1, w_swqkv + (size_t)1152 * 1024, T_TOK, 128, 1024, lds, ev); }
        xcd_barrier(xbar);
        AttnArgs a{q, k, vt, r2, nullptr, nullptr, P.sw_sinks, nullptr};
        attn_phase<1>(a, lds);
        xcd_barrier(xbar);
        EpiRes<false> er{(const void*)r1, P.sw_b_o, yb};
        gemm_phase(r2, w_swwo, T_TOK, 1024, 1024, lds, er);
        xcd_barrier(xbar);
        ln_phase(yb, P.ln1_g + DM, P.ln1_b + DM, r3);
        xcd_barrier(xbar);
        EpiBf16 eq{r2};
        gemm_phase(r3, w_pkq1, T_TOK, 1024, 1024, lds, eq);
        xcd_barrier(xbar);
        peer_topk_phase(r2, subk + (size_t)8 * 2 * 128 * 64, eidx, gws);
        xcd_barrier(xbar);
        peer_u_phase(r3, eidx, U8 + NE, yf);
        xcd_barrier(xbar);
        peer_hw_phase(yf, eidx, su + 16384, sv + 16384, gws);
        xcd_barrier(xbar);
        peer_v_phase(r3, eidx, gws, V8 + NE, yb);
        xcd_barrier(xbar);
        ln_phase(yb, P.ln2_g + DM, P.ln2_b + DM, nullptr, P.out);
    }
}

extern "C" void kernel_launch(void* const* d_in, const int* in_sizes, int n_in, void* d_out, int out_size, void* d_ws, size_t ws_size, hipStream_t stream) {
    static int grid_blocks = 0;
    if (grid_blocks == 0) {
        if (n_in != 18 || ws_size < WS_END) { fprintf(stderr, "kernel_launch: unexpected n_in %d or ws_size %zu (< %zu)\n", n_in, ws_size, (size_t)WS_END); grid_blocks = -1; return; }
        int dev = 0, cus = 0, per_cu = 0;
        hipGetDevice(&dev);
        hipDeviceGetAttribute(&cus, hipDeviceAttributeMultiprocessorCount, dev);
        if (hipFuncSetAttribute((const void*)mega_fwd, hipFuncAttributeMaxDynamicSharedMemorySize, LDS_BYTES) != hipSuccess) { fprintf(stderr, "kernel_launch: hipFuncSetAttribute failed\n"); grid_blocks = -1; return; }
        if (hipOccupancyMaxActiveBlocksPerMultiprocessor(&per_cu, (const void*)mega_fwd, 256, LDS_BYTES) != hipSuccess || per_cu < 1) { fprintf(stderr, "kernel_launch: occupancy query failed (%d)\n", per_cu); per_cu = 1; (void)hipGetLastError(); }
        grid_blocks = cus * per_cu;
        fprintf(stderr, "kernel_launch: grid %d (%d CUs x %d)\n", grid_blocks, cus, per_cu);
    }
    if (grid_blocks < 0) return;
    Params p{};
    p.x = (const float*)d_in[0]; p.da_w_qkv = (const float*)d_in[1]; p.da_lambda = (const float*)d_in[2]; p.da_subln_g = (const float*)d_in[3]; p.da_w_o = (const float*)d_in[4];
    p.sw_w_qkv = (const float*)d_in[5]; p.sw_b_qkv = (const float*)d_in[6]; p.sw_sinks = (const float*)d_in[7]; p.sw_w_o = (const float*)d_in[8]; p.sw_b_o = (const float*)d_in[9];
    p.pk_w_query = (const float*)d_in[10]; p.pk_sub_keys = (const float*)d_in[11]; p.pk_u = (const float*)d_in[12]; p.pk_v = (const float*)d_in[13];
    p.ln1_g = (const float*)d_in[14]; p.ln1_b = (const float*)d_in[15]; p.ln2_g = (const float*)d_in[16]; p.ln2_b = (const float*)d_in[17];
    p.out = (float*)d_out; p.ws = (unsigned char*)d_ws;
    if (hipMemsetAsync((unsigned char*)d_ws + W_BAR, 0, XCD_BAR_WORDS * sizeof(unsigned), stream) != hipSuccess) { fprintf(stderr, "kernel_launch: hipMemsetAsync failed\n"); return; }
    void* args[] = {&p};
    hipError_t e = hipLaunchCooperativeKernel((const void*)mega_fwd, dim3(grid_blocks), dim3(256), args, LDS_BYTES, stream);
    if (e != hipSuccess) fprintf(stderr, "cooperative launch failed: %s (grid %d)\n", hipGetErrorString(e), grid_blocks);
}
```

```cpp
#include <hip/hip_runtime.h>
#include <hip/hip_cooperative_groups.h>
#include <cstdio>
#include <cstdint>
namespace cg = cooperative_groups;

#define DI __device__ __forceinline__
typedef unsigned short bf16_t;
typedef short bf16x8 __attribute__((ext_vector_type(8)));
typedef float f32x16 __attribute__((ext_vector_type(16)));
typedef float f32x4 __attribute__((ext_vector_type(4)));
typedef float f32x2 __attribute__((ext_vector_type(2)));
typedef unsigned u32x4 __attribute__((ext_vector_type(4)));
typedef unsigned u32x2 __attribute__((ext_vector_type(2)));
typedef __bf16 bf16x2_t __attribute__((ext_vector_type(2)));
#define MFMA(a, b, c) __builtin_amdgcn_mfma_f32_32x32x16_bf16((a), (b), (c), 0, 0, 0)

constexpr int T_TOK = 65536, DM = 1024, SEQ = 8192;
constexpr float DN_ALPHA = 1.41421356237309515f;
constexpr float LN_EPS = 1e-5f;
constexpr float LOG2E = 1.44269504088896341f;
constexpr float LAMBDA_INIT0 = 0.2f;

constexpr size_t MBy = 1u << 20;
constexpr size_t R0 = 0, R1 = 384 * MBy, R2 = 512 * MBy, R3 = 640 * MBy, R4 = 768 * MBy, R5 = 832 * MBy, R6 = 960 * MBy;
constexpr size_t W_DAQKV = R6, W_DAWO = R6 + 6 * MBy, W_SWQKV = R6 + 8 * MBy, W_SWWO = R6 + 11 * MBy, W_PKQ0 = R6 + 13 * MBy, W_PKQ1 = R6 + 15 * MBy,
                 W_SUBK = R6 + 17 * MBy, W_ROPE = R6 + 18 * MBy, W_SCALE = R6 + 20 * MBy, W_BAR = R6 + 21 * MBy, WS_END = R6 + 22 * MBy;
constexpr int LDS_PHASE_BYTES = 73728, LDS_BYTES = LDS_PHASE_BYTES + 16;
#ifndef REP_GEMM
#define REP_GEMM 1
#endif
#ifndef REP_ATT0
#define REP_ATT0 1
#endif
#ifndef REP_ATT1
#define REP_ATT1 1
#endif
#ifndef REP_TOPK
#define REP_TOPK 1
#endif
#ifndef REP_GATHER
#define REP_GATHER 1
#endif
#ifndef REP_P0
#define REP_P0 1
#endif
#ifndef REP_PU
#define REP_PU 1
#endif
#ifndef REP_PV
#define REP_PV 1
#endif

__constant__ float c_inv_freq[32] = {
    1.000000000e+00f, 7.498942018e-01f, 5.623413324e-01f, 4.216965139e-01f, 3.162277639e-01f, 2.371373922e-01f, 1.778279394e-01f, 1.333521456e-01f,
    1.000000015e-01f, 7.498941571e-02f, 5.623412877e-02f, 4.216964915e-02f, 3.162277862e-02f, 2.371373586e-02f, 1.778279431e-02f, 1.333521493e-02f,
    9.999999776e-03f, 7.498942316e-03f, 5.623413250e-03f, 4.216964822e-03f, 3.162277862e-03f, 2.371373819e-03f, 1.778279431e-03f, 1.333521446e-03f,
    1.000000047e-03f, 7.498941850e-04f, 5.623413017e-04f, 4.216965463e-04f, 3.162277862e-04f, 2.371373848e-04f, 1.778279402e-04f, 1.333521504e-04f};

struct Params {
    const float* x; const float* da_w_qkv; const float* da_lambda; const float* da_subln_g; const float* da_w_o;
    const float* sw_w_qkv; const float* sw_b_qkv; const float* sw_sinks; const float* sw_w_o; const float* sw_b_o;
    const float* pk_w_query; const float* pk_sub_keys; const float* pk_u; const float* pk_v;
    const float* ln1_g; const float* ln1_b; const float* ln2_g; const float* ln2_b;
    float* out; unsigned char* ws;
};

DI unsigned pk_bf16(float a, float b) { f32x2 f = {a, b}; return __builtin_bit_cast(unsigned, __builtin_convertvector(f, bf16x2_t)); }
DI bf16_t to_bf16(float a) { return (bf16_t)(pk_bf16(a, a) & 0xffffu); }
DI float bf_lo(unsigned u) { return __uint_as_float(u << 16); }
DI float bf_hi(unsigned u) { return __uint_as_float(u & 0xffff0000u); }
DI float wave_sum(float v) {
#pragma unroll
    for (int o = 32; o >= 1; o >>= 1) v += __shfl_xor(v, o);
    return v;
}

DI void convert_flat(const float* __restrict__ src, bf16_t* __restrict__ dst, size_t n) {
    const size_t nthreads = (size_t)gridDim.x * blockDim.x;
    for (size_t i_ = (size_t)blockIdx.x * blockDim.x + threadIdx.x; i_ < (n / 8) * REP_P0; i_ += nthreads) {
        const size_t i = (REP_P0 == 1) ? i_ : i_ % (n / 8);
        const f32x4 a = ((const f32x4*)src)[2 * i], b = ((const f32x4*)src)[2 * i + 1];
        u32x4 o; o.x = pk_bf16(a.x, a.y); o.y = pk_bf16(a.z, a.w); o.z = pk_bf16(b.x, b.y); o.w = pk_bf16(b.z, b.w);
        ((u32x4*)dst)[i] = o;
    }
}
DI void transpose_convert(const float* __restrict__ src, bf16_t* __restrict__ dst, int N, float* ldsf) {
    const int tilesN = N >> 6, ntiles = 16 * tilesN;
    const int tx = threadIdx.x & 63, ty = threadIdx.x >> 6;
    for (int tile = blockIdx.x; tile < ntiles; tile += gridDim.x) {
        const int tk = tile / tilesN, tn = tile - tk * tilesN;
        __syncthreads();
#pragma unroll
        for (int i = 0; i < 16; ++i) { const int k = ty + 4 * i; ldsf[k * 65 + tx] = src[(size_t)(tk * 64 + k) * N + tn * 64 + tx]; }
        __syncthreads();
#pragma unroll
        for (int i = 0; i < 16; ++i) { const int n = ty + 4 * i; dst[(size_t)(tn * 64 + n) * 1024 + tk * 64 + tx] = to_bf16(ldsf[tx * 65 + n]); }
    }
}
DI void rope_table(f32x2* rope) {
    const int nthreads = gridDim.x * blockDim.x;
    for (int i = blockIdx.x * blockDim.x + threadIdx.x; i < SEQ * 32; i += nthreads) {
        const int pos = i >> 5, j = i & 31;
        const float ang = (float)pos * c_inv_freq[j];
        const float kf = rintf(ang * 0.636619772367581343f);
        float rr = fmaf(-kf, 1.57079637050628662109375f, ang);
        rr = fmaf(-kf, -4.37113882867379294e-8f, rr);
        const float r2 = rr * rr;
        const float sn = rr + rr * r2 * (-1.6666654611e-1f + r2 * (8.3321608736e-3f + r2 * (-1.9515295891e-4f)));
        const float cs = 1.0f - 0.5f * r2 + r2 * r2 * (4.166664568298827e-2f + r2 * (-1.388731625493765e-3f + r2 * 2.443315711809948e-5f));
        const int q = ((int)kf) & 3;
        float c, s;
        if (q == 0) { c = cs; s = sn; } else if (q == 1) { c = -sn; s = cs; } else if (q == 2) { c = -cs; s = -sn; } else { c = sn; s = -cs; }
        f32x2 o = {c, s};
        rope[i] = o;
    }
}

DI void store_row32_bf16(bf16_t* rowp, const u32x2 (&A)[4], int h) {
#pragma unroll
    for (int gp = 0; gp < 2; ++gp) {
        const auto r0 = __builtin_amdgcn_permlane32_swap(A[2 * gp].x, A[2 * gp + 1].x, false, false);
        const auto r1 = __builtin_amdgcn_permlane32_swap(A[2 * gp].y, A[2 * gp + 1].y, false, false);
        u32x4 wv = {(unsigned)r0[0], (unsigned)r1[0], (unsigned)r0[1], (unsigned)r1[1]};
        *(u32x4*)(rowp + 16 * gp + 8 * h) = wv;
    }
}

template <class Epi, bool SW = false>
DI void gemm_phase(const bf16_t* __restrict__ A, const bf16_t* __restrict__ Bt, int M, int N, int K, unsigned char* lds, const Epi& epi) {
    constexpr int STR = 144, TB = 128 * STR;
    const int tid = threadIdx.x, lane = tid & 63, w = tid >> 6, wm = w >> 1, wn = w & 1, r = lane & 31, h = lane >> 5;
    const int tilesN = N >> 7, ntiles = (M >> 7) * tilesN, nk = K >> 6;
    const int lrow = tid >> 3, lcol = tid & 7;
    const int G = gridDim.x, tilesM = M >> 7;
    const bool xcd_order = (G & 7) == 0;
    const int nlb = xcd_order ? (G >> 3) : 1, PW = (tilesN & 7) == 0 ? 8 : tilesN;
    const int npad = ((ntiles + G - 1) / G) * G;
    for (int tile_ = blockIdx.x; tile_ < npad * REP_GEMM; tile_ += G) {
        int tile = (REP_GEMM == 1) ? tile_ : tile_ % npad;
        if (xcd_order) {
            const int rd = tile / G, c = tile - rd * G;
            const int lin = ((rd << 3) + (c & 7)) * nlb + (c >> 3);
            tile = lin;
        }
        if (tile >= ntiles) continue;
        const int pnl = tile / (tilesM * PW), rem = tile - pnl * (tilesM * PW);
        const int tm = rem / PW, tn = pnl * PW + (rem - tm * PW);
        const bf16_t* Ag = A + (size_t)(tm * 128 + lrow) * K + lcol * 8;
        const bf16_t* Bg = Bt + (size_t)(tn * 128 + lrow) * K + lcol * 8;
        u32x4 ra0[4], rb0[4], ra1[4], rb1[4];
#define GEMM_LOAD(RA, RB, KT) { _Pragma("unroll") for (int i = 0; i < 4; ++i) { RA[i] = *(const u32x4*)(Ag + (size_t)(32 * i) * K + (KT) * 64); RB[i] = *(const u32x4*)(Bg + (size_t)(32 * i) * K + (KT) * 64); } }
#define GEMM_STORE(RA, RB, BUF) { _Pragma("unroll") for (int i = 0; i < 4; ++i) { *(u32x4*)(lds + (BUF) * TB + (lrow + 32 * i) * STR + lcol * 16) = RA[i]; *(u32x4*)(lds + 2 * TB + (BUF) * TB + (lrow + 32 * i) * STR + lcol * 16) = RB[i]; } }
#define GEMM_COMPUTE(BUF) { \
            const unsigned char* la = lds + (BUF) * TB + (wm * 64 + r) * STR + h * 16; \
            const unsigned char* lb = lds + 2 * TB + (BUF) * TB + (wn * 64 + r) * STR + h * 16; \
            _Pragma("unroll") for (int ks = 0; ks < 4; ++ks) { \
                bf16x8 af[2], bfr[2]; \
                _Pragma("unroll") for (int mi = 0; mi < 2; ++mi) af[mi] = *(const bf16x8*)(la + mi * 32 * STR + ks * 32); \
                _Pragma("unroll") for (int ni = 0; ni < 2; ++ni) bfr[ni] = *(const bf16x8*)(lb + ni * 32 * STR + ks * 32); \
                _Pragma("unroll") for (int mi = 0; mi < 2; ++mi) \
                    _Pragma("unroll") for (int ni = 0; ni < 2; ++ni) acc[mi][ni] = SW ? MFMA(af[mi], bfr[ni], acc[mi][ni]) : MFMA(bfr[ni], af[mi], acc[mi][ni]); \
            } }
        GEMM_LOAD(ra0, rb0, 0)
        if (nk > 1) GEMM_LOAD(ra1, rb1, 1)
        f32x16 acc[2][2];
#pragma unroll
        for (int mi = 0; mi < 2; ++mi)
#pragma unroll
            for (int ni = 0; ni < 2; ++ni)
#pragma unroll
                for (int i = 0; i < 16; ++i) acc[mi][ni][i] = 0.f;
        GEMM_STORE(ra0, rb0, 0)
        __syncthreads();
        for (int kt = 0; kt < nk; kt += 2) {
            if (kt + 2 < nk) GEMM_LOAD(ra0, rb0, kt + 2)
            GEMM_COMPUTE(0)
            if (kt + 1 < nk) GEMM_STORE(ra1, rb1, 1)
            __syncthreads();
            if (kt + 1 < nk) {
                if (kt + 3 < nk) GEMM_LOAD(ra1, rb1, kt + 3)
                GEMM_COMPUTE(1)
                if (kt + 2 < nk) GEMM_STORE(ra0, rb0, 0)
                __syncthreads();
            }
        }
#undef GEMM_LOAD
#undef GEMM_STORE
#undef GEMM_COMPUTE
        epi(acc, tm * 128 + wm * 64, tn * 128 + wn * 64, r, h);
    }
}

struct EpiQKV {
    bf16_t* q; bf16_t* k; bf16_t* vt; const f32x2* rope; const float* bias; int nq, nk, dv_shift, hv;
    DI void operator()(const f32x16 (&acc)[2][2], int m0, int n0, int r, int h) const {
        if (n0 < nq + nk) {
            const bool isq = n0 < nq;
            bf16_t* dst = isq ? q + n0 : k + (n0 - nq);
            const int ld = isq ? nq : nk;
            const float qs = isq ? 0.125f * LOG2E : 1.0f;
#pragma unroll
            for (int mi = 0; mi < 2; ++mi) {
                const int m = m0 + mi * 32 + r, pos = m & (SEQ - 1);
                const f32x4* rp = (const f32x4*)(rope + pos * 32);
                u32x2 A1[4], A2[4];
#pragma unroll
                for (int g = 0; g < 4; ++g) {
                    const int j0 = 8 * g + 4 * h;
                    const f32x4 cs01 = rp[j0 >> 1], cs23 = rp[(j0 >> 1) + 1];
                    f32x4 b1 = {0.f, 0.f, 0.f, 0.f}, b2 = {0.f, 0.f, 0.f, 0.f};
                    if (bias) { b1 = *(const f32x4*)(bias + n0 + j0); b2 = *(const f32x4*)(bias + n0 + 32 + j0); }
                    const float c[4] = {cs01.x, cs01.z, cs23.x, cs23.z}, s[4] = {cs01.y, cs01.w, cs23.y, cs23.w};
                    float o1[4], o2[4];
#pragma unroll
                    for (int e = 0; e < 4; ++e) {
                        const float t1 = acc[mi][0][4 * g + e] + b1[e], t2 = acc[mi][1][4 * g + e] + b2[e];
                        o1[e] = (t1 * c[e] - t2 * s[e]) * qs; o2[e] = (t2 * c[e] + t1 * s[e]) * qs;
                    }
                    A1[g].x = pk_bf16(o1[0], o1[1]); A1[g].y = pk_bf16(o1[2], o1[3]); A2[g].x = pk_bf16(o2[0], o2[1]); A2[g].y = pk_bf16(o2[2], o2[3]);
                }
                store_row32_bf16(dst + (size_t)m * ld, A1, h);
                store_row32_bf16(dst + (size_t)m * ld + 32, A2, h);
            }
        }
    }
};
struct EpiVt {
    bf16_t* vt; const float* bias; int dv_shift, hv;
    DI void operator()(const f32x16 (&acc)[2][2], int m0, int n0, int r, int h) const {
        const int b = m0 >> 13, s0 = m0 & (SEQ - 1);
#pragma unroll
        for (int ni = 0; ni < 2; ++ni) {
            const int eg = n0 + ni * 32 + r;
            const float bv = bias ? bias[eg] : 0.f;
            const int hh = eg >> dv_shift, e = eg & ((1 << dv_shift) - 1);
            bf16_t* rowp = vt + ((size_t)((b * hv + hh) << dv_shift) + e) * SEQ + s0;
#pragma unroll
            for (int mi = 0; mi < 2; ++mi) {
                u32x2 A[4];
#pragma unroll
                for (int g = 0; g < 4; ++g) { A[g].x = pk_bf16(acc[mi][ni][4 * g] + bv, acc[mi][ni][4 * g + 1] + bv); A[g].y = pk_bf16(acc[mi][ni][4 * g + 2] + bv, acc[mi][ni][4 * g + 3] + bv); }
                store_row32_bf16(rowp + mi * 32, A, h);
            }
        }
    }
};
template <bool RES_F32> struct EpiRes {
    const void* res; const float* bias; bf16_t* y;
    DI void operator()(const f32x16 (&acc)[2][2], int m0, int n0, int r, int h) const {
#pragma unroll
        for (int mi = 0; mi < 2; ++mi) {
            const int m = m0 + mi * 32 + r;
#pragma unroll
            for (int ni = 0; ni < 2; ++ni) {
                u32x2 A[4];
#pragma unroll
                for (int g = 0; g < 4; ++g) {
                    const int n = n0 + ni * 32 + 8 * g + 4 * h;
                    f32x4 xr;
                    if (RES_F32) xr = *(const f32x4*)((const float*)res + (size_t)m * DM + n);
                    else { const u32x2 u = *(const u32x2*)((const bf16_t*)res + (size_t)m * DM + n); xr.x = bf_lo(u.x); xr.y = bf_hi(u.x); xr.z = bf_lo(u.y); xr.w = bf_hi(u.y); }
                    f32x4 bv = {0.f, 0.f, 0.f, 0.f};
                    if (bias) bv = *(const f32x4*)(bias + n);
                    f32x4 o;
#pragma unroll
                    for (int e = 0; e < 4; ++e) o[e] = DN_ALPHA * xr[e] + acc[mi][ni][4 * g + e] + bv[e];
                    A[g].x = pk_bf16(o[0], o[1]); A[g].y = pk_bf16(o[2], o[3]);
                }
                store_row32_bf16(y + (size_t)m * DM + n0 + ni * 32, A, h);
            }
        }
    }
};
struct EpiBf16 {
    bf16_t* o;
    DI void operator()(const f32x16 (&acc)[2][2], int m0, int n0, int r, int h) const {
#pragma unroll
        for (int mi = 0; mi < 2; ++mi) {
            const int m = m0 + mi * 32 + r;
#pragma unroll
            for (int ni = 0; ni < 2; ++ni) {
                u32x2 A[4];
#pragma unroll
                for (int g = 0; g < 4; ++g) { A[g].x = pk_bf16(acc[mi][ni][4 * g], acc[mi][ni][4 * g + 1]); A[g].y = pk_bf16(acc[mi][ni][4 * g + 2], acc[mi][ni][4 * g + 3]); }
                store_row32_bf16(o + (size_t)m * DM + n0 + ni * 32, A, h);
            }
        }
    }
};

DI void ln_phase(const bf16_t* __restrict__ y, const float* __restrict__ g, const float* __restrict__ b, bf16_t* __restrict__ xo, float* __restrict__ xf = nullptr) {
    const int lane = threadIdx.x & 63, w = threadIdx.x >> 6;
    const int gw = blockIdx.x * 4 + w, nw = gridDim.x * 4;
    f32x4 gv[4], bv[4];
#pragma unroll
    for (int i = 0; i < 4; ++i) { gv[i] = ((const f32x4*)g)[lane + 64 * i]; bv[i] = ((const f32x4*)b)[lane + 64 * i]; }
    for (int row = gw; row < T_TOK; row += nw) {
        const u32x2* yr = (const u32x2*)(y + (size_t)row * DM);
        f32x4 v[4];
#pragma unroll
        for (int i = 0; i < 4; ++i) { const u32x2 u = yr[lane + 64 * i]; v[i].x = bf_lo(u.x); v[i].y = bf_hi(u.x); v[i].z = bf_lo(u.y); v[i].w = bf_hi(u.y); }
        float s = 0.f;
#pragma unroll
        for (int i = 0; i < 4; ++i) s += (v[i].x + v[i].y) + (v[i].z + v[i].w);
        const float mu = wave_sum(s) * (1.0f / DM);
        float q = 0.f;
#pragma unroll
        for (int i = 0; i < 4; ++i) { const f32x4 d = v[i] - mu; q += (d.x * d.x + d.y * d.y) + (d.z * d.z + d.w * d.w); }
        const float rstd = rsqrtf(wave_sum(q) * (1.0f / DM) + LN_EPS);
#pragma unroll
        for (int i = 0; i < 4; ++i) {
            const f32x4 o = (v[i] - mu) * rstd * gv[i] + bv[i];
            if (xf) *(f32x4*)(xf + (size_t)row * DM + 4 * (lane + 64 * i)) = o;
            if (xo) { u32x2 wv = {pk_bf16(o.x, o.y), pk_bf16(o.z, o.w)}; *(u32x2*)(xo + (size_t)row * DM + 4 * (lane + 64 * i)) = wv; }
        }
    }
}

struct AttnArgs {
    const bf16_t* q; const bf16_t* k; const bf16_t* vt; bf16_t* o;
    const float* lam_params; const float* subln_g; const float* sinks; float* scr;
};
DI int pi_perm(int r) { return (r & 0x13) | ((r & 4) << 1) | ((r & 8) >> 1); }

template <int MODE>
DI void attn_phase(const AttnArgs& a, unsigned char* lds) {
    constexpr int DV = MODE == 0 ? 128 : 64, EB = DV / 32;
    constexpr int KSTR = 144, VSTR = 144, KBUF = 64 * KSTR, VBUF = DV * VSTR;
    constexpr int KCH = 2, VCH = DV / 32;
    constexpr int LDK = MODE == 0 ? 1024 : 128, HV = MODE == 0 ? 8 : 2;
    constexpr int NITEMS = 8192;
    const int tid = threadIdx.x, lane = tid & 63, w = tid >> 6, r = lane & 31, h = lane >> 5;
    unsigned char* kl = lds;
    unsigned char* vl = lds + 3 * KBUF;
    const float NEG_INF = -__builtin_inff();
    const int G = gridDim.x;
    const int krow = tid >> 3, kcc = tid & 7;

    constexpr int REPA = MODE == 0 ? REP_ATT0 : REP_ATT1;
    for (int it_ = blockIdx.x; it_ < NITEMS * REPA; it_ += G) {
        const int it = (REPA == 1) ? it_ : it_ % NITEMS;
        int b, qb, qcol0, kcol0, vh, p = 0;
        if (MODE == 0) {
            int bh;
            const int s = it / G, c = it - s * G;
            if (G == 512) { const int jj = c >> 3; bh = (c & 7) + 8 * (s >> 1); p = jj & 1; qb = (s & 1) ? (jj >> 1) : 63 - (jj >> 1); }
            else if (G == 256) { const int jj = c >> 3; bh = (c & 7) + 8 * (s >> 2); p = s & 1; qb = (s & 2) ? jj : 63 - jj; }
            else { bh = it >> 7; p = it & 1; qb = 63 - ((it >> 1) & 63); }
            b = bh >> 3; const int hh = bh & 7; qcol0 = hh * 128; kcol0 = hh * 128; vh = hh;
        } else {
            const int head = it & 15; qb = (it >> 4) & 63; b = it >> 10;
            qcol0 = head * 64; vh = head >> 3; kcol0 = vh * 64;
        }
        const int q0 = qb * 128, qw0 = q0 + 32 * w, qpos = qw0 + r;
        const int kt0 = MODE == 0 ? 0 : ((q0 >= 128 ? q0 - 128 : 0) >> 6), kt1 = (q0 + 128) >> 6;
        const bf16_t* vg = a.vt + (size_t)(b * HV + vh) * DV * SEQ + (size_t)krow * SEQ + kcc * 8;
        const size_t tok = (size_t)b * SEQ + qpos;

        {
            const bf16_t* kg = a.k + (size_t)b * SEQ * LDK + kcol0 + p * 64 + (size_t)krow * LDK + kcc * 8;
            bf16x8 qf[4];
            {
                const bf16_t* qp = a.q + tok * 1024 + qcol0 + p * 64 + h * 8;
#pragma unroll
                for (int ks = 0; ks < 4; ++ks) qf[ks] = *(const bf16x8*)(qp + ks * 16);
            }
            f32x16 O[EB];
#pragma unroll
            for (int eb = 0; eb < EB; ++eb)
#pragma unroll
                for (int i = 0; i < 16; ++i) O[eb][i] = 0.f;
            float mrow = NEG_INF, lsum = 0.f;
            if (MODE == 1) { mrow = a.sinks[it & 15] * LOG2E; lsum = (h == 0) ? 1.0f : 0.0f; }

            u32x4 rk[KCH], rv[VCH];
#define ATT_LOADK(KT) { _Pragma("unroll") for (int i = 0; i < KCH; ++i) rk[i] = *(const u32x4*)(kg + (size_t)((KT) * 64 + 32 * i) * LDK); }
#define ATT_LOADV(KT) { _Pragma("unroll") for (int i = 0; i < VCH; ++i) rv[i] = *(const u32x4*)(vg + (size_t)(32 * i) * SEQ + (KT) * 64); }
#define ATT_STOREK(KT) { unsigned char* kd_ = kl + (((KT) - kt0) % 3) * KBUF; _Pragma("unroll") for (int i = 0; i < KCH; ++i) *(u32x4*)(kd_ + (krow + 32 * i) * KSTR + kcc * 16) = rk[i]; }
#define ATT_STOREV(KT) { unsigned char* vd_ = vl + (((KT) - kt0) & 1) * VBUF; _Pragma("unroll") for (int i = 0; i < VCH; ++i) *(u32x4*)(vd_ + (krow + 32 * i) * VSTR + kcc * 16) = rv[i]; }
            auto s_compute = [&](f32x16 (&sx)[2], const int kt) __attribute__((always_inline)) {
                const unsigned char* kb_ = kl + ((kt - kt0) % 3) * KBUF;
#pragma unroll
                for (int kb = 0; kb < 2; ++kb) {
#pragma unroll
                    for (int i = 0; i < 16; ++i) sx[kb][i] = 0.f;
#pragma unroll
                    for (int ks = 0; ks < 4; ++ks) {
                        const bf16x8 kf = *(const bf16x8*)(kb_ + (kb * 32 + pi_perm(r)) * KSTR + ks * 32 + h * 16);
                        sx[kb] = MFMA(kf, qf[ks], sx[kb]);
                    }
                }
            };
            auto step = [&](f32x16 (&s)[2], f32x16 (&sn)[2], const int kt) __attribute__((always_inline)) {
                const bool more1 = kt + 1 < kt1, more2 = kt + 2 < kt1;
                if (more2) ATT_LOADK(kt + 2)
                if (more1) ATT_LOADV(kt + 1)
                const int key0 = kt * 64;
                bool need_mask = key0 + 63 > qw0;
                if (MODE == 1) need_mask = need_mask || (key0 < qw0 + 31 - 127);
                if (need_mask) {
                    asm volatile("" ::: "memory");
#pragma unroll
                    for (int kb = 0; kb < 2; ++kb)
#pragma unroll
                        for (int i = 0; i < 16; ++i) {
                            const int key = key0 + kb * 32 + 16 * (i >> 3) + 8 * h + (i & 7);
                            bool valid = key <= qpos;
                            if (MODE == 1) valid = valid && (key > qpos - 128);
                            s[kb][i] = valid ? s[kb][i] : NEG_INF;
                        }
                }
                float mx = NEG_INF;
#pragma unroll
                for (int kb = 0; kb < 2; ++kb)
#pragma unroll
                    for (int i = 0; i < 16; ++i) mx = fmaxf(mx, s[kb][i]);
                mx = fmaxf(mx, __shfl_xor(mx, 32));
                if (__builtin_amdgcn_ballot_w64(mx > mrow + 8.0f) != 0ull) {
                    asm volatile("" ::: "memory");
                    const float mnew = fmaxf(mrow, mx);
                    const float alpha = __builtin_amdgcn_exp2f(mrow - mnew);
                    mrow = mnew;
                    lsum *= alpha;
#pragma unroll
                    for (int eb = 0; eb < EB; ++eb)
#pragma unroll
                        for (int i = 0; i < 16; ++i) O[eb][i] *= alpha;
                }
                __builtin_amdgcn_s_setprio(1);
                s_compute(sn, kt + 1);
                f32x2 ps2 = {0.f, 0.f};
#pragma unroll
                for (int kb = 0; kb < 2; ++kb)
#pragma unroll
                    for (int i = 0; i < 16; i += 2) {
                        f32x2 pv = {__builtin_amdgcn_exp2f(s[kb][i] - mrow), __builtin_amdgcn_exp2f(s[kb][i + 1] - mrow)};
                        s[kb][i] = pv.x; s[kb][i + 1] = pv.y; ps2 += pv;
                    }
                lsum += ps2.x + ps2.y;
                bf16x8 pf[2][2];
#pragma unroll
                for (int kb = 0; kb < 2; ++kb)
#pragma unroll
                    for (int s2 = 0; s2 < 2; ++s2) {
                        u32x4 u;
                        u.x = pk_bf16(s[kb][8 * s2 + 0], s[kb][8 * s2 + 1]); u.y = pk_bf16(s[kb][8 * s2 + 2], s[kb][8 * s2 + 3]);
                        u.z = pk_bf16(s[kb][8 * s2 + 4], s[kb][8 * s2 + 5]); u.w = pk_bf16(s[kb][8 * s2 + 6], s[kb][8 * s2 + 7]);
                        pf[kb][s2] = __builtin_bit_cast(bf16x8, u);
                    }
                const unsigned char* vb_ = vl + ((kt - kt0) & 1) * VBUF;
#pragma unroll
                for (int eb = 0; eb < EB; ++eb) {
#pragma unroll
                    for (int kb = 0; kb < 2; ++kb)
#pragma unroll
                        for (int s2 = 0; s2 < 2; ++s2) {
                            const bf16x8 vf = *(const bf16x8*)(vb_ + (eb * 32 + r) * VSTR + (kb * 32 + 16 * s2 + 8 * h) * 2);
                            O[eb] = MFMA(vf, pf[kb][s2], O[eb]);
                        }
                }
                __builtin_amdgcn_s_setprio(0);
                if (more2) ATT_STOREK(kt + 2)
                if (more1) ATT_STOREV(kt + 1)
                __syncthreads();
            };
            ATT_LOADK(kt0) ATT_LOADV(kt0)
            ATT_STOREK(kt0) ATT_STOREV(kt0)
            if (kt0 + 1 < kt1) { ATT_LOADK(kt0 + 1) ATT_STOREK(kt0 + 1) }
            __syncthreads();
            f32x16 sA[2], sB[2];
            s_compute(sA, kt0);
            for (int kt = kt0; kt < kt1; kt += 2) {
                step(sA, sB, kt);
                if (kt + 1 < kt1) step(sB, sA, kt + 1);
            }
#undef ATT_LOADK
#undef ATT_LOADV
#undef ATT_STOREK
#undef ATT_STOREV
            const float inv0 = 1.0f / (lsum + __shfl_xor(lsum, 32));
            bf16_t* op = (MODE == 0) ? a.o + tok * 2048 + qcol0 * 2 + p * 128 : a.o + tok * 1024 + qcol0;
#pragma unroll
            for (int eb = 0; eb < EB; ++eb) {
                u32x2 A[4];
#pragma unroll
                for (int g = 0; g < 4; ++g) { A[g].x = pk_bf16(O[eb][4 * g] * inv0, O[eb][4 * g + 1] * inv0); A[g].y = pk_bf16(O[eb][4 * g + 2] * inv0, O[eb][4 * g + 3] * inv0); }
                store_row32_bf16(op + eb * 32, A, h);
            }
        }
    }
}

DI void diff_combine_phase(const bf16_t* __restrict__ op, const float* __restrict__ lam_params, const float* __restrict__ subln_g, bf16_t* __restrict__ o) {
    const int lane = threadIdx.x & 63, w = threadIdx.x >> 6;
    const int gwave = blockIdx.x * 4 + w, nwave = gridDim.x * 4;
    const float p1 = wave_sum(lam_params[lane] * lam_params[64 + lane]);
    const float p2 = wave_sum(lam_params[128 + lane] * lam_params[192 + lane]);
    const float lam = __expf(p1) - __expf(p2) + LAMBDA_INIT0;
    const int hd = lane >> 3, d0 = 16 * (lane & 7);
    f32x4 gg[4];
#pragma unroll
    for (int i = 0; i < 4; ++i) gg[i] = *(const f32x4*)(subln_g + d0 + 4 * i);
    for (int t = gwave; t < T_TOK; t += nwave) {
        const bf16_t* p0 = op + (size_t)t * 2048 + hd * 256 + d0;
        const u32x4 a0 = *(const u32x4*)p0, a1 = *(const u32x4*)(p0 + 8), b0 = *(const u32x4*)(p0 + 128), b1 = *(const u32x4*)(p0 + 136);
        float v[16];
#pragma unroll
        for (int i = 0; i < 4; ++i) {
            v[2 * i] = bf_lo(a0[i]) - lam * bf_lo(b0[i]); v[2 * i + 1] = bf_hi(a0[i]) - lam * bf_hi(b0[i]);
            v[8 + 2 * i] = bf_lo(a1[i]) - lam * bf_lo(b1[i]); v[8 + 2 * i + 1] = bf_hi(a1[i]) - lam * bf_hi(b1[i]);
        }
        float ss = 0.f;
#pragma unroll
        for (int i = 0; i < 16; ++i) ss += v[i] * v[i];
        ss += __shfl_xor(ss, 1); ss += __shfl_xor(ss, 2); ss += __shfl_xor(ss, 4);
        const float rs = rsqrtf(ss * (1.0f / 128.0f) + LN_EPS) * (1.0f - LAMBDA_INIT0);
        u32x4 w0, w1;
#pragma unroll
        for (int i = 0; i < 4; ++i) {
            const int e = (i & 1) * 2;
            w0[i] = pk_bf16(v[2 * i] * rs * gg[i >> 1][e], v[2 * i + 1] * rs * gg[i >> 1][e + 1]);
            w1[i] = pk_bf16(v[8 + 2 * i] * rs * gg[2 + (i >> 1)][e], v[8 + 2 * i + 1] * rs * gg[2 + (i >> 1)][e + 1]);
        }
        bf16_t* dst = o + (size_t)t * 1024 + hd * 128 + d0;
        *(u32x4*)dst = w0; *(u32x4*)(dst + 8) = w1;
    }
}

DI unsigned f2ord(float f) { const unsigned u = __float_as_uint(f); return (u & 0x80000000u) ? ~u : (u | 0x80000000u); }
DI float ord2f(unsigned o) { const unsigned u = (o & 0x80000000u) ? (o & 0x7fffffffu) : ~o; return __uint_as_float(u); }
__host__ __device__ constexpr int combo_row_start(int a) { int s = 0; for (int i = 0; i < a; ++i) s += 16 / (i + 1); return s; }

constexpr int SORT16[63][2] = {{0,1}, {2,3}, {0,2}, {1,3}, {1,2}, {4,5}, {6,7}, {4,6}, {5,7}, {5,6}, {0,4}, {2,6}, {2,4}, {1,5}, {3,7}, {3,5}, {1,2}, {3,4}, {5,6}, {8,9}, {10,11}, {8,10}, {9,11}, {9,10}, {12,13}, {14,15}, {12,14}, {13,15}, {13,14}, {8,12}, {10,14}, {10,12}, {9,13}, {11,15}, {11,13}, {9,10}, {11,12}, {13,14}, {0,8}, {4,12}, {4,8}, {2,10}, {6,14}, {6,10}, {2,4}, {6,8}, {10,12}, {1,9}, {5,13}, {5,9}, {3,11}, {7,15}, {7,11}, {3,5}, {7,9}, {11,13}, {1,2}, {3,4}, {5,6}, {7,8}, {9,10}, {11,12}, {13,14}};
constexpr int BMERGE16[32][2] = {{0,8}, {1,9}, {2,10}, {3,11}, {4,12}, {5,13}, {6,14}, {7,15}, {0,4}, {1,5}, {2,6}, {3,7}, {8,12}, {9,13}, {10,14}, {11,15}, {0,2}, {1,3}, {4,6}, {5,7}, {8,10}, {9,11}, {12,14}, {13,15}, {0,1}, {2,3}, {4,5}, {6,7}, {8,9}, {10,11}, {12,13}, {14,15}};
DI void cex(unsigned& a, unsigned& b) { const unsigned hi = max(a, b), lo = min(a, b); a = hi; b = lo; }
DI void merge_top16(unsigned (&A)[16], const unsigned (&B)[16]) {
#pragma unroll
    for (int i = 0; i < 16; ++i) A[i] = max(A[i], B[15 - i]);
#pragma unroll
    for (int n = 0; n < 32; ++n) cex(A[BMERGE16[n][0]], A[BMERGE16[n][1]]);
}
DI void peer_topk_phase(const bf16_t* __restrict__ qpk, const bf16_t* __restrict__ subk, int* __restrict__ eidx, float* __restrict__ gout) {
    int tidv = threadIdx.x;
    asm volatile("" : "+v"(tidv));
    const int lane = tidv & 63, w = tidv >> 6, r = lane & 31, h = lane >> 5;
    const int gwave = blockIdx.x * 4 + w, nwave = gridDim.x * 4;
    for (int item_ = gwave; item_ < 2048 * 8 * REP_TOPK; item_ += nwave) {
        const int item = (REP_TOPK == 1) ? item_ : item_ % (2048 * 8);
        const int tt = item >> 3, hh = item & 7, t0 = tt * 32;
        unsigned top[2][16];
#pragma unroll
        for (int c = 0; c < 2; ++c) {
            f32x16 acc[4];
#pragma unroll
            for (int nb = 0; nb < 4; ++nb)
#pragma unroll
                for (int i = 0; i < 16; ++i) acc[nb][i] = 0.f;
            const bf16_t* qp = qpk + (size_t)(t0 + r) * 1024 + hh * 128 + c * 64 + h * 8;
            const bf16_t* kp = subk + ((size_t)(hh * 2 + c) * 128 + r) * 64 + h * 8;
#pragma unroll
            for (int ks = 0; ks < 4; ++ks) {
                const bf16x8 qfr = *(const bf16x8*)(qp + ks * 16);
#pragma unroll
                for (int nb = 0; nb < 4; ++nb) {
                    const bf16x8 kf = *(const bf16x8*)(kp + nb * 32 * 64 + ks * 16);
                    acc[nb] = MFMA(kf, qfr, acc[nb]);
                }
            }
            unsigned key[64];
#pragma unroll
            for (int nb = 0; nb < 4; ++nb)
#pragma unroll
                for (int i = 0; i < 16; ++i) {
                    const int n = nb * 32 + (i & 3) + 8 * (i >> 2) + 4 * h;
                    key[nb * 16 + i] = (f2ord(acc[nb][i]) & ~127u) | (unsigned)(127 - n);
                }
            unsigned g0[16], g1[16], g2[16], g3[16];
#pragma unroll
            for (int i = 0; i < 16; ++i) { g0[i] = key[i]; g1[i] = key[16 + i]; g2[i] = key[32 + i]; g3[i] = key[48 + i]; }
#pragma unroll
            for (int n = 0; n < 63; ++n) { cex(g0[SORT16[n][0]], g0[SORT16[n][1]]); cex(g1[SORT16[n][0]], g1[SORT16[n][1]]); cex(g2[SORT16[n][0]], g2[SORT16[n][1]]); cex(g3[SORT16[n][0]], g3[SORT16[n][1]]); }
            merge_top16(g0, g1); merge_top16(g2, g3); merge_top16(g0, g2);
            unsigned pb[16];
#pragma unroll
            for (int i = 0; i < 16; ++i) pb[i] = (unsigned)__shfl_xor((int)g0[i], 32);
            merge_top16(g0, pb);
#pragma unroll
            for (int i = 0; i < 16; ++i) top[c][i] = g0[i];
        }
        unsigned ck[50];
#pragma unroll
        for (int a = 0; a < 16; ++a)
#pragma unroll
            for (int b = 0; b < 16 / (a + 1); ++b) {
                const float cv = ord2f(top[0][a] & ~127u) + ord2f(top[1][b] & ~127u);
                ck[combo_row_start(a) + b] = (f2ord(cv) & ~255u) | (unsigned)(((15 - a) << 4) | (15 - b));
            }
        unsigned c0[16], c1[16], c2[16], c3[16];
#pragma unroll
        for (int i = 0; i < 16; ++i) { c0[i] = ck[i]; c1[i] = ck[16 + i]; c2[i] = ck[32 + i]; c3[i] = (i < 2) ? ck[48 + i] : 0u; }
#pragma unroll
        for (int n = 0; n < 63; ++n) { cex(c1[SORT16[n][0]], c1[SORT16[n][1]]); cex(c2[SORT16[n][0]], c2[SORT16[n][1]]); }
        merge_top16(c0, c1); merge_top16(c2, c3); merge_top16(c0, c2);
        float sv[16]; int se[16];
#pragma unroll
        for (int rd = 0; rd < 16; ++rd) {
            const unsigned m = c0[rd];
            const int asel = 15 - (int)((m >> 4) & 15u), bsel = 15 - (int)(m & 15u);
            unsigned ka = top[0][0], kb = top[1][0];
#pragma unroll
            for (int i = 1; i < 16; ++i) { ka = (asel == i) ? top[0][i] : ka; kb = (bsel == i) ? top[1][i] : kb; }
            sv[rd] = ord2f(ka & ~127u) + ord2f(kb & ~127u);
            se[rd] = (127 - (int)(ka & 127u)) * 128 + (127 - (int)(kb & 127u));
        }
        float den = 0.f;
        const float mx0 = sv[0];
#pragma unroll
        for (int i = 0; i < 16; ++i) { sv[i] = __expf(sv[i] - mx0); den += sv[i]; }
        const float inv = 1.0f / den;
        const size_t ob = (size_t)(t0 + r) * 128 + hh * 16;
        if (h == 0) {
#pragma unroll
            for (int i = 0; i < 4; ++i) { int4 v = make_int4(se[4 * i], se[4 * i + 1], se[4 * i + 2], se[4 * i + 3]); *(int4*)(eidx + ob + 4 * i) = v; }
        } else {
#pragma unroll
            for (int i = 0; i < 4; ++i) { f32x4 v = {sv[4 * i] * inv, sv[4 * i + 1] * inv, sv[4 * i + 2] * inv, sv[4 * i + 3] * inv}; *(f32x4*)(gout + ob + 4 * i) = v; }
        }
    }
}

DI float gelu_exact(float v) { return 0.5f * v * (1.0f + erff(v * 0.70710678118654752f)); }
DI void convert_rows_fp8(const float* __restrict__ src, unsigned char* __restrict__ dst, float* __restrict__ inv, int nrows) {
    const int lane = threadIdx.x & 63, w = threadIdx.x >> 6;
    const int gwave = blockIdx.x * 4 + w, nwave = gridDim.x * 4;
    for (int row_ = gwave; row_ < nrows * REP_P0; row_ += nwave) {
        const int row = (REP_P0 == 1) ? row_ : row_ % nrows;
        const f32x4* p = (const f32x4*)(src + (size_t)row * DM + 16 * lane);
        f32x4 v[4];
#pragma unroll
        for (int i = 0; i < 4; ++i) v[i] = p[i];
        float am = 0.f;
#pragma unroll
        for (int i = 0; i < 4; ++i) am = fmaxf(am, fmaxf(fmaxf(fabsf(v[i].x), fabsf(v[i].y)), fmaxf(fabsf(v[i].z), fabsf(v[i].w))));
#pragma unroll
        for (int o = 32; o >= 1; o >>= 1) am = fmaxf(am, __shfl_xor(am, o));
        const unsigned eb = (__float_as_uint(am) >> 23) & 0xffu;
        float sc = 1.0f, isc = 1.0f;
        if (eb >= 16u && eb <= 250u) { sc = __uint_as_float((261u - eb) << 23); isc = __uint_as_float((eb - 7u) << 23); }
        u32x4 o;
#pragma unroll
        for (int i = 0; i < 4; ++i) {
            int pk = __builtin_amdgcn_cvt_pk_fp8_f32(v[i].x * sc, v[i].y * sc, 0, false);
            pk = __builtin_amdgcn_cvt_pk_fp8_f32(v[i].z * sc, v[i].w * sc, pk, true);
            o[i] = (unsigned)pk;
        }
        *(u32x4*)(dst + (size_t)row * DM + 16 * lane) = o;
        if (lane == 0) inv[row] = isc;
    }
}
DI float dot16(const unsigned (&a)[8], u32x4 b0, u32x4 b1) {
    float acc;
    asm volatile("v_dot2_f32_bf16 %0, %1, %9, 0\n\tv_dot2_f32_bf16 %0, %2, %10, %0\n\tv_dot2_f32_bf16 %0, %3, %11, %0\n\tv_dot2_f32_bf16 %0, %4, %12, %0\n\t"
                 "v_dot2_f32_bf16 %0, %5, %13, %0\n\tv_dot2_f32_bf16 %0, %6, %14, %0\n\tv_dot2_f32_bf16 %0, %7, %15, %0\n\tv_dot2_f32_bf16 %0, %8, %16, %0\n\ts_nop 2"
                 : "=&v"(acc)
                 : "v"(a[0]), "v"(a[1]), "v"(a[2]), "v"(a[3]), "v"(a[4]), "v"(a[5]), "v"(a[6]), "v"(a[7]),
                   "v"(b0.x), "v"(b0.y), "v"(b0.z), "v"(b0.w), "v"(b1.x), "v"(b1.y), "v"(b1.z), "v"(b1.w));
    return acc;
}
DI float dot_fp8_row(u32x4 u, u32x4 xa, u32x4 xb) {
    unsigned a[8];
#pragma unroll
    for (int j = 0; j < 4; ++j) {
        a[2 * j] = __builtin_bit_cast(unsigned, __builtin_amdgcn_cvt_scalef32_pk_bf16_fp8(u[j], 1.0f, false));
        a[2 * j + 1] = __builtin_bit_cast(unsigned, __builtin_amdgcn_cvt_scalef32_pk_bf16_fp8(u[j], 1.0f, true));
    }
    return dot16(a, xa, xb);
}
DI void axpy_fp8_row(f32x2 (&o)[8], float wgt, u32x4 v) {
    const f32x2 w2 = {wgt, wgt};
#pragma unroll
    for (int j = 0; j < 4; ++j) {
        const f32x2 lo = __builtin_amdgcn_cvt_pk_f32_fp8(v[j], false), hi = __builtin_amdgcn_cvt_pk_f32_fp8(v[j], true);
        o[2 * j] = __builtin_elementwise_fma(w2, lo, o[2 * j]);
        o[2 * j + 1] = __builtin_elementwise_fma(w2, hi, o[2 * j + 1]);
    }
}
struct TokMeta { int e0, e1; float su0, su1, gv0, gv1; u32x4 xa, xb; };
DI TokMeta load_meta(int t, int lane, const bf16_t* __restrict__ x1, const int* __restrict__ eidx, const float* __restrict__ gws, const float* __restrict__ su, const float* __restrict__ sv) {
    TokMeta m;
    m.e0 = eidx[(size_t)t * 128 + lane]; m.e1 = eidx[(size_t)t * 128 + 64 + lane];
    const float g0 = gws[(size_t)t * 128 + lane], g1 = gws[(size_t)t * 128 + 64 + lane];
    m.su0 = su[m.e0]; m.su1 = su[m.e1];
    m.gv0 = g0 * sv[m.e0]; m.gv1 = g1 * sv[m.e1];
    m.xa = *(const u32x4*)(x1 + (size_t)t * DM + 16 * lane); m.xb = *(const u32x4*)(x1 + (size_t)t * DM + 16 * lane + 8);
    return m;
}
DI void gather_issue(u32x4 (&bu)[8], u32x4 (&bv)[8], int ev, int lbase, int lane, const unsigned char* __restrict__ U8, const unsigned char* __restrict__ V8) {
#pragma unroll
    for (int i = 0; i < 8; ++i) {
        const int e = __builtin_amdgcn_readlane(ev, lbase + i);
        bu[i] = *(const u32x4*)(U8 + (size_t)e * DM + 16 * lane);
        bv[i] = *(const u32x4*)(V8 + (size_t)e * DM + 16 * lane);
    }
}
DI void gather_compute(const u32x4 (&bu)[8], const u32x4 (&bv)[8], float suv, float gvv, int lbase, int lane_in, u32x4 xa, u32x4 xb, f32x2 (&out)[8]) {
    int lane = lane_in;
    float d[8];
#pragma unroll
    for (int i = 0; i < 8; ++i) { d[i] = dot_fp8_row(bu[i], xa, xb) * __builtin_bit_cast(float, __builtin_amdgcn_readlane(__builtin_bit_cast(int, suv), lbase + i)); __builtin_amdgcn_sched_barrier(0); }
    float d4[4], d2[2], d1;
    asm volatile("" : "+v"(lane));
    {
        const bool hi = (lane & 32) != 0;
#pragma unroll
        for (int i = 0; i < 4; ++i) { const float keep = hi ? d[i + 4] : d[i], send = hi ? d[i] : d[i + 4]; d4[i] = keep + __shfl_xor(send, 32); }
    }
    {
        const bool hi = (lane & 16) != 0;
#pragma unroll
        for (int i = 0; i < 2; ++i) { const float keep = hi ? d4[i + 2] : d4[i], send = hi ? d4[i] : d4[i + 2]; d2[i] = keep + __shfl_xor(send, 16); }
    }
    {
        const bool hi = (lane & 8) != 0;
        const float keep = hi ? d2[1] : d2[0], send = hi ? d2[0] : d2[1];
        d1 = keep + __shfl_xor(send, 8);
    }
    d1 += __shfl_xor(d1, 4); d1 += __shfl_xor(d1, 2); d1 += __shfl_xor(d1, 1);
    const float hv = gelu_exact(d1);
#pragma unroll
    for (int i = 0; i < 8; ++i) {
        const int src = 8 * (i & 1) + 16 * ((i >> 1) & 1) + 32 * ((i >> 2) & 1);
        const float wi = __builtin_bit_cast(float, __builtin_amdgcn_readlane(__builtin_bit_cast(int, gvv), lbase + i)) *
                         __builtin_bit_cast(float, __builtin_amdgcn_readlane(__builtin_bit_cast(int, hv), src));
        axpy_fp8_row(out, wi, bv[i]);
        __builtin_amdgcn_sched_barrier(0);
    }
}
DI void peer_gather_phase(const bf16_t* __restrict__ x1, const int* __restrict__ eidx, const float* __restrict__ gws, const unsigned char* __restrict__ U8,
                          const unsigned char* __restrict__ V8, const float* __restrict__ su, const float* __restrict__ sv, const float* __restrict__ lng,
                          const float* __restrict__ lnb, bf16_t* __restrict__ xo_bf, float* __restrict__ xo_f32) {
    const int lane = threadIdx.x & 63, w = threadIdx.x >> 6;
    const int gwave = blockIdx.x * 4 + w, nwave = gridDim.x * 4;
    if (gwave < T_TOK) {
        TokMeta cur = load_meta(gwave, lane, x1, eidx, gws, su, sv);
        u32x4 au[8], av[8], bu[8], bv[8];
        gather_issue(au, av, cur.e0, 0, lane, U8, V8);
        for (int t_ = gwave; t_ < T_TOK * REP_GATHER; t_ += nwave) {
            const int t = (REP_GATHER == 1) ? t_ : t_ % T_TOK;
            const bool has_next = t_ + nwave < T_TOK * REP_GATHER;
            TokMeta nxt = cur;
            if (has_next) nxt = load_meta((REP_GATHER == 1) ? t_ + nwave : (t_ + nwave) % T_TOK, lane, x1, eidx, gws, su, sv);
            f32x2 out[8];
#pragma unroll
            for (int i = 0; i < 8; ++i) { out[i].x = 0.f; out[i].y = 0.f; }
            for (int jb = 0; jb < 16; jb += 2) {
                const int ev = (jb < 8) ? cur.e0 : cur.e1;
                const float suv = (jb < 8) ? cur.su0 : cur.su1, gvv = (jb < 8) ? cur.gv0 : cur.gv1;
                const int lbase = (jb & 7) * 8;
                gather_issue(bu, bv, ev, lbase + 8, lane, U8, V8);
                gather_compute(au, av, suv, gvv, lbase, lane, cur.xa, cur.xb, out);
                if (jb + 2 < 16) {
                    const int ev2 = (jb + 2 < 8) ? cur.e0 : cur.e1;
                    gather_issue(au, av, ev2, ((jb + 2) & 7) * 8, lane, U8, V8);
                } else if (has_next) {
                    gather_issue(au, av, nxt.e0, 0, lane, U8, V8);
                }
                gather_compute(bu, bv, suv, gvv, lbase + 8, lane, cur.xa, cur.xb, out);
            }
            float y[16];
            {
                const u32x4 xa = cur.xa, xb = cur.xb;
                y[0] = bf_lo(xa.x); y[1] = bf_hi(xa.x); y[2] = bf_lo(xa.y); y[3] = bf_hi(xa.y); y[4] = bf_lo(xa.z); y[5] = bf_hi(xa.z); y[6] = bf_lo(xa.w); y[7] = bf_hi(xa.w);
                y[8] = bf_lo(xb.x); y[9] = bf_hi(xb.x); y[10] = bf_lo(xb.y); y[11] = bf_hi(xb.y); y[12] = bf_lo(xb.z); y[13] = bf_hi(xb.z); y[14] = bf_lo(xb.w); y[15] = bf_hi(xb.w);
            }
            float s = 0.f;
#pragma unroll
            for (int i = 0; i < 8; ++i) { y[2 * i] = DN_ALPHA * y[2 * i] + out[i].x; y[2 * i + 1] = DN_ALPHA * y[2 * i + 1] + out[i].y; s += y[2 * i] + y[2 * i + 1]; }
            const float mu = wave_sum(s) * (1.0f / DM);
            float qq = 0.f;
#pragma unroll
            for (int i = 0; i < 16; ++i) { const float dd = y[i] - mu; qq += dd * dd; }
            const float rstd = rsqrtf(wave_sum(qq) * (1.0f / DM) + LN_EPS);
            const int col = 16 * lane;
            f32x4 o4[4];
#pragma unroll
            for (int q4 = 0; q4 < 4; ++q4) {
                const f32x4 ga = *(const f32x4*)(lng + col + 4 * q4), ba = *(const f32x4*)(lnb + col + 4 * q4);
#pragma unroll
                for (int e = 0; e < 4; ++e) o4[q4][e] = (y[4 * q4 + e] - mu) * rstd * ga[e] + ba[e];
            }
            if (xo_f32) {
#pragma unroll
                for (int q4 = 0; q4 < 4; ++q4) *(f32x4*)(xo_f32 + (size_t)t * DM + col + 4 * q4) = o4[q4];
            }
            if (xo_bf) {
                u32x4 w0 = {pk_bf16(o4[0].x, o4[0].y), pk_bf16(o4[0].z, o4[0].w), pk_bf16(o4[1].x, o4[1].y), pk_bf16(o4[1].z, o4[1].w)};
                u32x4 w1 = {pk_bf16(o4[2].x, o4[2].y), pk_bf16(o4[2].z, o4[2].w), pk_bf16(o4[3].x, o4[3].y), pk_bf16(o4[3].z, o4[3].w)};
                *(u32x4*)(xo_bf + (size_t)t * DM + col) = w0; *(u32x4*)(xo_bf + (size_t)t * DM + col + 8) = w1;
            }
            cur = nxt;
        }
    }
}

struct SliceMap { int j0, jstep, wslot, nslot; };
DI SliceMap slice_map(int w) {
    SliceMap m; const int G = gridDim.x;
    if (G >= 8) { m.j0 = blockIdx.x & 7; m.jstep = 8; m.wslot = (blockIdx.x >> 3) * 4 + w; m.nslot = ((G - m.j0 + 7) >> 3) * 4; }
    else { m.j0 = 0; m.jstep = 1; m.wslot = blockIdx.x * 4 + w; m.nslot = G * 4; }
    return m;
}
DI void peer_u_phase(const bf16_t* __restrict__ x1, const int* __restrict__ eidx, const unsigned char* __restrict__ U8, float* __restrict__ ph) {
    int tidv = threadIdx.x;
    asm volatile("" : "+v"(tidv));
    const int lane = tidv & 63, w = tidv >> 6, grp = lane >> 3, l8 = lane & 7;
    const SliceMap sm = slice_map(w);
    for (int j_ = sm.j0; j_ < 8 * REP_PU; j_ += sm.jstep) {
        const int j = j_ & 7;
        const unsigned char* ub = U8 + 128 * j + 16 * l8;
        const bf16_t* xb_ = x1 + 128 * j + 16 * l8;
        float* pj = ph + (size_t)j * T_TOK * 128;
        const int step = sm.nslot;
        int t = sm.wslot;
        if (t >= T_TOK) continue;
        u32x4 sa[16], sb[16];
        int e0n = 0, e1n = 0;
        u32x4 xa, xb, xan, xbn;
#define U_ISSUE(SEG, E0, E1) { _Pragma("unroll") for (int b = 0; b < 16; ++b) { const int e = __shfl((b < 8) ? (E0) : (E1), (b & 7) * 8 + grp); SEG[b] = *(const u32x4*)(ub + (size_t)e * DM); } }
#define U_COMPUTE(SEG, TT) { float hsum[2]; \
            _Pragma("unroll") for (int hf = 0; hf < 2; ++hf) { float d[8]; \
                _Pragma("unroll") for (int i = 0; i < 8; ++i) { d[i] = dot_fp8_row(SEG[hf * 8 + i], xa, xb); } \
                float d4[4], d2[2]; \
                { const bool hi = (l8 & 4) != 0; _Pragma("unroll") for (int i = 0; i < 4; ++i) { const float keep = hi ? d[i + 4] : d[i], send = hi ? d[i] : d[i + 4]; d4[i] = keep + __shfl_xor(send, 4); } } \
                { const bool hi = (l8 & 2) != 0; _Pragma("unroll") for (int i = 0; i < 2; ++i) { const float keep = hi ? d4[i + 2] : d4[i], send = hi ? d4[i] : d4[i + 2]; d2[i] = keep + __shfl_xor(send, 2); } } \
                { const bool hi = (l8 & 1) != 0; const float keep = hi ? d2[1] : d2[0], send = hi ? d2[0] : d2[1]; hsum[hf] = keep + __shfl_xor(send, 1); } } \
            pj[(size_t)(TT) * 128 + 8 * l8 + grp] = hsum[0]; pj[(size_t)(TT) * 128 + 64 + 8 * l8 + grp] = hsum[1]; }
        {
            const int e0 = eidx[(size_t)t * 128 + lane], e1 = eidx[(size_t)t * 128 + 64 + lane];
            xa = *(const u32x4*)(xb_ + (size_t)t * DM); xb = *(const u32x4*)(xb_ + (size_t)t * DM + 8);
            U_ISSUE(sa, e0, e1)
            if (t + step < T_TOK) { e0n = eidx[(size_t)(t + step) * 128 + lane]; e1n = eidx[(size_t)(t + step) * 128 + 64 + lane]; }
        }
        for (; t < T_TOK; t += 2 * step) {
            int e0nn = 0, e1nn = 0;
            const bool n1 = t + step < T_TOK, n2 = t + 2 * step < T_TOK, n3 = t + 3 * step < T_TOK;
            if (n1) { U_ISSUE(sb, e0n, e1n) xan = *(const u32x4*)(xb_ + (size_t)(t + step) * DM); xbn = *(const u32x4*)(xb_ + (size_t)(t + step) * DM + 8); }
            if (n2) { e0nn = eidx[(size_t)(t + 2 * step) * 128 + lane]; e1nn = eidx[(size_t)(t + 2 * step) * 128 + 64 + lane]; }
            U_COMPUTE(sa, t)
            if (n1) {
                xa = xan; xb = xbn;
                if (n2) { U_ISSUE(sa, e0nn, e1nn) xan = *(const u32x4*)(xb_ + (size_t)(t + 2 * step) * DM); xbn = *(const u32x4*)(xb_ + (size_t)(t + 2 * step) * DM + 8); }
                if (n3) { e0n = eidx[(size_t)(t + 3 * step) * 128 + lane]; e1n = eidx[(size_t)(t + 3 * step) * 128 + 64 + lane]; }
                U_COMPUTE(sb, t + step)
                xa = xan; xb = xbn;
            }
        }
#undef U_ISSUE
#undef U_COMPUTE
    }
}
DI void peer_hw_phase(const float* __restrict__ ph, const int* __restrict__ eidx, const float* __restrict__ su, const float* __restrict__ sv, float* __restrict__ gws) {
    const size_t n = (size_t)T_TOK * 128, nthreads = (size_t)gridDim.x * blockDim.x;
    for (size_t i = (size_t)blockIdx.x * blockDim.x + threadIdx.x; i < n; i += nthreads) {
        float hsum = 0.f;
#pragma unroll
        for (int j = 0; j < 8; ++j) hsum += ph[(size_t)j * n + i];
        const int e = eidx[i];
        gws[i] = gws[i] * gelu_exact(hsum * su[e]) * sv[e];
    }
}
DI void peer_v_phase(const bf16_t* __restrict__ x1, const int* __restrict__ eidx, const float* __restrict__ wgt, const unsigned char* __restrict__ V8, bf16_t* __restrict__ y) {
    int tidv = threadIdx.x;
    asm volatile("" : "+v"(tidv));
    const int lane = tidv & 63, w = tidv >> 6, grp = lane >> 3, l8 = lane & 7;
    const SliceMap sm = slice_map(w);
    for (int j_ = sm.j0; j_ < 8 * REP_PV; j_ += sm.jstep) {
        const int j = j_ & 7;
        const unsigned char* vb = V8 + 128 * j + 16 * l8;
        const int col = 128 * j + 16 * l8 + 2 * grp;
        const int step = sm.nslot;
        int t = sm.wslot;
        if (t >= T_TOK) continue;
        u32x4 sa[16], sb[16];
        int e0n = 0, e1n = 0;
        float w0, w1, w0n = 0.f, w1n = 0.f;
#define V_ISSUE(SEG, E0, E1) { _Pragma("unroll") for (int b = 0; b < 16; ++b) { const int e = __shfl((b < 8) ? (E0) : (E1), (b & 7) * 8 + grp); SEG[b] = *(const u32x4*)(vb + (size_t)e * DM); } }
#define V_COMPUTE(SEG, TT) { f32x2 acc[8]; \
            _Pragma("unroll") for (int i = 0; i < 8; ++i) { acc[i].x = 0.f; acc[i].y = 0.f; } \
            _Pragma("unroll") for (int b = 0; b < 16; ++b) { const float wv = __shfl((b < 8) ? w0 : w1, (b & 7) * 8 + grp); axpy_fp8_row(acc, wv, SEG[b]); } \
            float a8[8], a4[4], a2[2]; \
            { const bool hi = (lane & 32) != 0; _Pragma("unroll") for (int i = 0; i < 8; ++i) { const float lo_ = (i & 1) ? acc[i >> 1].y : acc[i >> 1].x, hi_ = (i & 1) ? acc[4 + (i >> 1)].y : acc[4 + (i >> 1)].x; \
                const float keep = hi ? hi_ : lo_, send = hi ? lo_ : hi_; a8[i] = keep + __shfl_xor(send, 32); } } \
            { const bool hi = (lane & 16) != 0; _Pragma("unroll") for (int i = 0; i < 4; ++i) { const float keep = hi ? a8[i + 4] : a8[i], send = hi ? a8[i] : a8[i + 4]; a4[i] = keep + __shfl_xor(send, 16); } } \
            { const bool hi = (lane & 8) != 0; _Pragma("unroll") for (int i = 0; i < 2; ++i) { const float keep = hi ? a4[i + 2] : a4[i], send = hi ? a4[i] : a4[i + 2]; a2[i] = keep + __shfl_xor(send, 8); } } \
            const unsigned xr = *(const unsigned*)(x1 + (size_t)(TT) * DM + col); \
            *(unsigned*)(y + (size_t)(TT) * DM + col) = pk_bf16(DN_ALPHA * bf_lo(xr) + a2[0], DN_ALPHA * bf_hi(xr) + a2[1]); }
        {
            const int e0 = eidx[(size_t)t * 128 + lane], e1 = eidx[(size_t)t * 128 + 64 + lane];
            w0 = wgt[(size_t)t * 128 + lane]; w1 = wgt[(size_t)t * 128 + 64 + lane];
            V_ISSUE(sa, e0, e1)
            if (t + step < T_TOK) { e0n = eidx[(size_t)(t + step) * 128 + lane]; e1n = eidx[(size_t)(t + step) * 128 + 64 + lane]; }
        }
        for (; t < T_TOK; t += 2 * step) {
            int e0nn = 0, e1nn = 0;
            const bool n1 = t + step < T_TOK, n2 = t + 2 * step < T_TOK, n3 = t + 3 * step < T_TOK;
            if (n1) { V_ISSUE(sb, e0n, e1n) w0n = wgt[(size_t)(t + step) * 128 + lane]; w1n = wgt[(size_t)(t + step) * 128 + 64 + lane]; }
            if (n2) { e0nn = eidx[(size_t)(t + 2 * step) * 128 + lane]; e1nn = eidx[(size_t)(t + 2 * step) * 128 + 64 + lane]; }
            V_COMPUTE(sa, t)
            if (n1) {
                w0 = w0n; w1 = w1n;
                if (n2) { V_ISSUE(sa, e0nn, e1nn) w0n = wgt[(size_t)(t + 2 * step) * 128 + lane]; w1n = wgt[(size_t)(t + 2 * step) * 128 + 64 + lane]; }
                if (n3) { e0n = eidx[(size_t)(t + 3 * step) * 128 + lane]; e1n = eidx[(size_t)(t + 3 * step) * 128 + 64 + lane]; }
                V_COMPUTE(sb, t + step)
                w0 = w0n; w1 = w1n;
            }
        }
#undef V_ISSUE
#undef V_COMPUTE
    }
}

#define XB_TMO      128
#define XB_XCNT(j)  (256  + 64 * (j))
#define XB_XSUB(j)  (1280 + 64 * (j))
#define XB_XGEN(j)  (2304 + 64 * (j))
#define XB_TOP      3328
#define XB_TOPGEN   3392
#define XCD_BAR_WORDS 3456
#define XB_SPIN_CAP (1u << 22)
#define LAS __attribute__((address_space(3)))

__device__ __forceinline__ unsigned xb_ld(unsigned* p)              { return __hip_atomic_load(p, __ATOMIC_RELAXED, __HIP_MEMORY_SCOPE_AGENT); }
__device__ __forceinline__ unsigned xb_add(unsigned* p, unsigned v) { return __hip_atomic_fetch_add(p, v, __ATOMIC_RELAXED, __HIP_MEMORY_SCOPE_AGENT); }
__device__ __forceinline__ unsigned xb_xcc_id() { return (unsigned)__builtin_amdgcn_s_getreg((3 << 11) | 20) & 0xFu; }
#define XB_SPIN(cond, bar) do { unsigned _sp = 0; while (cond) { __builtin_amdgcn_s_sleep(1); \
    if ((++_sp & 255u) == 0u) { if (xb_ld(&(bar)[XB_TMO])) break; if (_sp > XB_SPIN_CAP) { atomicAdd(&(bar)[XB_TMO], 1u); break; } } } } while (0)

struct XcdBarrier {
    unsigned* bar; unsigned x;
    volatile LAS unsigned* st;
};

__device__ __forceinline__ XcdBarrier xcd_barrier_post(unsigned* bar, volatile LAS unsigned* st) {
    XcdBarrier b; b.bar = bar; b.x = xb_xcc_id(); b.st = st;
    if (threadIdx.x == 0) (void)xb_add(&bar[XB_XCNT(b.x)], 1u);
    return b;
}
__device__ __forceinline__ void xcd_barrier_complete(unsigned* bar, unsigned x, unsigned& nloc, unsigned& nx) {
    const unsigned G = gridDim.x * gridDim.y * gridDim.z;
    unsigned sum, cnt, mine, sp = 0u;
    for (;;) {
        sum = 0u; cnt = 0u; mine = 0u;
#pragma unroll
        for (unsigned j = 0; j < 16; ++j) { const unsigned c = xb_ld(&bar[XB_XCNT(j)]); sum += c; cnt += (c > 0u) ? 1u : 0u; mine = (j == x) ? c : mine; }
        if (sum == G) break;
        __builtin_amdgcn_s_sleep(1);
        if ((++sp & 255u) == 0u) { if (xb_ld(&bar[XB_TMO])) break; if (sp > XB_SPIN_CAP) { atomicAdd(&bar[XB_TMO], 1u); break; } }
    }
    nloc = mine > 0u ? mine : 1u; nx = cnt > 0u ? cnt : 1u;
}

__device__ __forceinline__ void xcd_barrier(const XcdBarrier& b) {
    asm volatile("s_waitcnt vmcnt(0)" ::: "memory");
    __syncthreads();
    if (threadIdx.x == 0) {
        unsigned* bar = b.bar;
        __builtin_amdgcn_s_waitcnt(0);
        unsigned nloc = b.st[0], nx = b.st[1];
        if (nloc == 0u) { xcd_barrier_complete(bar, b.x, nloc, nx); b.st[0] = nloc; b.st[1] = nx; }
        const unsigned old = xb_add(&bar[XB_XSUB(b.x)], 1u);
        const unsigned gen = old / nloc;
        if (old + 1u == (gen + 1u) * nloc) {
            __builtin_amdgcn_fence(__ATOMIC_RELEASE, "agent");
            asm volatile("s_waitcnt vmcnt(0)" ::: "memory");
            const unsigned og = xb_add(&bar[XB_TOP], 1u);
            const unsigned tg = og / nx;
            if (og + 1u == (tg + 1u) * nx) xb_add(&bar[XB_TOPGEN], 1u);
            else XB_SPIN(xb_ld(&bar[XB_TOPGEN]) == tg, bar);
            __builtin_amdgcn_fence(__ATOMIC_ACQUIRE, "agent");
            xb_add(&bar[XB_XGEN(b.x)], 1u);
            asm volatile("s_waitcnt vmcnt(0)" ::: "memory");
        } else {
            XB_SPIN(xb_ld(&bar[XB_XGEN(b.x)]) == gen, bar);
            __builtin_amdgcn_fence(__ATOMIC_ACQUIRE, "agent");
            asm volatile("s_waitcnt vmcnt(0)" ::: "memory");
        }
    }
    __syncthreads();
}


DI void gsync(cg::grid_group& g) {
    asm volatile("s_waitcnt vmcnt(0) lgkmcnt(0)" ::: "memory");
    g.sync();
    if (threadIdx.x == 0) { __builtin_amdgcn_fence(__ATOMIC_ACQUIRE, "agent"); asm volatile("s_waitcnt vmcnt(0)" ::: "memory"); }
    __syncthreads();
}

__global__ void __launch_bounds__(256, 2) mega_fwd(Params P) {
    extern __shared__ __attribute__((aligned(16))) unsigned char lds[];
    cg::grid_group grid = cg::this_grid();
    volatile LAS unsigned* xb_st = (volatile LAS unsigned*)(lds + LDS_PHASE_BYTES);
    if (threadIdx.x == 0) { xb_st[0] = 0u; xb_st[1] = 0u; }
    __syncthreads();
    const XcdBarrier xbar = xcd_barrier_post((unsigned*)(P.ws + W_BAR), xb_st);
    unsigned char* ws = P.ws;
    bf16_t* r0 = (bf16_t*)(ws + R0);
    bf16_t* r1 = (bf16_t*)(ws + R1);
    bf16_t* r2 = (bf16_t*)(ws + R2);
    bf16_t* r3 = (bf16_t*)(ws + R3);
    int* eidx = (int*)(ws + R4);
    float* gws = (float*)(ws + R4 + 32 * MBy);
    unsigned char* U8 = ws + R5;
    unsigned char* V8 = ws + R5 + 32 * MBy;
    float* su = (float*)(ws + W_SCALE);
    float* sv = su + 2 * 16384;
    bf16_t* w_daqkv = (bf16_t*)(ws + W_DAQKV);
    bf16_t* w_dawo = (bf16_t*)(ws + W_DAWO);
    bf16_t* w_swqkv = (bf16_t*)(ws + W_SWQKV);
    bf16_t* w_swwo = (bf16_t*)(ws + W_SWWO);
    bf16_t* w_pkq0 = (bf16_t*)(ws + W_PKQ0);
    bf16_t* w_pkq1 = (bf16_t*)(ws + W_PKQ1);
    bf16_t* subk = (bf16_t*)(ws + W_SUBK);
    f32x2* rope = (f32x2*)(ws + W_ROPE);
    float* yf = (float*)(ws + R0);
    bf16_t* yb = (bf16_t*)(ws + R0);
    constexpr size_t TD = (size_t)T_TOK * DM;
    constexpr size_t NE = (size_t)16384 * DM;

    convert_flat(P.x, r1, TD);
    convert_rows_fp8(P.pk_u, U8, su, 2 * 16384);
    convert_rows_fp8(P.pk_v, V8, sv, 2 * 16384);
    convert_flat(P.pk_sub_keys, subk, (size_t)2 * 8 * 2 * 128 * 64);
    transpose_convert(P.da_w_qkv, w_daqkv, 3072, (float*)lds);
    transpose_convert(P.da_w_o, w_dawo, 1024, (float*)lds);
    transpose_convert(P.sw_w_qkv, w_swqkv, 1280, (float*)lds);
    transpose_convert(P.sw_w_o, w_swwo, 1024, (float*)lds);
    transpose_convert(P.pk_w_query, w_pkq0, 1024, (float*)lds);
    transpose_convert(P.pk_w_query + (size_t)1024 * 1024, w_pkq1, 1024, (float*)lds);
    rope_table(rope);
    gsync(grid);

    {
        bf16_t* q = r0; bf16_t* k = r0 + TD; bf16_t* vt = r0 + 2 * TD;
        EpiQKV e{q, k, vt, rope, nullptr, 1024, 1024, 7, 8};
        gemm_phase(r1, w_daqkv, T_TOK, 2048, 1024, lds, e);
        { EpiVt ev{vt, nullptr, 7, 8}; gemm_phase<EpiVt, true>(r1, w_daqkv + (size_t)2048 * 1024, T_TOK, 1024, 1024, lds, ev); }
        xcd_barrier(xbar);
        AttnArgs a{q, k, vt, r2, P.da_lambda, P.da_subln_g, nullptr, nullptr};
        attn_phase<0>(a, lds);
        xcd_barrier(xbar);
        diff_combine_phase(r2, P.da_lambda, P.da_subln_g, r1);
        xcd_barrier(xbar);
        EpiRes<true> er{(const void*)P.x, nullptr, yb};
        gemm_phase(r1, w_dawo, T_TOK, 1024, 1024, lds, er);
        xcd_barrier(xbar);
        ln_phase(yb, P.ln1_g, P.ln1_b, r2);
        xcd_barrier(xbar);
        EpiBf16 eq{r3};
        gemm_phase(r2, w_pkq0, T_TOK, 1024, 1024, lds, eq);
        xcd_barrier(xbar);
        peer_topk_phase(r3, subk, eidx, gws);
        xcd_barrier(xbar);
        peer_u_phase(r2, eidx, U8, yf);
        xcd_barrier(xbar);
        peer_hw_phase(yf, eidx, su, sv, gws);
        xcd_barrier(xbar);
        peer_v_phase(r2, eidx, gws, V8, yb);
        xcd_barrier(xbar);
        ln_phase(yb, P.ln2_g, P.ln2_b, r1);
        xcd_barrier(xbar);
    }
    {
        bf16_t* q = r0; bf16_t* k = r0 + TD; bf16_t* vt = k + (size_t)T_TOK * 128;
        EpiQKV e{q, k, vt, rope, P.sw_b_qkv, 1024, 128, 6, 2};
        gemm_phase(r1, w_swqkv, T_TOK, 1152, 1024, lds, e);
        { EpiVt ev{vt, P.sw_b_qkv + 1152, 6, 2}; gemm_phase<EpiVt, true>(r1, w_swqkv + (size_t)1152 * 1024, T_TOK, 128, 1024, lds, ev); }
        xcd_barrier(xbar);
        AttnArgs a{q, k, vt, r2, nullptr, nullptr, P.sw_sinks, nullptr};
        attn_phase<1>(a, lds);
        xcd_barrier(xbar);
        EpiRes<false> er{(const void*)r1, P.sw_b_o, yb};
        gemm_phase(r2, w_swwo, T_TOK, 1024, 1024, lds, er);
        xcd_barrier(xbar);
        ln_phase(yb, P.ln1_g + DM, P.ln1_b + DM, r3);
        xcd_barrier(xbar);
        EpiBf16 eq{r2};
        gemm_phase(r3, w_pkq1, T_TOK, 1024, 1024, lds, eq);
        xcd_barrier(xbar);
        peer_topk_phase(r2, subk + (size_t)8 * 2 * 128 * 64, eidx, gws);
        xcd_barrier(xbar);
        peer_u_phase(r3, eidx, U8 + NE, yf);
        xcd_barrier(xbar);
        peer_hw_phase(yf, eidx, su + 16384, sv + 16384, gws);
        xcd_barrier(xbar);
        peer_v_phase(r3, eidx, gws, V8 + NE, yb);
        xcd_barrier(xbar);
        ln_phase(yb, P.ln2_g + DM, P.ln2_b + DM, nullptr, P.out);
    }
}

extern "C" void kernel_launch(void* const* d_in, const int* in_sizes, int n_in, void* d_out, int out_size, void* d_ws, size_t ws_size, hipStream_t stream) {
    static int grid_blocks = 0;
    if (grid_blocks == 0) {
        if (n_in != 18 || ws_size < WS_END) { fprintf(stderr, "kernel_launch: unexpected n_in %d or ws_size %zu (< %zu)\n", n_in, ws_size, (size_t)WS_END); grid_blocks = -1; return; }
        int dev = 0, cus = 0, per_cu = 0;
        hipGetDevice(&dev);
        hipDeviceGetAttribute(&cus, hipDeviceAttributeMultiprocessorCount, dev);
        if (hipFuncSetAttribute((const void*)mega_fwd, hipFuncAttributeMaxDynamicSharedMemorySize, LDS_BYTES) != hipSuccess) { fprintf(stderr, "kernel_launch: hipFuncSetAttribute failed\n"); grid_blocks = -1; return; }
        if (hipOccupancyMaxActiveBlocksPerMultiprocessor(&per_cu, (const void*)mega_fwd, 256, LDS_BYTES) != hipSuccess || per_cu < 1) { fprintf(stderr, "kernel_launch: occupancy query failed (%d)\n", per_cu); per_cu = 1; (void)hipGetLastError(); }
        grid_blocks = cus * per_cu;
        fprintf(stderr, "kernel_launch: grid %d (%d CUs x %d)\n", grid_blocks, cus, per_cu);
    }
    if (grid_blocks < 0) return;
    Params p{};
    p.x = (const float*)d_in[0]; p.da_w_qkv = (const float*)d_in[1]; p.da_lambda = (const float*)d_in[2]; p.da_subln_g = (const float*)d_in[3]; p.da_w_o = (const float*)d_in[4];
    p.sw_w_qkv = (const float*)d_in[5]; p.sw_b_qkv = (const float*)d_in[6]; p.sw_sinks = (const float*)d_in[7]; p.sw_w_o = (const float*)d_in[8]; p.sw_b_o = (const float*)d_in[9];
    p.pk_w_query = (const float*)d_in[10]; p.pk_sub_keys = (const float*)d_in[11]; p.pk_u = (const float*)d_in[12]; p.pk_v = (const float*)d_in[13];
    p.ln1_g = (const float*)d_in[14]; p.ln1_b = (const float*)d_in[15]; p.ln2_g = (const float*)d_in[16]; p.ln2_b = (const float*)d_in[17];
    p.out = (float*)d_out; p.ws = (unsigned char*)d_ws;
    if (hipMemsetAsync((unsigned char*)d_ws + W_BAR, 0, XCD_BAR_WORDS * sizeof(unsigned), stream) != hipSuccess) { fprintf(stderr, "kernel_launch: hipMemsetAsync failed\n"); return; }
    void* args[] = {&p};
    hipError_t e = hipLaunchCooperativeKernel((const void*)mega_fwd, dim3(grid_blocks), dim3(256), args, LDS_BYTES, stream);
    if (e != hipSuccess) fprintf(stderr, "cooperative launch failed: %s (grid %d)\n", hipGetErrorString(e), grid_blocks);
}
```

```cpp
#include <hip/hip_runtime.h>
#include <hip/hip_cooperative_groups.h>
#include <cstdio>
#include <cstdint>
namespace cg = cooperative_groups;

#define DI __device__ __forceinline__
typedef unsigned short bf16_t;
typedef short bf16x8 __attribute__((ext_vector_type(8)));
typedef float f32x16 __attribute__((ext_vector_type(16)));
typedef float f32x4 __attribute__((ext_vector_type(4)));
typedef float f32x2 __attribute__((ext_vector_type(2)));
typedef unsigned u32x4 __attribute__((ext_vector_type(4)));
typedef unsigned u32x2 __attribute__((ext_vector_type(2)));
typedef __bf16 bf16x2_t __attribute__((ext_vector_type(2)));
#define MFMA(a, b, c) __builtin_amdgcn_mfma_f32_32x32x16_bf16((a), (b), (c), 0, 0, 0)

constexpr int T_TOK = 65536, DM = 1024, SEQ = 8192;
constexpr float DN_ALPHA = 1.41421356237309515f;
constexpr float LN_EPS = 1e-5f;
constexpr float LOG2E = 1.44269504088896341f;
constexpr float LAMBDA_INIT0 = 0.2f;

constexpr size_t MBy = 1u << 20;
constexpr size_t R0 = 0, R1 = 384 * MBy, R2 = 512 * MBy, R3 = 640 * MBy, R4 = 768 * MBy, R5 = 832 * MBy, R6 = 960 * MBy;
constexpr size_t W_DAQKV = R6, W_DAWO = R6 + 6 * MBy, W_SWQKV = R6 + 8 * MBy, W_SWWO = R6 + 11 * MBy, W_PKQ0 = R6 + 13 * MBy, W_PKQ1 = R6 + 15 * MBy,
                 W_SUBK = R6 + 17 * MBy, W_ROPE = R6 + 18 * MBy, W_SCALE = R6 + 20 * MBy, W_BAR = R6 + 21 * MBy, WS_END = R6 + 22 * MBy;
constexpr int LDS_PHASE_BYTES = 73728, LDS_BYTES = LDS_PHASE_BYTES + 16;
#ifndef REP_GEMM
#define REP_GEMM 1
#endif
#ifndef REP_ATT0
#define REP_ATT0 1
#endif
#ifndef REP_ATT1
#define REP_ATT1 1
#endif
#ifndef REP_TOPK
#define REP_TOPK 1
#endif
#ifndef REP_GATHER
#define REP_GATHER 1
#endif
#ifndef REP_P0
#define REP_P0 1
#endif
#ifndef REP_PU
#define REP_PU 1
#endif
#ifndef REP_PV
#define REP_PV 1
#endif

__constant__ float c_inv_freq[32] = {
    1.000000000e+00f, 7.498942018e-01f, 5.623413324e-01f, 4.216965139e-01f, 3.162277639e-01f, 2.371373922e-01f, 1.778279394e-01f, 1.333521456e-01f,
    1.000000015e-01f, 7.498941571e-02f, 5.623412877e-02f, 4.216964915e-02f, 3.162277862e-02f, 2.371373586e-02f, 1.778279431e-02f, 1.333521493e-02f,
    9.999999776e-03f, 7.498942316e-03f, 5.623413250e-03f, 4.216964822e-03f, 3.162277862e-03f, 2.371373819e-03f, 1.778279431e-03f, 1.333521446e-03f,
    1.000000047e-03f, 7.498941850e-04f, 5.623413017e-04f, 4.216965463e-04f, 3.162277862e-04f, 2.371373848e-04f, 1.778279402e-04f, 1.333521504e-04f};

struct Params {
    const float* x; const float* da_w_qkv; const float* da_lambda; const float* da_subln_g; const float* da_w_o;
    const float* sw_w_qkv; const float* sw_b_qkv; const float* sw_sinks; const float* sw_w_o; const float* sw_b_o;
    const float* pk_w_query; const float* pk_sub_keys; const float* pk_u; const float* pk_v;
    const float* ln1_g; const float* ln1_b; const float* ln2_g; const float* ln2_b;
    float* out; unsigned char* ws;
};

DI unsigned pk_bf16(float a, float b) { f32x2 f = {a, b}; return __builtin_bit_cast(unsigned, __builtin_convertvector(f, bf16x2_t)); }
DI bf16_t to_bf16(float a) { return (bf16_t)(pk_bf16(a, a) & 0xffffu); }
DI float bf_lo(unsigned u) { return __uint_as_float(u << 16); }
DI float bf_hi(unsigned u) { return __uint_as_float(u & 0xffff0000u); }
DI float wave_sum(float v) {
#pragma unroll
    for (int o = 32; o >= 1; o >>= 1) v += __shfl_xor(v, o);
    return v;
}

DI void convert_flat(const float* __restrict__ src, bf16_t* __restrict__ dst, size_t n) {
    const size_t nthreads = (size_t)gridDim.x * blockDim.x;
    for (size_t i_ = (size_t)blockIdx.x * blockDim.x + threadIdx.x; i_ < (n / 8) * REP_P0; i_ += nthreads) {
        const size_t i = (REP_P0 == 1) ? i_ : i_ % (n / 8);
        const f32x4 a = ((const f32x4*)src)[2 * i], b = ((const f32x4*)src)[2 * i + 1];
        u32x4 o; o.x = pk_bf16(a.x, a.y); o.y = pk_bf16(a.z, a.w); o.z = pk_bf16(b.x, b.y); o.w = pk_bf16(b.z, b.w);
        ((u32x4*)dst)[i] = o;
    }
}
DI void transpose_convert(const float* __restrict__ src, bf16_t* __restrict__ dst, int N, float* ldsf) {
    const int tilesN = N >> 6, ntiles = 16 * tilesN;
    const int tx = threadIdx.x & 63, ty = threadIdx.x >> 6;
    for (int tile = blockIdx.x; tile < ntiles; tile += gridDim.x) {
        const int tk = tile / tilesN, tn = tile - tk * tilesN;
        __syncthreads();
#pragma unroll
        for (int i = 0; i < 16; ++i) { const int k = ty + 4 * i; ldsf[k * 65 + tx] = src[(size_t)(tk * 64 + k) * N + tn * 64 + tx]; }
        __syncthreads();
#pragma unroll
        for (int i = 0; i < 16; ++i) { const int n = ty + 4 * i; dst[(size_t)(tn * 64 + n) * 1024 + tk * 64 + tx] = to_bf16(ldsf[tx * 65 + n]); }
    }
}
DI void rope_table(f32x2* rope) {
    const int nthreads = gridDim.x * blockDim.x;
    for (int i = blockIdx.x * blockDim.x + threadIdx.x; i < SEQ * 32; i += nthreads) {
        const int pos = i >> 5, j = i & 31;
        const float ang = (float)pos * c_inv_freq[j];
        const float kf = rintf(ang * 0.636619772367581343f);
        float rr = fmaf(-kf, 1.57079637050628662109375f, ang);
        rr = fmaf(-kf, -4.37113882867379294e-8f, rr);
        const float r2 = rr * rr;
        const float sn = rr + rr * r2 * (-1.6666654611e-1f + r2 * (8.3321608736e-3f + r2 * (-1.9515295891e-4f)));
        const float cs = 1.0f - 0.5f * r2 + r2 * r2 * (4.166664568298827e-2f + r2 * (-1.388731625493765e-3f + r2 * 2.443315711809948e-5f));
        const int q = ((int)kf) & 3;
        float c, s;
        if (q == 0) { c = cs; s = sn; } else if (q == 1) { c = -sn; s = cs; } else if (q == 2) { c = -cs; s = -sn; } else { c = sn; s = -cs; }
        f32x2 o = {c, s};
        rope[i] = o;
    }
}

DI void store_row32_bf16(bf16_t* rowp, const u32x2 (&A)[4], int h) {
#pragma unroll
    for (int gp = 0; gp < 2; ++gp) {
        const auto r0 = __builtin_amdgcn_permlane32_swap(A[2 * gp].x, A[2 * gp + 1].x, false, false);
        const auto r1 = __builtin_amdgcn_permlane32_swap(A[2 * gp].y, A[2 * gp + 1].y, false, false);
        u32x4 wv = {(unsigned)r0[0], (unsigned)r1[0], (unsigned)r0[1], (unsigned)r1[1]};
        *(u32x4*)(rowp + 16 * gp + 8 * h) = wv;
    }
}

template <class Epi, bool SW = false>
DI void gemm_phase(const bf16_t* __restrict__ A, const bf16_t* __restrict__ Bt, int M, int N, int K, unsigned char* lds, const Epi& epi) {
    constexpr int STR = 144, TB = 128 * STR;
    const int tid = threadIdx.x, lane = tid & 63, w = tid >> 6, wm = w >> 1, wn = w & 1, r = lane & 31, h = lane >> 5;
    const int tilesN = N >> 7, ntiles = (M >> 7) * tilesN, nk = K >> 6;
    const int lrow = tid >> 3, lcol = tid & 7;
    const int G = gridDim.x, tilesM = M >> 7;
    const bool xcd_order = (G & 7) == 0;
    const int nlb = xcd_order ? (G >> 3) : 1, PW = (tilesN & 7) == 0 ? 8 : tilesN;
    const int npad = ((ntiles + G - 1) / G) * G;
    for (int tile_ = blockIdx.x; tile_ < npad * REP_GEMM; tile_ += G) {
        int tile = (REP_GEMM == 1) ? tile_ : tile_ % npad;
        if (xcd_order) {
            const int rd = tile / G, c = tile - rd * G;
            const int lin = ((rd << 3) + (c & 7)) * nlb + (c >> 3);
            tile = lin;
        }
        if (tile >= ntiles) continue;
        const int pnl = tile / (tilesM * PW), rem = tile - pnl * (tilesM * PW);
        const int tm = rem / PW, tn = pnl * PW + (rem - tm * PW);
        const bf16_t* Ag = A + (size_t)(tm * 128 + lrow) * K + lcol * 8;
        const bf16_t* Bg = Bt + (size_t)(tn * 128 + lrow) * K + lcol * 8;
        u32x4 ra0[4], rb0[4], ra1[4], rb1[4];
#define GEMM_LOAD(RA, RB, KT) { _Pragma("unroll") for (int i = 0; i < 4; ++i) { RA[i] = *(const u32x4*)(Ag + (size_t)(32 * i) * K + (KT) * 64); RB[i] = *(const u32x4*)(Bg + (size_t)(32 * i) * K + (KT) * 64); } }
#define GEMM_STORE(RA, RB, BUF) { _Pragma("unroll") for (int i = 0; i < 4; ++i) { *(u32x4*)(lds + (BUF) * TB + (lrow + 32 * i) * STR + lcol * 16) = RA[i]; *(u32x4*)(lds + 2 * TB + (BUF) * TB + (lrow + 32 * i) * STR + lcol * 16) = RB[i]; } }
#define GEMM_COMPUTE(BUF) { \
            const unsigned char* la = lds + (BUF) * TB + (wm * 64 + r) * STR + h * 16; \
            const unsigned char* lb = lds + 2 * TB + (BUF) * TB + (wn * 64 + r) * STR + h * 16; \
            _Pragma("unroll") for (int ks = 0; ks < 4; ++ks) { \
                bf16x8 af[2], bfr[2]; \
                _Pragma("unroll") for (int mi = 0; mi < 2; ++mi) af[mi] = *(const bf16x8*)(la + mi * 32 * STR + ks * 32); \
                _Pragma("unroll") for (int ni = 0; ni < 2; ++ni) bfr[ni] = *(const bf16x8*)(lb + ni * 32 * STR + ks * 32); \
                _Pragma("unroll") for (int mi = 0; mi < 2; ++mi) \
                    _Pragma("unroll") for (int ni = 0; ni < 2; ++ni) acc[mi][ni] = SW ? MFMA(af[mi], bfr[ni], acc[mi][ni]) : MFMA(bfr[ni], af[mi], acc[mi][ni]); \
            } }
        GEMM_LOAD(ra0, rb0, 0)
        if (nk > 1) GEMM_LOAD(ra1, rb1, 1)
        f32x16 acc[2][2];
#pragma unroll
        for (int mi = 0; mi < 2; ++mi)
#pragma unroll
            for (int ni = 0; ni < 2; ++ni)
#pragma unroll
                for (int i = 0; i < 16; ++i) acc[mi][ni][i] = 0.f;
        GEMM_STORE(ra0, rb0, 0)
        __syncthreads();
        for (int kt = 0; kt < nk; kt += 2) {
            if (kt + 2 < nk) GEMM_LOAD(ra0, rb0, kt + 2)
            GEMM_COMPUTE(0)
            if (kt + 1 < nk) GEMM_STORE(ra1, rb1, 1)
            __syncthreads();
            if (kt + 1 < nk) {
                if (kt + 3 < nk) GEMM_LOAD(ra1, rb1, kt + 3)
                GEMM_COMPUTE(1)
                if (kt + 2 < nk) GEMM_STORE(ra0, rb0, 0)
                __syncthreads();
            }
        }
#undef GEMM_LOAD
#undef GEMM_STORE
#undef GEMM_COMPUTE
        epi(acc, tm * 128 + wm * 64, tn * 128 + wn * 64, r, h);
    }
}

struct EpiQKV {
    bf16_t* q; bf16_t* k; bf16_t* vt; const f32x2* rope; const float* bias; int nq, nk, dv_shift, hv;
    DI void operator()(const f32x16 (&acc)[2][2], int m0, int n0, int r, int h) const {
        if (n0 < nq + nk) {
            const bool isq = n0 < nq;
            bf16_t* dst = isq ? q + n0 : k + (n0 - nq);
            const int ld = isq ? nq : nk;
            const float qs = isq ? 0.125f * LOG2E : 1.0f;
#pragma unroll
            for (int mi = 0; mi < 2; ++mi) {
                const int m = m0 + mi * 32 + r, pos = m & (SEQ - 1);
                const f32x4* rp = (const f32x4*)(rope + pos * 32);
                u32x2 A1[4], A2[4];
#pragma unroll
                for (int g = 0; g < 4; ++g) {
                    const int j0 = 8 * g + 4 * h;
                    const f32x4 cs01 = rp[j0 >> 1], cs23 = rp[(j0 >> 1) + 1];
                    f32x4 b1 = {0.f, 0.f, 0.f, 0.f}, b2 = {0.f, 0.f, 0.f, 0.f};
                    if (bias) { b1 = *(const f32x4*)(bias + n0 + j0); b2 = *(const f32x4*)(bias + n0 + 32 + j0); }
                    const float c[4] = {cs01.x, cs01.z, cs23.x, cs23.z}, s[4] = {cs01.y, cs01.w, cs23.y, cs23.w};
                    float o1[4], o2[4];
#pragma unroll
                    for (int e = 0; e < 4; ++e) {
                        const float t1 = acc[mi][0][4 * g + e] + b1[e], t2 = acc[mi][1][4 * g + e] + b2[e];
                        o1[e] = (t1 * c[e] - t2 * s[e]) * qs; o2[e] = (t2 * c[e] + t1 * s[e]) * qs;
                    }
                    A1[g].x = pk_bf16(o1[0], o1[1]); A1[g].y = pk_bf16(o1[2], o1[3]); A2[g].x = pk_bf16(o2[0], o2[1]); A2[g].y = pk_bf16(o2[2], o2[3]);
                }
                store_row32_bf16(dst + (size_t)m * ld, A1, h);
                store_row32_bf16(dst + (size_t)m * ld + 32, A2, h);
            }
        }
    }
};
struct EpiVt {
    bf16_t* vt; const float* bias; int dv_shift, hv;
    DI void operator()(const f32x16 (&acc)[2][2], int m0, int n0, int r, int h) const {
        const int b = m0 >> 13, s0 = m0 & (SEQ - 1);
#pragma unroll
        for (int ni = 0; ni < 2; ++ni) {
            const int eg = n0 + ni * 32 + r;
            const float bv = bias ? bias[eg] : 0.f;
            const int hh = eg >> dv_shift, e = eg & ((1 << dv_shift) - 1);
            bf16_t* rowp = vt + ((size_t)((b * hv + hh) << dv_shift) + e) * SEQ + s0;
#pragma unroll
            for (int mi = 0; mi < 2; ++mi) {
                u32x2 A[4];
#pragma unroll
                for (int g = 0; g < 4; ++g) { A[g].x = pk_bf16(acc[mi][ni][4 * g] + bv, acc[mi][ni][4 * g + 1] + bv); A[g].y = pk_bf16(acc[mi][ni][4 * g + 2] + bv, acc[mi][ni][4 * g + 3] + bv); }
                store_row32_bf16(rowp + mi * 32, A, h);
            }
        }
    }
};
template <bool RES_F32> struct EpiRes {
    const void* res; const float* bias; bf16_t* y;
    DI void operator()(const f32x16 (&acc)[2][2], int m0, int n0, int r, int h) const {
#pragma unroll
        for (int mi = 0; mi < 2; ++mi) {
            const int m = m0 + mi * 32 + r;
#pragma unroll
            for (int ni = 0; ni < 2; ++ni) {
                u32x2 A[4];
#pragma unroll
                for (int g = 0; g < 4; ++g) {
                    const int n = n0 + ni * 32 + 8 * g + 4 * h;
                    f32x4 xr;
                    if (RES_F32) xr = *(const f32x4*)((const float*)res + (size_t)m * DM + n);
                    else { const u32x2 u = *(const u32x2*)((const bf16_t*)res + (size_t)m * DM + n); xr.x = bf_lo(u.x); xr.y = bf_hi(u.x); xr.z = bf_lo(u.y); xr.w = bf_hi(u.y); }
                    f32x4 bv = {0.f, 0.f, 0.f, 0.f};
                    if (bias) bv = *(const f32x4*)(bias + n);
                    f32x4 o;
#pragma unroll
                    for (int e = 0; e < 4; ++e) o[e] = DN_ALPHA * xr[e] + acc[mi][ni][4 * g + e] + bv[e];
                    A[g].x = pk_bf16(o[0], o[1]); A[g].y = pk_bf16(o[2], o[3]);
                }
                store_row32_bf16(y + (size_t)m * DM + n0 + ni * 32, A, h);
            }
        }
    }
};
struct EpiBf16 {
    bf16_t* o;
    DI void operator()(const f32x16 (&acc)[2][2], int m0, int n0, int r, int h) const {
#pragma unroll
        for (int mi = 0; mi < 2; ++mi) {
            const int m = m0 + mi * 32 + r;
#pragma unroll
            for (int ni = 0; ni < 2; ++ni) {
                u32x2 A[4];
#pragma unroll
                for (int g = 0; g < 4; ++g) { A[g].x = pk_bf16(acc[mi][ni][4 * g], acc[mi][ni][4 * g + 1]); A[g].y = pk_bf16(acc[mi][ni][4 * g + 2], acc[mi][ni][4 * g + 3]); }
                store_row32_bf16(o + (size_t)m * DM + n0 + ni * 32, A, h);
            }
        }
    }
};

DI void ln_phase(const bf16_t* __restrict__ y, const float* __restrict__ g, const float* __restrict__ b, bf16_t* __restrict__ xo, float* __restrict__ xf = nullptr) {
    const int lane = threadIdx.x & 63, w = threadIdx.x >> 6;
    const int gw = blockIdx.x * 4 + w, nw = gridDim.x * 4;
    f32x4 gv[4], bv[4];
#pragma unroll
    for (int i = 0; i < 4; ++i) { gv[i] = ((const f32x4*)g)[lane + 64 * i]; bv[i] = ((const f32x4*)b)[lane + 64 * i]; }
    for (int row = gw; row < T_TOK; row += nw) {
        const u32x2* yr = (const u32x2*)(y + (size_t)row * DM);
        f32x4 v[4];
#pragma unroll
        for (int i = 0; i < 4; ++i) { const u32x2 u = yr[lane + 64 * i]; v[i].x = bf_lo(u.x); v[i].y = bf_hi(u.x); v[i].z = bf_lo(u.y); v[i].w = bf_hi(u.y); }
        float s = 0.f;
#pragma unroll
        for (int i = 0; i < 4; ++i) s += (v[i].x + v[i].y) + (v[i].z + v[i].w);
        const float mu = wave_sum(s) * (1.0f / DM);
        float q = 0.f;
#pragma unroll
        for (int i = 0; i < 4; ++i) { const f32x4 d = v[i] - mu; q += (d.x * d.x + d.y * d.y) + (d.z * d.z + d.w * d.w); }
        const float rstd = rsqrtf(wave_sum(q) * (1.0f / DM) + LN_EPS);
#pragma unroll
        for (int i = 0; i < 4; ++i) {
            const f32x4 o = (v[i] - mu) * rstd * gv[i] + bv[i];
            if (xf) *(f32x4*)(xf + (size_t)row * DM + 4 * (lane + 64 * i)) = o;
            if (xo) { u32x2 wv = {pk_bf16(o.x, o.y), pk_bf16(o.z, o.w)}; *(u32x2*)(xo + (size_t)row * DM + 4 * (lane + 64 * i)) = wv; }
        }
    }
}

struct AttnArgs {
    const bf16_t* q; const bf16_t* k; const bf16_t* vt; bf16_t* o;
    const float* lam_params; const float* subln_g; const float* sinks; float* scr;
};
DI int pi_perm(int r) { return (r & 0x13) | ((r & 4) << 1) | ((r & 8) >> 1); }

template <int MODE>
DI void attn_phase(const AttnArgs& a, unsigned char* lds) {
    constexpr int DV = MODE == 0 ? 128 : 64, EB = DV / 32;
    constexpr int KSTR = 144, VSTR = 144, KBUF = 64 * KSTR, VBUF = DV * VSTR;
    constexpr int KCH = 2, VCH = DV / 32;
    constexpr int LDK = MODE == 0 ? 1024 : 128, HV = MODE == 0 ? 8 : 2;
    constexpr int NITEMS = 8192;
    const int tid = threadIdx.x, lane = tid & 63, w = tid >> 6, r = lane & 31, h = lane >> 5;
    unsigned char* kl = lds;
    unsigned char* vl = lds + 3 * KBUF;
    const float NEG_INF = -__builtin_inff();
    const int G = gridDim.x;
    const int krow = tid >> 3, kcc = tid & 7;

    constexpr int REPA = MODE == 0 ? REP_ATT0 : REP_ATT1;
    for (int it_ = blockIdx.x; it_ < NITEMS * REPA; it_ += G) {
        const int it = (REPA == 1) ? it_ : it_ % NITEMS;
        int b, qb, qcol0, kcol0, vh, p = 0;
        if (MODE == 0) {
            int bh;
            const int s = it / G, c = it - s * G;
            if (G == 512) { const int jj = c >> 3; bh = (c & 7) + 8 * (s >> 1); p = jj & 1; qb = (s & 1) ? (jj >> 1) : 63 - (jj >> 1); }
            else if (G == 256) { const int jj = c >> 3; bh = (c & 7) + 8 * (s >> 2); p = s & 1; qb = (s & 2) ? jj : 63 - jj; }
            else { bh = it >> 7; p = it & 1; qb = 63 - ((it >> 1) & 63); }
            b = bh >> 3; const int hh = bh & 7; qcol0 = hh * 128; kcol0 = hh * 128; vh = hh;
        } else {
            const int head = it & 15; qb = (it >> 4) & 63; b = it >> 10;
            qcol0 = head * 64; vh = head >> 3; kcol0 = vh * 64;
        }
        const int q0 = qb * 128, qw0 = q0 + 32 * w, qpos = qw0 + r;
        const int kt0 = MODE == 0 ? 0 : ((q0 >= 128 ? q0 - 128 : 0) >> 6), kt1 = (q0 + 128) >> 6;
        const bf16_t* vg = a.vt + (size_t)(b * HV + vh) * DV * SEQ + (size_t)krow * SEQ + kcc * 8;
        const size_t tok = (size_t)b * SEQ + qpos;

        {
            const bf16_t* kg = a.k + (size_t)b * SEQ * LDK + kcol0 + p * 64 + (size_t)krow * LDK + kcc * 8;
            bf16x8 qf[4];
            {
                const bf16_t* qp = a.q + tok * 1024 + qcol0 + p * 64 + h * 8;
#pragma unroll
                for (int ks = 0; ks < 4; ++ks) qf[ks] = *(const bf16x8*)(qp + ks * 16);
            }
            f32x16 O[EB];
#pragma unroll
            for (int eb = 0; eb < EB; ++eb)
#pragma unroll
                for (int i = 0; i < 16; ++i) O[eb][i] = 0.f;
            float mrow = NEG_INF, lsum = 0.f;
            if (MODE == 1) { mrow = a.sinks[it & 15] * LOG2E; lsum = (h == 0) ? 1.0f : 0.0f; }

            u32x4 rk[KCH], rv[VCH];
#define ATT_LOADK(KT) { _Pragma("unroll") for (int i = 0; i < KCH; ++i) rk[i] = *(const u32x4*)(kg + (size_t)((KT) * 64 + 32 * i) * LDK); }
#define ATT_LOADV(KT) { _Pragma("unroll") for (int i = 0; i < VCH; ++i) rv[i] = *(const u32x4*)(vg + (size_t)(32 * i) * SEQ + (KT) * 64); }
#define ATT_STOREK(KT) { unsigned char* kd_ = kl + (((KT) - kt0) % 3) * KBUF; _Pragma("unroll") for (int i = 0; i < KCH; ++i) *(u32x4*)(kd_ + (krow + 32 * i) * KSTR + kcc * 16) = rk[i]; }
#define ATT_STOREV(KT) { unsigned char* vd_ = vl + (((KT) - kt0) & 1) * VBUF; _Pragma("unroll") for (int i = 0; i < VCH; ++i) *(u32x4*)(vd_ + (krow + 32 * i) * VSTR + kcc * 16) = rv[i]; }
            auto s_compute = [&](f32x16 (&sx)[2], const int kt) __attribute__((always_inline)) {
                const unsigned char* kb_ = kl + ((kt - kt0) % 3) * KBUF;
#pragma unroll
                for (int kb = 0; kb < 2; ++kb) {
#pragma unroll
                    for (int i = 0; i < 16; ++i) sx[kb][i] = 0.f;
#pragma unroll
                    for (int ks = 0; ks < 4; ++ks) {
                        const bf16x8 kf = *(const bf16x8*)(kb_ + (kb * 32 + pi_perm(r)) * KSTR + ks * 32 + h * 16);
                        sx[kb] = MFMA(kf, qf[ks], sx[kb]);
                    }
                }
            };
            auto step = [&](f32x16 (&s)[2], f32x16 (&sn)[2], const int kt) __attribute__((always_inline)) {
                const bool more1 = kt + 1 < kt1, more2 = kt + 2 < kt1;
                if (more2) ATT_LOADK(kt + 2)
                if (more1) ATT_LOADV(kt + 1)
                const int key0 = kt * 64;
                bool need_mask = key0 + 63 > qw0;
                if (MODE == 1) need_mask = need_mask || (key0 < qw0 + 31 - 127);
                if (need_mask) {
                    asm volatile("" ::: "memory");
#pragma unroll
                    for (int kb = 0; kb < 2; ++kb)
#pragma unroll
                        for (int i = 0; i < 16; ++i) {
                            const int key = key0 + kb * 32 + 16 * (i >> 3) + 8 * h + (i & 7);
                            bool valid = key <= qpos;
                            if (MODE == 1) valid = valid && (key > qpos - 128);
                            s[kb][i] = valid ? s[kb][i] : NEG_INF;
                        }
                }
                float mx = NEG_INF;
#pragma unroll
                for (int kb = 0; kb < 2; ++kb)
#pragma unroll
                    for (int i = 0; i < 16; ++i) mx = fmaxf(mx, s[kb][i]);
                mx = fmaxf(mx, __shfl_xor(mx, 32));
                if (__builtin_amdgcn_ballot_w64(mx > mrow + 8.0f) != 0ull) {
                    asm volatile("" ::: "memory");
                    const float mnew = fmaxf(mrow, mx);
                    const float alpha = __builtin_amdgcn_exp2f(mrow - mnew);
                    mrow = mnew;
                    lsum *= alpha;
#pragma unroll
                    for (int eb = 0; eb < EB; ++eb)
#pragma unroll
                        for (int i = 0; i < 16; ++i) O[eb][i] *= alpha;
                }
                __builtin_amdgcn_s_setprio(1);
                s_compute(sn, kt + 1);
                f32x2 ps2 = {0.f, 0.f};
#pragma unroll
                for (int kb = 0; kb < 2; ++kb)
#pragma unroll
                    for (int i = 0; i < 16; i += 2) {
                        f32x2 pv = {__builtin_amdgcn_exp2f(s[kb][i] - mrow), __builtin_amdgcn_exp2f(s[kb][i + 1] - mrow)};
                        s[kb][i] = pv.x; s[kb][i + 1] = pv.y; ps2 += pv;
                    }
                lsum += ps2.x + ps2.y;
                bf16x8 pf[2][2];
#pragma unroll
                for (int kb = 0; kb < 2; ++kb)
#pragma unroll
                    for (int s2 = 0; s2 < 2; ++s2) {
                        u32x4 u;
                        u.x = pk_bf16(s[kb][8 * s2 + 0], s[kb][8 * s2 + 1]); u.y = pk_bf16(s[kb][8 * s2 + 2], s[kb][8 * s2 + 3]);
                        u.z = pk_bf16(s[kb][8 * s2 + 4], s[kb][8 * s2 + 5]); u.w = pk_bf16(s[kb][8 * s2 + 6], s[kb][8 * s2 + 7]);
                        pf[kb][s2] = __builtin_bit_cast(bf16x8, u);
                    }
                const unsigned char* vb_ = vl + ((kt - kt0) & 1) * VBUF;
#pragma unroll
                for (int eb = 0; eb < EB; ++eb) {
#pragma unroll
                    for (int kb = 0; kb < 2; ++kb)
#pragma unroll
                        for (int s2 = 0; s2 < 2; ++s2) {
                            const bf16x8 vf = *(const bf16x8*)(vb_ + (eb * 32 + r) * VSTR + (kb * 32 + 16 * s2 + 8 * h) * 2);
                            O[eb] = MFMA(vf, pf[kb][s2], O[eb]);
                        }
                }
                __builtin_amdgcn_s_setprio(0);
                if (more2) ATT_STOREK(kt + 2)
                if (more1) ATT_STOREV(kt + 1)
                __syncthreads();
            };
            ATT_LOADK(kt0) ATT_LOADV(kt0)
            ATT_STOREK(kt0) ATT_STOREV(kt0)
            if (kt0 + 1 < kt1) { ATT_LOADK(kt0 + 1) ATT_STOREK(kt0 + 1) }
            __syncthreads();
            f32x16 sA[2], sB[2];
            s_compute(sA, kt0);
            for (int kt = kt0; kt < kt1; kt += 2) {
                step(sA, sB, kt);
                if (kt + 1 < kt1) step(sB, sA, kt + 1);
            }
#undef ATT_LOADK
#undef ATT_LOADV
#undef ATT_STOREK
#undef ATT_STOREV
            const float inv0 = 1.0f / (lsum + __shfl_xor(lsum, 32));
            bf16_t* op = (MODE == 0) ? a.o + tok * 2048 + qcol0 * 2 + p * 128 : a.o + tok * 1024 + qcol0;
#pragma unroll
            for (int eb = 0; eb < EB; ++eb) {
                u32x2 A[4];
#pragma unroll
                for (int g = 0; g < 4; ++g) { A[g].x = pk_bf16(O[eb][4 * g] * inv0, O[eb][4 * g + 1] * inv0); A[g].y = pk_bf16(O[eb][4 * g + 2] * inv0, O[eb][4 * g + 3] * inv0); }
                store_row32_bf16(op + eb * 32, A, h);
            }
        }
    }
}

DI void diff_combine_phase(const bf16_t* __restrict__ op, const float* __restrict__ lam_params, const float* __restrict__ subln_g, bf16_t* __restrict__ o) {
    const int lane = threadIdx.x & 63, w = threadIdx.x >> 6;
    const int gwave = blockIdx.x * 4 + w, nwave = gridDim.x * 4;
    const float p1 = wave_sum(lam_params[lane] * lam_params[64 + lane]);
    const float p2 = wave_sum(lam_params[128 + lane] * lam_params[192 + lane]);
    const float lam = __expf(p1) - __expf(p2) + LAMBDA_INIT0;
    const int hd = lane >> 3, d0 = 16 * (lane & 7);
    f32x4 gg[4];
#pragma unroll
    for (int i = 0; i < 4; ++i) gg[i] = *(const f32x4*)(subln_g + d0 + 4 * i);
    for (int t = gwave; t < T_TOK; t += nwave) {
        const bf16_t* p0 = op + (size_t)t * 2048 + hd * 256 + d0;
        const u32x4 a0 = *(const u32x4*)p0, a1 = *(const u32x4*)(p0 + 8), b0 = *(const u32x4*)(p0 + 128), b1 = *(const u32x4*)(p0 + 136);
        float v[16];
#pragma unroll
        for (int i = 0; i < 4; ++i) {
            v[2 * i] = bf_lo(a0[i]) - lam * bf_lo(b0[i]); v[2 * i + 1] = bf_hi(a0[i]) - lam * bf_hi(b0[i]);
            v[8 + 2 * i] = bf_lo(a1[i]) - lam * bf_lo(b1[i]); v[8 + 2 * i + 1] = bf_hi(a1[i]) - lam * bf_hi(b1[i]);
        }
        float ss = 0.f;
#pragma unroll
        for (int i = 0; i < 16; ++i) ss += v[i] * v[i];
        ss += __shfl_xor(ss, 1); ss += __shfl_xor(ss, 2); ss += __shfl_xor(ss, 4);
        const float rs = rsqrtf(ss * (1.0f / 128.0f) + LN_EPS) * (1.0f - LAMBDA_INIT0);
        u32x4 w0, w1;
#pragma unroll
        for (int i = 0; i < 4; ++i) {
            const int e = (i & 1) * 2;
            w0[i] = pk_bf16(v[2 * i] * rs * gg[i >> 1][e], v[2 * i + 1] * rs * gg[i >> 1][e + 1]);
            w1[i] = pk_bf16(v[8 + 2 * i] * rs * gg[2 + (i >> 1)][e], v[8 + 2 * i + 1] * rs * gg[2 + (i >> 1)][e + 1]);
        }
        bf16_t* dst = o + (size_t)t * 1024 + hd * 128 + d0;
        *(u32x4*)dst = w0; *(u32x4*)(dst + 8) = w1;
    }
}

DI unsigned f2ord(float f) { const unsigned u = __float_as_uint(f); return (u & 0x80000000u) ? ~u : (u | 0x80000000u); }
DI float ord2f(unsigned o) { const unsigned u = (o & 0x80000000u) ? (o & 0x7fffffffu) : ~o; return __uint_as_float(u); }
__host__ __device__ constexpr int combo_row_start(int a) { int s = 0; for (int i = 0; i < a; ++i) s += 16 / (i + 1); return s; }

constexpr int SORT16[63][2] = {{0,1}, {2,3}, {0,2}, {1,3}, {1,2}, {4,5}, {6,7}, {4,6}, {5,7}, {5,6}, {0,4}, {2,6}, {2,4}, {1,5}, {3,7}, {3,5}, {1,2}, {3,4}, {5,6}, {8,9}, {10,11}, {8,10}, {9,11}, {9,10}, {12,13}, {14,15}, {12,14}, {13,15}, {13,14}, {8,12}, {10,14}, {10,12}, {9,13}, {11,15}, {11,13}, {9,10}, {11,12}, {13,14}, {0,8}, {4,12}, {4,8}, {2,10}, {6,14}, {6,10}, {2,4}, {6,8}, {10,12}, {1,9}, {5,13}, {5,9}, {3,11}, {7,15}, {7,11}, {3,5}, {7,9}, {11,13}, {1,2}, {3,4}, {5,6}, {7,8}, {9,10}, {11,12}, {13,14}};
constexpr int BMERGE16[32][2] = {{0,8}, {1,9}, {2,10}, {3,11}, {4,12}, {5,13}, {6,14}, {7,15}, {0,4}, {1,5}, {2,6}, {3,7}, {8,12}, {9,13}, {10,14}, {11,15}, {0,2}, {1,3}, {4,6}, {5,7}, {8,10}, {9,11}, {12,14}, {13,15}, {0,1}, {2,3}, {4,5}, {6,7}, {8,9}, {10,11}, {12,13}, {14,15}};
DI void cex(unsigned& a, unsigned& b) { const unsigned hi = max(a, b), lo = min(a, b); a = hi; b = lo; }
DI void merge_top16(unsigned (&A)[16], const unsigned (&B)[16]) {
#pragma unroll
    for (int i = 0; i < 16; ++i) A[i] = max(A[i], B[15 - i]);
#pragma unroll
    for (int n = 0; n < 32; ++n) cex(A[BMERGE16[n][0]], A[BMERGE16[n][1]]);
}
DI void peer_topk_phase(const bf16_t* __restrict__ qpk, const bf16_t* __restrict__ subk, int* __restrict__ eidx, float* __restrict__ gout) {
    int tidv = threadIdx.x;
    asm volatile("" : "+v"(tidv));
    const int lane = tidv & 63, w = tidv >> 6, r = lane & 31, h = lane >> 5;
    const int gwave = blockIdx.x * 4 + w, nwave = gridDim.x * 4;
    for (int item_ = gwave; item_ < 2048 * 8 * REP_TOPK; item_ += nwave) {
        const int item = (REP_TOPK == 1) ? item_ : item_ % (2048 * 8);
        const int tt = item >> 3, hh = item & 7, t0 = tt * 32;
        unsigned top[2][16];
#pragma unroll
        for (int c = 0; c < 2; ++c) {
            f32x16 acc[4];
#pragma unroll
            for (int nb = 0; nb < 4; ++nb)
#pragma unroll
                for (int i = 0; i < 16; ++i) acc[nb][i] = 0.f;
            const bf16_t* qp = qpk + (size_t)(t0 + r) * 1024 + hh * 128 + c * 64 + h * 8;
            const bf16_t* kp = subk + ((size_t)(hh * 2 + c) * 128 + r) * 64 + h * 8;
#pragma unroll
            for (int ks = 0; ks < 4; ++ks) {
                const bf16x8 qfr = *(const bf16x8*)(qp + ks * 16);
#pragma unroll
                for (int nb = 0; nb < 4; ++nb) {
                    const bf16x8 kf = *(const bf16x8*)(kp + nb * 32 * 64 + ks * 16);
                    acc[nb] = MFMA(kf, qfr, acc[nb]);
                }
            }
            unsigned key[64];
#pragma unroll
            for (int nb = 0; nb < 4; ++nb)
#pragma unroll
                for (int i = 0; i < 16; ++i) {
                    const int n = nb * 32 + (i & 3) + 8 * (i >> 2) + 4 * h;
                    key[nb * 16 + i] = (f2ord(acc[nb][i]) & ~127u) | (unsigned)(127 - n);
                }
            unsigned g0[16], g1[16], g2[16], g3[16];
#pragma unroll
            for (int i = 0; i < 16; ++i) { g0[i] = key[i]; g1[i] = key[16 + i]; g2[i] = key[32 + i]; g3[i] = key[48 + i]; }
#pragma unroll
            for (int n = 0; n < 63; ++n) { cex(g0[SORT16[n][0]], g0[SORT16[n][1]]); cex(g1[SORT16[n][0]], g1[SORT16[n][1]]); cex(g2[SORT16[n][0]], g2[SORT16[n][1]]); cex(g3[SORT16[n][0]], g3[SORT16[n][1]]); }
            merge_top16(g0, g1); merge_top16(g2, g3); merge_top16(g0, g2);
            unsigned pb[16];
#pragma unroll
            for (int i = 0; i < 16; ++i) pb[i] = (unsigned)__shfl_xor((int)g0[i], 32);
            merge_top16(g0, pb);
#pragma unroll
            for (int i = 0; i < 16; ++i) top[c][i] = g0[i];
        }
        unsigned ck[50];
#pragma unroll
        for (int a = 0; a < 16; ++a)
#pragma unroll
            for (int b = 0; b < 16 / (a + 1); ++b) {
                const float cv = ord2f(top[0][a] & ~127u) + ord2f(top[1][b] & ~127u);
                ck[combo_row_start(a) + b] = (f2ord(cv) & ~255u) | (unsigned)(((15 - a) << 4) | (15 - b));
            }
        unsigned c0[16], c1[16], c2[16], c3[16];
#pragma unroll
        for (int i = 0; i < 16; ++i) { c0[i] = ck[i]; c1[i] = ck[16 + i]; c2[i] = ck[32 + i]; c3[i] = (i < 2) ? ck[48 + i] : 0u; }
#pragma unroll
        for (int n = 0; n < 63; ++n) { cex(c1[SORT16[n][0]], c1[SORT16[n][1]]); cex(c2[SORT16[n][0]], c2[SORT16[n][1]]); }
        merge_top16(c0, c1); merge_top16(c2, c3); merge_top16(c0, c2);
        float sv[16]; int se[16];
#pragma unroll
        for (int rd = 0; rd < 16; ++rd) {
            const unsigned m = c0[rd];
            const int asel = 15 - (int)((m >> 4) & 15u), bsel = 15 - (int)(m & 15u);
            unsigned ka = top[0][0], kb = top[1][0];
#pragma unroll
            for (int i = 1; i < 16; ++i) { ka = (asel == i) ? top[0][i] : ka; kb = (bsel == i) ? top[1][i] : kb; }
            sv[rd] = ord2f(ka & ~127u) + ord2f(kb & ~127u);
            se[rd] = (127 - (int)(ka & 127u)) * 128 + (127 - (int)(kb & 127u));
        }
        float den = 0.f;
        const float mx0 = sv[0];
#pragma unroll
        for (int i = 0; i < 16; ++i) { sv[i] = __expf(sv[i] - mx0); den += sv[i]; }
        const float inv = 1.0f / den;
        const size_t ob = (size_t)(t0 + r) * 128 + hh * 16;
        if (h == 0) {
#pragma unroll
            for (int i = 0; i < 4; ++i) { int4 v = make_int4(se[4 * i], se[4 * i + 1], se[4 * i + 2], se[4 * i + 3]); *(int4*)(eidx + ob + 4 * i) = v; }
        } else {
#pragma unroll
            for (int i = 0; i < 4; ++i) { f32x4 v = {sv[4 * i] * inv, sv[4 * i + 1] * inv, sv[4 * i + 2] * inv, sv[4 * i + 3] * inv}; *(f32x4*)(gout + ob + 4 * i) = v; }
        }
    }
}

DI float gelu_exact(float v) { return 0.5f * v * (1.0f + erff(v * 0.70710678118654752f)); }
DI void convert_rows_fp8(const float* __restrict__ src, unsigned char* __restrict__ dst, float* __restrict__ inv, int nrows) {
    const int lane = threadIdx.x & 63, w = threadIdx.x >> 6;
    const int gwave = blockIdx.x * 4 + w, nwave = gridDim.x * 4;
    for (int row_ = gwave; row_ < nrows * REP_P0; row_ += nwave) {
        const int row = (REP_P0 == 1) ? row_ : row_ % nrows;
        const f32x4* p = (const f32x4*)(src + (size_t)row * DM + 16 * lane);
        f32x4 v[4];
#pragma unroll
        for (int i = 0; i < 4; ++i) v[i] = p[i];
        float am = 0.f;
#pragma unroll
        for (int i = 0; i < 4; ++i) am = fmaxf(am, fmaxf(fmaxf(fabsf(v[i].x), fabsf(v[i].y)), fmaxf(fabsf(v[i].z), fabsf(v[i].w))));
#pragma unroll
        for (int o = 32; o >= 1; o >>= 1) am = fmaxf(am, __shfl_xor(am, o));
        const unsigned eb = (__float_as_uint(am) >> 23) & 0xffu;
        float sc = 1.0f, isc = 1.0f;
        if (eb >= 16u && eb <= 250u) { sc = __uint_as_float((261u - eb) << 23); isc = __uint_as_float((eb - 7u) << 23); }
        u32x4 o;
#pragma unroll
        for (int i = 0; i < 4; ++i) {
            int pk = __builtin_amdgcn_cvt_pk_fp8_f32(v[i].x * sc, v[i].y * sc, 0, false);
            pk = __builtin_amdgcn_cvt_pk_fp8_f32(v[i].z * sc, v[i].w * sc, pk, true);
            o[i] = (unsigned)pk;
        }
        *(u32x4*)(dst + (size_t)row * DM + 16 * lane) = o;
        if (lane == 0) inv[row] = isc;
    }
}
DI float dot16(const unsigned (&a)[8], u32x4 b0, u32x4 b1) {
    float acc;
    asm volatile("v_dot2_f32_bf16 %0, %1, %9, 0\n\tv_dot2_f32_bf16 %0, %2, %10, %0\n\tv_dot2_f32_bf16 %0, %3, %11, %0\n\tv_dot2_f32_bf16 %0, %4, %12, %0\n\t"
                 "v_dot2_f32_bf16 %0, %5, %13, %0\n\tv_dot2_f32_bf16 %0, %6, %14, %0\n\tv_dot2_f32_bf16 %0, %7, %15, %0\n\tv_dot2_f32_bf16 %0, %8, %16, %0\n\ts_nop 2"
                 : "=&v"(acc)
                 : "v"(a[0]), "v"(a[1]), "v"(a[2]), "v"(a[3]), "v"(a[4]), "v"(a[5]), "v"(a[6]), "v"(a[7]),
                   "v"(b0.x), "v"(b0.y), "v"(b0.z), "v"(b0.w), "v"(b1.x), "v"(b1.y), "v"(b1.z), "v"(b1.w));
    return acc;
}
DI float dot_fp8_row(u32x4 u, u32x4 xa, u32x4 xb) {
    unsigned a[8];
#pragma unroll
    for (int j = 0; j < 4; ++j) {
        a[2 * j] = __builtin_bit_cast(unsigned, __builtin_amdgcn_cvt_scalef32_pk_bf16_fp8(u[j], 1.0f, false));
        a[2 * j + 1] = __builtin_bit_cast(unsigned, __builtin_amdgcn_cvt_scalef32_pk_bf16_fp8(u[j], 1.0f, true));
    }
    return dot16(a, xa, xb);
}
DI void axpy_fp8_row(f32x2 (&o)[8], float wgt, u32x4 v) {
    const f32x2 w2 = {wgt, wgt};
#pragma unroll
    for (int j = 0; j < 4; ++j) {
        const f32x2 lo = __builtin_amdgcn_cvt_pk_f32_fp8(v[j], false), hi = __builtin_amdgcn_cvt_pk_f32_fp8(v[j], true);
        o[2 * j] = __builtin_elementwise_fma(w2, lo, o[2 * j]);
        o[2 * j + 1] = __builtin_elementwise_fma(w2, hi, o[2 * j + 1]);
    }
}
struct TokMeta { int e0, e1; float su0, su1, gv0, gv1; u32x4 xa, xb; };
DI TokMeta load_meta(int t, int lane, const bf16_t* __restrict__ x1, const int* __restrict__ eidx, const float* __restrict__ gws, const float* __restrict__ su, const float* __restrict__ sv) {
    TokMeta m;
    m.e0 = eidx[(size_t)t * 128 + lane]; m.e1 = eidx[(size_t)t * 128 + 64 + lane];
    const float g0 = gws[(size_t)t * 128 + lane], g1 = gws[(size_t)t * 128 + 64 + lane];
    m.su0 = su[m.e0]; m.su1 = su[m.e1];
    m.gv0 = g0 * sv[m.e0]; m.gv1 = g1 * sv[m.e1];
    m.xa = *(const u32x4*)(x1 + (size_t)t * DM + 16 * lane); m.xb = *(const u32x4*)(x1 + (size_t)t * DM + 16 * lane + 8);
    return m;
}
DI void gather_issue(u32x4 (&bu)[8], u32x4 (&bv)[8], int ev, int lbase, int lane, const unsigned char* __restrict__ U8, const unsigned char* __restrict__ V8) {
#pragma unroll
    for (int i = 0; i < 8; ++i) {
        const int e = __builtin_amdgcn_readlane(ev, lbase + i);
        bu[i] = *(const u32x4*)(U8 + (size_t)e * DM + 16 * lane);
        bv[i] = *(const u32x4*)(V8 + (size_t)e * DM + 16 * lane);
    }
}
DI void gather_compute(const u32x4 (&bu)[8], const u32x4 (&bv)[8], float suv, float gvv, int lbase, int lane_in, u32x4 xa, u32x4 xb, f32x2 (&out)[8]) {
    int lane = lane_in;
    float d[8];
#pragma unroll
    for (int i = 0; i < 8; ++i) { d[i] = dot_fp8_row(bu[i], xa, xb) * __builtin_bit_cast(float, __builtin_amdgcn_readlane(__builtin_bit_cast(int, suv), lbase + i)); __builtin_amdgcn_sched_barrier(0); }
    float d4[4], d2[2], d1;
    asm volatile("" : "+v"(lane));
    {
        const bool hi = (lane & 32) != 0;
#pragma unroll
        for (int i = 0; i < 4; ++i) { const float keep = hi ? d[i + 4] : d[i], send = hi ? d[i] : d[i + 4]; d4[i] = keep + __shfl_xor(send, 32); }
    }
    {
        const bool hi = (lane & 16) != 0;
#pragma unroll
        for (int i = 0; i < 2; ++i) { const float keep = hi ? d4[i + 2] : d4[i], send = hi ? d4[i] : d4[i + 2]; d2[i] = keep + __shfl_xor(send, 16); }
    }
    {
        const bool hi = (lane & 8) != 0;
        const float keep = hi ? d2[1] : d2[0], send = hi ? d2[0] : d2[1];
        d1 = keep + __shfl_xor(send, 8);
    }
    d1 += __shfl_xor(d1, 4); d1 += __shfl_xor(d1, 2); d1 += __shfl_xor(d1, 1);
    const float hv = gelu_exact(d1);
#pragma unroll
    for (int i = 0; i < 8; ++i) {
        const int src = 8 * (i & 1) + 16 * ((i >> 1) & 1) + 32 * ((i >> 2) & 1);
        const float wi = __builtin_bit_cast(float, __builtin_amdgcn_readlane(__builtin_bit_cast(int, gvv), lbase + i)) *
                         __builtin_bit_cast(float, __builtin_amdgcn_readlane(__builtin_bit_cast(int, hv), src));
        axpy_fp8_row(out, wi, bv[i]);
        __builtin_amdgcn_sched_barrier(0);
    }
}
DI void peer_gather_phase(const bf16_t* __restrict__ x1, const int* __restrict__ eidx, const float* __restrict__ gws, const unsigned char* __restrict__ U8,
                          const unsigned char* __restrict__ V8, const float* __restrict__ su, const float* __restrict__ sv, const float* __restrict__ lng,
                          const float* __restrict__ lnb, bf16_t* __restrict__ xo_bf, float* __restrict__ xo_f32) {
    const int lane = threadIdx.x & 63, w = threadIdx.x >> 6;
    const int gwave = blockIdx.x * 4 + w, nwave = gridDim.x * 4;
    if (gwave < T_TOK) {
        TokMeta cur = load_meta(gwave, lane, x1, eidx, gws, su, sv);
        u32x4 au[8], av[8], bu[8], bv[8];
        gather_issue(au, av, cur.e0, 0, lane, U8, V8);
        for (int t_ = gwave; t_ < T_TOK * REP_GATHER; t_ += nwave) {
            const int t = (REP_GATHER == 1) ? t_ : t_ % T_TOK;
            const bool has_next = t_ + nwave < T_TOK * REP_GATHER;
            TokMeta nxt = cur;
            if (has_next) nxt = load_meta((REP_GATHER == 1) ? t_ + nwave : (t_ + nwave) % T_TOK, lane, x1, eidx, gws, su, sv);
            f32x2 out[8];
#pragma unroll
            for (int i = 0; i < 8; ++i) { out[i].x = 0.f; out[i].y = 0.f; }
            for (int jb = 0; jb < 16; jb += 2) {
                const int ev = (jb < 8) ? cur.e0 : cur.e1;
                const float suv = (jb < 8) ? cur.su0 : cur.su1, gvv = (jb < 8) ? cur.gv0 : cur.gv1;
                const int lbase = (jb & 7) * 8;
                gather_issue(bu, bv, ev, lbase + 8, lane, U8, V8);
                gather_compute(au, av, suv, gvv, lbase, lane, cur.xa, cur.xb, out);
                if (jb + 2 < 16) {
                    const int ev2 = (jb + 2 < 8) ? cur.e0 : cur.e1;
                    gather_issue(au, av, ev2, ((jb + 2) & 7) * 8, lane, U8, V8);
                } else if (has_next) {
                    gather_issue(au, av, nxt.e0, 0, lane, U8, V8);
                }
                gather_compute(bu, bv, suv, gvv, lbase + 8, lane, cur.xa, cur.xb, out);
            }
            float y[16];
            {
                const u32x4 xa = cur.xa, xb = cur.xb;
                y[0] = bf_lo(xa.x); y[1] = bf_hi(xa.x); y[2] = bf_lo(xa.y); y[3] = bf_hi(xa.y); y[4] = bf_lo(xa.z); y[5] = bf_hi(xa.z); y[6] = bf_lo(xa.w); y[7] = bf_hi(xa.w);
                y[8] = bf_lo(xb.x); y[9] = bf_hi(xb.x); y[10] = bf_lo(xb.y); y[11] = bf_hi(xb.y); y[12] = bf_lo(xb.z); y[13] = bf_hi(xb.z); y[14] = bf_lo(xb.w); y[15] = bf_hi(xb.w);
            }
            float s = 0.f;
#pragma unroll
            for (int i = 0; i < 8; ++i) { y[2 * i] = DN_ALPHA * y[2 * i] + out[i].x; y[2 * i + 1] = DN_ALPHA * y[2 * i + 1] + out[i].y; s += y[2 * i] + y[2 * i + 1]; }
            const float mu = wave_sum(s) * (1.0f / DM);
            float qq = 0.f;
#pragma unroll
            for (int i = 0; i < 16; ++i) { const float dd = y[i] - mu; qq += dd * dd; }
            const float rstd = rsqrtf(wave_sum(qq) * (1.0f / DM) + LN_EPS);
            const int col = 16 * lane;
            f32x4 o4[4];
#pragma unroll
            for (int q4 = 0; q4 < 4; ++q4) {
                const f32x4 ga = *(const f32x4*)(lng + col + 4 * q4), ba = *(const f32x4*)(lnb + col + 4 * q4);
#pragma unroll
                for (int e = 0; e < 4; ++e) o4[q4][e] = (y[4 * q4 + e] - mu) * rstd * ga[e] + ba[e];
            }
            if (xo_f32) {
#pragma unroll
                for (int q4 = 0; q4 < 4; ++q4) *(f32x4*)(xo_f32 + (size_t)t * DM + col + 4 * q4) = o4[q4];
            }
            if (xo_bf) {
                u32x4 w0 = {pk_bf16(o4[0].x, o4[0].y), pk_bf16(o4[0].z, o4[0].w), pk_bf16(o4[1].x, o4[1].y), pk_bf16(o4[1].z, o4[1].w)};
                u32x4 w1 = {pk_bf16(o4[2].x, o4[2].y), pk_bf16(o4[2].z, o4[2].w), pk_bf16(o4[3].x, o4[3].y), pk_bf16(o4[3].z, o4[3].w)};
                *(u32x4*)(xo_bf + (size_t)t * DM + col) = w0; *(u32x4*)(xo_bf + (size_t)t * DM + col + 8) = w1;
            }
            cur = nxt;
        }
    }
}

struct SliceMap { int j0, jstep, wslot, nslot; };
DI SliceMap slice_map(int w) {
    SliceMap m; const int G = gridDim.x;
    if (G >= 8) { m.j0 = blockIdx.x & 7; m.jstep = 8; m.wslot = (blockIdx.x >> 3) * 4 + w; m.nslot = ((G - m.j0 + 7) >> 3) * 4; }
    else { m.j0 = 0; m.jstep = 1; m.wslot = blockIdx.x * 4 + w; m.nslot = G * 4; }
    return m;
}
DI void peer_u_phase(const bf16_t* __restrict__ x1, const int* __restrict__ eidx, const unsigned char* __restrict__ U8, float* __restrict__ ph) {
    int tidv = threadIdx.x;
    asm volatile("" : "+v"(tidv));
    const int lane = tidv & 63, w = tidv >> 6, grp = lane >> 3, l8 = lane & 7;
    const SliceMap sm = slice_map(w);
    for (int j_ = sm.j0; j_ < 8 * REP_PU; j_ += sm.jstep) {
        const int j = j_ & 7;
        const unsigned char* ub = U8 + 128 * j + 16 * l8;
        const bf16_t* xb_ = x1 + 128 * j + 16 * l8;
        float* pj = ph + (size_t)j * T_TOK * 128;
        const int step = sm.nslot;
        int t = sm.wslot;
        if (t >= T_TOK) continue;
        u32x4 sa[16], sb[16];
        int e0n = 0, e1n = 0;
        u32x4 xa, xb, xan, xbn;
#define U_ISSUE(SEG, E0, E1) { _Pragma("unroll") for (int b = 0; b < 16; ++b) { const int e = __shfl((b < 8) ? (E0) : (E1), (b & 7) * 8 + grp); SEG[b] = *(const u32x4*)(ub + (size_t)e * DM); } }
#define U_COMPUTE(SEG, TT) { float hsum[2]; __builtin_amdgcn_s_setprio(1); \
            _Pragma("unroll") for (int hf = 0; hf < 2; ++hf) { float d[8]; \
                _Pragma("unroll") for (int i = 0; i < 8; ++i) { d[i] = dot_fp8_row(SEG[hf * 8 + i], xa, xb); } \
                float d4[4], d2[2]; \
                { const bool hi = (l8 & 4) != 0; _Pragma("unroll") for (int i = 0; i < 4; ++i) { const float keep = hi ? d[i + 4] : d[i], send = hi ? d[i] : d[i + 4]; d4[i] = keep + __shfl_xor(send, 4); } } \
                { const bool hi = (l8 & 2) != 0; _Pragma("unroll") for (int i = 0; i < 2; ++i) { const float keep = hi ? d4[i + 2] : d4[i], send = hi ? d4[i] : d4[i + 2]; d2[i] = keep + __shfl_xor(send, 2); } } \
                { const bool hi = (l8 & 1) != 0; const float keep = hi ? d2[1] : d2[0], send = hi ? d2[0] : d2[1]; hsum[hf] = keep + __shfl_xor(send, 1); } } \
            __builtin_amdgcn_s_setprio(0); \
            pj[(size_t)(TT) * 128 + 8 * l8 + grp] = hsum[0]; pj[(size_t)(TT) * 128 + 64 + 8 * l8 + grp] = hsum[1]; }
        {
            const int e0 = eidx[(size_t)t * 128 + lane], e1 = eidx[(size_t)t * 128 + 64 + lane];
            xa = *(const u32x4*)(xb_ + (size_t)t * DM); xb = *(const u32x4*)(xb_ + (size_t)t * DM + 8);
            U_ISSUE(sa, e0, e1)
            if (t + step < T_TOK) { e0n = eidx[(size_t)(t + step) * 128 + lane]; e1n = eidx[(size_t)(t + step) * 128 + 64 + lane]; }
        }
        for (; t < T_TOK; t += 2 * step) {
            int e0nn = 0, e1nn = 0;
            const bool n1 = t + step < T_TOK, n2 = t + 2 * step < T_TOK, n3 = t + 3 * step < T_TOK;
            if (n1) { U_ISSUE(sb, e0n, e1n) xan = *(const u32x4*)(xb_ + (size_t)(t + step) * DM); xbn = *(const u32x4*)(xb_ + (size_t)(t + step) * DM + 8); }
            if (n2) { e0nn = eidx[(size_t)(t + 2 * step) * 128 + lane]; e1nn = eidx[(size_t)(t + 2 * step) * 128 + 64 + lane]; }
            U_COMPUTE(sa, t)
            if (n1) {
                xa = xan; xb = xbn;
                if (n2) { U_ISSUE(sa, e0nn, e1nn) xan = *(const u32x4*)(xb_ + (size_t)(t + 2 * step) * DM); xbn = *(const u32x4*)(xb_ + (size_t)(t + 2 * step) * DM + 8); }
                if (n3) { e0n = eidx[(size_t)(t + 3 * step) * 128 + lane]; e1n = eidx[(size_t)(t + 3 * step) * 128 + 64 + lane]; }
                U_COMPUTE(sb, t + step)
                xa = xan; xb = xbn;
            }
        }
#undef U_ISSUE
#undef U_COMPUTE
    }
}
DI void peer_hw_phase(const float* __restrict__ ph, const int* __restrict__ eidx, const float* __restrict__ su, const float* __restrict__ sv, float* __restrict__ gws) {
    const size_t n = (size_t)T_TOK * 128, nthreads = (size_t)gridDim.x * blockDim.x;
    for (size_t i = (size_t)blockIdx.x * blockDim.x + threadIdx.x; i < n; i += nthreads) {
        float hsum = 0.f;
#pragma unroll
        for (int j = 0; j < 8; ++j) hsum += ph[(size_t)j * n + i];
        const int e = eidx[i];
        gws[i] = gws[i] * gelu_exact(hsum * su[e]) * sv[e];
    }
}
DI void peer_v_phase(const bf16_t* __restrict__ x1, const int* __restrict__ eidx, const float* __restrict__ wgt, const unsigned char* __restrict__ V8, bf16_t* __restrict__ y) {
    int tidv = threadIdx.x;
    asm volatile("" : "+v"(tidv));
    const int lane = tidv & 63, w = tidv >> 6, grp = lane >> 3, l8 = lane & 7;
    const SliceMap sm = slice_map(w);
    for (int j_ = sm.j0; j_ < 8 * REP_PV; j_ += sm.jstep) {
        const int j = j_ & 7;
        const unsigned char* vb = V8 + 128 * j + 16 * l8;
        const int col = 128 * j + 16 * l8 + 2 * grp;
        const int step = sm.nslot;
        int t = sm.wslot;
        if (t >= T_TOK) continue;
        u32x4 sa[16], sb[16];
        int e0n = 0, e1n = 0;
        float w0, w1, w0n = 0.f, w1n = 0.f;
#define V_ISSUE(SEG, E0, E1) { _Pragma("unroll") for (int b = 0; b < 16; ++b) { const int e = __shfl((b < 8) ? (E0) : (E1), (b & 7) * 8 + grp); SEG[b] = *(const u32x4*)(vb + (size_t)e * DM); } }
#define V_COMPUTE(SEG, TT) { f32x2 acc[8]; __builtin_amdgcn_s_setprio(1); \
            _Pragma("unroll") for (int i = 0; i < 8; ++i) { acc[i].x = 0.f; acc[i].y = 0.f; } \
            _Pragma("unroll") for (int b = 0; b < 16; ++b) { const float wv = __shfl((b < 8) ? w0 : w1, (b & 7) * 8 + grp); axpy_fp8_row(acc, wv, SEG[b]); } \
            float a8[8], a4[4], a2[2]; \
            { const bool hi = (lane & 32) != 0; _Pragma("unroll") for (int i = 0; i < 8; ++i) { const float lo_ = (i & 1) ? acc[i >> 1].y : acc[i >> 1].x, hi_ = (i & 1) ? acc[4 + (i >> 1)].y : acc[4 + (i >> 1)].x; \
                const float keep = hi ? hi_ : lo_, send = hi ? lo_ : hi_; a8[i] = keep + __shfl_xor(send, 32); } } \
            { const bool hi = (lane & 16) != 0; _Pragma("unroll") for (int i = 0; i < 4; ++i) { const float keep = hi ? a8[i + 4] : a8[i], send = hi ? a8[i] : a8[i + 4]; a4[i] = keep + __shfl_xor(send, 16); } } \
            { const bool hi = (lane & 8) != 0; _Pragma("unroll") for (int i = 0; i < 2; ++i) { const float keep = hi ? a4[i + 2] : a4[i], send = hi ? a4[i] : a4[i + 2]; a2[i] = keep + __shfl_xor(send, 8); } } \
            __builtin_amdgcn_s_setprio(0); \
            const unsigned xr = *(const unsigned*)(x1 + (size_t)(TT) * DM + col); \
            *(unsigned*)(y + (size_t)(TT) * DM + col) = pk_bf16(DN_ALPHA * bf_lo(xr) + a2[0], DN_ALPHA * bf_hi(xr) + a2[1]); }
        {
            const int e0 = eidx[(size_t)t * 128 + lane], e1 = eidx[(size_t)t * 128 + 64 + lane];
            w0 = wgt[(size_t)t * 128 + lane]; w1 = wgt[(size_t)t * 128 + 64 + lane];
            V_ISSUE(sa, e0, e1)
            if (t + step < T_TOK) { e0n = eidx[(size_t)(t + step) * 128 + lane]; e1n = eidx[(size_t)(t + step) * 128 + 64 + lane]; }
        }
        for (; t < T_TOK; t += 2 * step) {
            int e0nn = 0, e1nn = 0;
            const bool n1 = t + step < T_TOK, n2 = t + 2 * step < T_TOK, n3 = t + 3 * step < T_TOK;
            if (n1) { V_ISSUE(sb, e0n, e1n) w0n = wgt[(size_t)(t + step) * 128 + lane]; w1n = wgt[(size_t)(t + step) * 128 + 64 + lane]; }
            if (n2) { e0nn = eidx[(size_t)(t + 2 * step) * 128 + lane]; e1nn = eidx[(size_t)(t + 2 * step) * 128 + 64 + lane]; }
            V_COMPUTE(sa, t)
            if (n1) {
                w0 = w0n; w1 = w1n;
                if (n2) { V_ISSUE(sa, e0nn, e1nn) w0n = wgt[(size_t)(t + 2 * step) * 128 + lane]; w1n = wgt[(size_t)(t + 2 * step) * 128 + 64 + lane]; }
                if (n3) { e0n = eidx[(size_t)(t + 3 * step) * 128 + lane]; e1n = eidx[(size_t)(t + 3 * step) * 128 + 64 + lane]; }
                V_COMPUTE(sb, t + step)
                w0 = w0n; w1 = w1n;
            }
        }
#undef V_ISSUE
#undef V_COMPUTE
    }
}

#define XB_TMO      128
#define XB_XCNT(j)  (256  + 64 * (j))
#define XB_XSUB(j)  (1280 + 64 * (j))
#define XB_XGEN(j)  (2304 + 64 * (j))
#define XB_TOP      3328
#define XB_TOPGEN   3392
#define XCD_BAR_WORDS 3456
#define XB_SPIN_CAP (1u << 22)
#define LAS __attribute__((address_space(3)))

__device__ __forceinline__ unsigned xb_ld(unsigned* p)              { return __hip_atomic_load(p, __ATOMIC_RELAXED, __HIP_MEMORY_SCOPE_AGENT); }
__device__ __forceinline__ unsigned xb_add(unsigned* p, unsigned v) { return __hip_atomic_fetch_add(p, v, __ATOMIC_RELAXED, __HIP_MEMORY_SCOPE_AGENT); }
__device__ __forceinline__ unsigned xb_xcc_id() { return (unsigned)__builtin_amdgcn_s_getreg((3 << 11) | 20) & 0xFu; }
#define XB_SPIN(cond, bar) do { unsigned _sp = 0; while (cond) { __builtin_amdgcn_s_sleep(1); \
    if ((++_sp & 255u) == 0u) { if (xb_ld(&(bar)[XB_TMO])) break; if (_sp > XB_SPIN_CAP) { atomicAdd(&(bar)[XB_TMO], 1u); break; } } } } while (0)

struct XcdBarrier {
    unsigned* bar; unsigned x;
    volatile LAS unsigned* st;
};

__device__ __forceinline__ XcdBarrier xcd_barrier_post(unsigned* bar, volatile LAS unsigned* st) {
    XcdBarrier b; b.bar = bar; b.x = xb_xcc_id(); b.st = st;
    if (threadIdx.x == 0) (void)xb_add(&bar[XB_XCNT(b.x)], 1u);
    return b;
}
__device__ __forceinline__ void xcd_barrier_complete(unsigned* bar, unsigned x, unsigned& nloc, unsigned& nx) {
    const unsigned G = gridDim.x * gridDim.y * gridDim.z;
    unsigned sum, cnt, mine, sp = 0u;
    for (;;) {
        sum = 0u; cnt = 0u; mine = 0u;
#pragma unroll
        for (unsigned j = 0; j < 16; ++j) { const unsigned c = xb_ld(&bar[XB_XCNT(j)]); sum += c; cnt += (c > 0u) ? 1u : 0u; mine = (j == x) ? c : mine; }
        if (sum == G) break;
        __builtin_amdgcn_s_sleep(1);
        if ((++sp & 255u) == 0u) { if (xb_ld(&bar[XB_TMO])) break; if (sp > XB_SPIN_CAP) { atomicAdd(&bar[XB_TMO], 1u); break; } }
    }
    nloc = mine > 0u ? mine : 1u; nx = cnt > 0u ? cnt : 1u;
}

__device__ __forceinline__ void xcd_barrier(const XcdBarrier& b) {
    asm volatile("s_waitcnt vmcnt(0)" ::: "memory");
    __syncthreads();
    if (threadIdx.x == 0) {
        unsigned* bar = b.bar;
        __builtin_amdgcn_s_waitcnt(0);
        unsigned nloc = b.st[0], nx = b.st[1];
        if (nloc == 0u) { xcd_barrier_complete(bar, b.x, nloc, nx); b.st[0] = nloc; b.st[1] = nx; }
        const unsigned old = xb_add(&bar[XB_XSUB(b.x)], 1u);
        const unsigned gen = old / nloc;
        if (old + 1u == (gen + 1u) * nloc) {
            __builtin_amdgcn_fence(__ATOMIC_RELEASE, "agent");
            asm volatile("s_waitcnt vmcnt(0)" ::: "memory");
            const unsigned og = xb_add(&bar[XB_TOP], 1u);
            const unsigned tg = og / nx;
            if (og + 1u == (tg + 1u) * nx) xb_add(&bar[XB_TOPGEN], 1u);
            else XB_SPIN(xb_ld(&bar[XB_TOPGEN]) == tg, bar);
            __builtin_amdgcn_fence(__ATOMIC_ACQUIRE, "agent");
            xb_add(&bar[XB_XGEN(b.x)], 1u);
            asm volatile("s_waitcnt vmcnt(0)" ::: "memory");
        } else {
            XB_SPIN(xb_ld(&bar[XB_XGEN(b.x)]) == gen, bar);
            __builtin_amdgcn_fence(__ATOMIC_ACQUIRE, "agent");
            asm volatile("s_waitcnt vmcnt(0)" ::: "memory");
        }
    }
    __syncthreads();
}


DI void gsync(cg::grid_group& g) {
    asm volatile("s_waitcnt vmcnt(0) lgkmcnt(0)" ::: "memory");
    g.sync();
    if (threadIdx.x == 0) { __builtin_amdgcn_fence(__ATOMIC_ACQUIRE, "agent"); asm volatile("s_waitcnt vmcnt(0)" ::: "memory"); }
    __syncthreads();
}

__global__ void __launch_bounds__(256, 2) mega_fwd(Params P) {
    extern __shared__ __attribute__((aligned(16))) unsigned char lds[];
    cg::grid_group grid = cg::this_grid();
    volatile LAS unsigned* xb_st = (volatile LAS unsigned*)(lds + LDS_PHASE_BYTES);
    if (threadIdx.x == 0) { xb_st[0] = 0u; xb_st[1] = 0u; }
    __syncthreads();
    const XcdBarrier xbar = xcd_barrier_post((unsigned*)(P.ws + W_BAR), xb_st);
    unsigned char* ws = P.ws;
    bf16_t* r0 = (bf16_t*)(ws + R0);
    bf16_t* r1 = (bf16_t*)(ws + R1);
    bf16_t* r2 = (bf16_t*)(ws + R2);
    bf16_t* r3 = (bf16_t*)(ws + R3);
    int* eidx = (int*)(ws + R4);
    float* gws = (float*)(ws + R4 + 32 * MBy);
    unsigned char* U8 = ws + R5;
    unsigned char* V8 = ws + R5 + 32 * MBy;
    float* su = (float*)(ws + W_SCALE);
    float* sv = su + 2 * 16384;
    bf16_t* w_daqkv = (bf16_t*)(ws + W_DAQKV);
    bf16_t* w_dawo = (bf16_t*)(ws + W_DAWO);
    bf16_t* w_swqkv = (bf16_t*)(ws + W_SWQKV);
    bf16_t* w_swwo = (bf16_t*)(ws + W_SWWO);
    bf16_t* w_pkq0 = (bf16_t*)(ws + W_PKQ0);
    bf16_t* w_pkq1 = (bf16_t*)(ws + W_PKQ1);
    bf16_t* subk = (bf16_t*)(ws + W_SUBK);
    f32x2* rope = (f32x2*)(ws + W_ROPE);
    float* yf = (float*)(ws + R0);
    bf16_t* yb = (bf16_t*)(ws + R0);
    constexpr size_t TD = (size_t)T_TOK * DM;
    constexpr size_t NE = (size_t)16384 * DM;

    convert_flat(P.x, r1, TD);
    convert_rows_fp8(P.pk_u, U8, su, 2 * 16384);
    convert_rows_fp8(P.pk_v, V8, sv, 2 * 16384);
    convert_flat(P.pk_sub_keys, subk, (size_t)2 * 8 * 2 * 128 * 64);
    transpose_convert(P.da_w_qkv, w_daqkv, 3072, (float*)lds);
    transpose_convert(P.da_w_o, w_dawo, 1024, (float*)lds);
    transpose_convert(P.sw_w_qkv, w_swqkv, 1280, (float*)lds);
    transpose_convert(P.sw_w_o, w_swwo, 1024, (float*)lds);
    transpose_convert(P.pk_w_query, w_pkq0, 1024, (float*)lds);
    transpose_convert(P.pk_w_query + (size_t)1024 * 1024, w_pkq1, 1024, (float*)lds);
    rope_table(rope);
    gsync(grid);

    {
        bf16_t* q = r0; bf16_t* k = r0 + TD; bf16_t* vt = r0 + 2 * TD;
        EpiQKV e{q, k, vt, rope, nullptr, 1024, 1024, 7, 8};
        gemm_phase(r1, w_daqkv, T_TOK, 2048, 1024, lds, e);
        { EpiVt ev{vt, nullptr, 7, 8}; gemm_phase<EpiVt, true>(r1, w_daqkv + (size_t)2048 * 1024, T_TOK, 1024, 1024, lds, ev); }
        xcd_barrier(xbar);
        AttnArgs a{q, k, vt, r2, P.da_lambda, P.da_subln_g, nullptr, nullptr};
        attn_phase<0>(a, lds);
        xcd_barrier(xbar);
        diff_combine_phase(r2, P.da_lambda, P.da_subln_g, r1);
        xcd_barrier(xbar);
        EpiRes<true> er{(const void*)P.x, nullptr, yb};
        gemm_phase(r1, w_dawo, T_TOK, 1024, 1024, lds, er);
        xcd_barrier(xbar);
        ln_phase(yb, P.ln1_g, P.ln1_b, r2);
        xcd_barrier(xbar);
        EpiBf16 eq{r3};
        gemm_phase(r2, w_pkq0, T_TOK, 1024, 1024, lds, eq);
        xcd_barrier(xbar);
        peer_topk_phase(r3, subk, eidx, gws);
        xcd_barrier(xbar);
        peer_u_phase(r2, eidx, U8, yf);
        xcd_barrier(xbar);
        peer_hw_phase(yf, eidx, su, sv, gws);
        xcd_barrier(xbar);
        peer_v_phase(r2, eidx, gws, V8, yb);
        xcd_barrier(xbar);
        ln_phase(yb, P.ln2_g, P.ln2_b, r1);
        xcd_barrier(xbar);
    }
    {
        bf16_t* q = r0; bf16_t* k = r0 + TD; bf16_t* vt = k + (size_t)T_TOK * 128;
        EpiQKV e{q, k, vt, rope, P.sw_b_qkv, 1024, 128, 6, 2};
        gemm_phase(r1, w_swqkv, T_TOK, 1152, 1024, lds, e);
        { EpiVt ev{vt, P.sw_b_qkv + 1152, 6, 2}; gemm_phase<EpiVt, true>(r1, w_swqkv + (size_t)1152 * 1024, T_TOK, 128, 1024, lds, ev); }
        xcd_barrier(xbar);
        AttnArgs a{q, k, vt, r2, nullptr, nullptr, P.sw_sinks, nullptr};
        attn_phase<1>(a, lds);
        xcd_barrier(xbar);
        EpiRes<false> er{(const void*)r1, P.sw_b_o, yb};
        gemm_phase(r2, w_swwo, T_TOK, 1024, 1024, lds, er);
        xcd_barrier(xbar);
        ln_phase(yb, P.ln1_g + DM, P.ln1_b + DM, r3);
        xcd_barrier(xbar);
        EpiBf16 eq{r2};
        gemm_phase(r3, w_pkq1, T_TOK, 1024, 1024, lds, eq);
        xcd_barrier(xbar);
        peer_topk_phase(r2, subk + (size_t)8 * 2 * 128 * 64, eidx, gws);
        xcd_barrier(xbar);
        peer_u_phase(r3, eidx, U8 + NE, yf);
        xcd_barrier(xbar);
        peer_hw_phase(yf, eidx, su + 16384, sv + 16384, gws);
        xcd_barrier(xbar);
        peer_v_phase(r3, eidx, gws, V8 + NE, yb);
        xcd_barrier(xbar);
        ln_phase(yb, P.ln2_g + DM, P.ln2_b + DM, nullptr, P.out);
    }
}

extern "C" void kernel_launch(void* const* d_in, const int* in_sizes, int n_in, void* d_out, int out_size, void* d_ws, size_t ws_size, hipStream_t stream) {
    static int grid_blocks = 0;
    if (grid_blocks == 0) {
        if (n_in != 18 || ws_size < WS_END) { fprintf(stderr, "kernel_launch: unexpected n_in %d or ws_size %zu (< %zu)\n", n_in, ws_size, (size_t)WS_END); grid_blocks = -1; return; }
        int dev = 0, cus = 0, per_cu = 0;
        hipGetDevice(&dev);
        hipDeviceGetAttribute(&cus, hipDeviceAttributeMultiprocessorCount, dev);
        if (hipFuncSetAttribute((const void*)mega_fwd, hipFuncAttributeMaxDynamicSharedMemorySize, LDS_BYTES) != hipSuccess) { fprintf(stderr, "kernel_launch: hipFuncSetAttribute failed\n"); grid_blocks = -1; return; }
        if (hipOccupancyMaxActiveBlocksPerMultiprocessor(&per_cu, (const void*)mega_fwd, 256, LDS_BYTES) != hipSuccess || per_cu < 1) { fprintf(stderr, "kernel_launch: occupancy query failed (%d)\n", per_cu); per_cu = 1; (void)hipGetLastError(); }
        grid_blocks = cus * per_cu;
        fprintf(stderr, "kernel_launch: grid %d (%d CUs x %d)\n", grid_blocks, cus, per_cu);
    }
    if (grid_blocks < 0) return;
    Params p{};
    p.x = (const float*)d_in[0]; p.da_w_qkv = (const float*)d_in[1]; p.da_lambda = (const float*)d_in[2]; p.da_subln_g = (const float*)d_in[3]; p.da_w_o = (const float*)d_in[4];
    p.sw_w_qkv = (const float*)d_in[5]; p.sw_b_qkv = (const float*)d_in[6]; p.sw_sinks = (const float*)d_in[7]; p.sw_w_o = (const float*)d_in[8]; p.sw_b_o = (const float*)d_in[9];
    p.pk_w_query = (const float*)d_in[10]; p.pk_sub_keys = (const float*)d_in[11]; p.pk_u = (const float*)d_in[12]; p.pk_v = (const float*)d_in[13];
    p.ln1_g = (const float*)d_in[14]; p.ln1_b = (const float*)d_in[15]; p.ln2_g = (const float*)d_in[16]; p.ln2_b = (const float*)d_in[17];
    p.out = (float*)d_out; p.ws = (unsigned char*)d_ws;
    if (hipMemsetAsync((unsigned char*)d_ws + W_BAR, 0, XCD_BAR_WORDS * sizeof(unsigned), stream) != hipSuccess) { fprintf(stderr, "kernel_launch: hipMemsetAsync failed\n"); return; }
    void* args[] = {&p};
    hipError_t e = hipLaunchCooperativeKernel((const void*)mega_fwd, dim3(grid_blocks), dim3(256), args, LDS_BYTES, stream);
    if (e != hipSuccess) fprintf(stderr, "cooperative launch failed: %s (grid %d)\n", hipGetErrorString(e), grid_blocks);
}
```

```cpp
#include <hip/hip_runtime.h>
#include <hip/hip_cooperative_groups.h>
#include <cstdio>
#include <cstdint>
namespace cg = cooperative_groups;

#define DI __device__ __forceinline__
typedef unsigned short bf16_t;
typedef short bf16x8 __attribute__((ext_vector_type(8)));
typedef float f32x16 __attribute__((ext_vector_type(16)));
typedef float f32x4 __attribute__((ext_vector_type(4)));
typedef float f32x2 __attribute__((ext_vector_type(2)));
typedef unsigned u32x4 __attribute__((ext_vector_type(4)));
typedef unsigned u32x2 __attribute__((ext_vector_type(2)));
typedef __bf16 bf16x2_t __attribute__((ext_vector_type(2)));
#define MFMA(a, b, c) __builtin_amdgcn_mfma_f32_32x32x16_bf16((a), (b), (c), 0, 0, 0)

constexpr int T_TOK = 65536, DM = 1024, SEQ = 8192;
constexpr float DN_ALPHA = 1.41421356237309515f;
constexpr float LN_EPS = 1e-5f;
constexpr float LOG2E = 1.44269504088896341f;
constexpr float LAMBDA_INIT0 = 0.2f;

constexpr size_t MBy = 1u << 20;
constexpr size_t R0 = 0, R1 = 384 * MBy, R2 = 512 * MBy, R3 = 640 * MBy, R4 = 768 * MBy, R5 = 832 * MBy, R6 = 960 * MBy;
constexpr size_t W_DAQKV = R6, W_DAWO = R6 + 6 * MBy, W_SWQKV = R6 + 8 * MBy, W_SWWO = R6 + 11 * MBy, W_PKQ0 = R6 + 13 * MBy, W_PKQ1 = R6 + 15 * MBy,
                 W_SUBK = R6 + 17 * MBy, W_ROPE = R6 + 18 * MBy, W_SCALE = R6 + 20 * MBy, W_BAR = R6 + 21 * MBy, WS_END = R6 + 22 * MBy;
constexpr int LDS_PHASE_BYTES = 73728, LDS_BYTES = LDS_PHASE_BYTES + 16;
#ifndef REP_GEMM
#define REP_GEMM 1
#endif
#ifndef REP_ATT0
#define REP_ATT0 1
#endif
#ifndef REP_ATT1
#define REP_ATT1 1
#endif
#ifndef REP_TOPK
#define REP_TOPK 1
#endif
#ifndef REP_GATHER
#define REP_GATHER 1
#endif
#ifndef REP_P0
#define REP_P0 1
#endif
#ifndef REP_PU
#define REP_PU 1
#endif
#ifndef REP_PV
#define REP_PV 1
#endif

__constant__ float c_inv_freq[32] = {
    1.000000000e+00f, 7.498942018e-01f, 5.623413324e-01f, 4.216965139e-01f, 3.162277639e-01f, 2.371373922e-01f, 1.778279394e-01f, 1.333521456e-01f,
    1.000000015e-01f, 7.498941571e-02f, 5.623412877e-02f, 4.216964915e-02f, 3.162277862e-02f, 2.371373586e-02f, 1.778279431e-02f, 1.333521493e-02f,
    9.999999776e-03f, 7.498942316e-03f, 5.623413250e-03f, 4.216964822e-03f, 3.162277862e-03f, 2.371373819e-03f, 1.778279431e-03f, 1.333521446e-03f,
    1.000000047e-03f, 7.498941850e-04f, 5.623413017e-04f, 4.216965463e-04f, 3.162277862e-04f, 2.371373848e-04f, 1.778279402e-04f, 1.333521504e-04f};

struct Params {
    const float* x; const float* da_w_qkv; const float* da_lambda; const float* da_subln_g; const float* da_w_o;
    const float* sw_w_qkv; const float* sw_b_qkv; const float* sw_sinks; const float* sw_w_o; const float* sw_b_o;
    const float* pk_w_query; const float* pk_sub_keys; const float* pk_u; const float* pk_v;
    const float* ln1_g; const float* ln1_b; const float* ln2_g; const float* ln2_b;
    float* out; unsigned char* ws;
};

DI unsigned pk_bf16(float a, float b) { f32x2 f = {a, b}; return __builtin_bit_cast(unsigned, __builtin_convertvector(f, bf16x2_t)); }
DI bf16_t to_bf16(float a) { return (bf16_t)(pk_bf16(a, a) & 0xffffu); }
DI float bf_lo(unsigned u) { return __uint_as_float(u << 16); }
DI float bf_hi(unsigned u) { return __uint_as_float(u & 0xffff0000u); }
DI float wave_sum(float v) {
#pragma unroll
    for (int o = 32; o >= 1; o >>= 1) v += __shfl_xor(v, o);
    return v;
}

DI void convert_flat(const float* __restrict__ src, bf16_t* __restrict__ dst, size_t n) {
    const size_t nthreads = (size_t)gridDim.x * blockDim.x;
    for (size_t i_ = (size_t)blockIdx.x * blockDim.x + threadIdx.x; i_ < (n / 8) * REP_P0; i_ += nthreads) {
        const size_t i = (REP_P0 == 1) ? i_ : i_ % (n / 8);
        const f32x4 a = ((const f32x4*)src)[2 * i], b = ((const f32x4*)src)[2 * i + 1];
        u32x4 o; o.x = pk_bf16(a.x, a.y); o.y = pk_bf16(a.z, a.w); o.z = pk_bf16(b.x, b.y); o.w = pk_bf16(b.z, b.w);
        ((u32x4*)dst)[i] = o;
    }
}
DI void transpose_convert(const float* __restrict__ src, bf16_t* __restrict__ dst, int N, float* ldsf) {
    const int tilesN = N >> 6, ntiles = 16 * tilesN;
    const int tx = threadIdx.x & 63, ty = threadIdx.x >> 6;
    for (int tile = blockIdx.x; tile < ntiles; tile += gridDim.x) {
        const int tk = tile / tilesN, tn = tile - tk * tilesN;
        __syncthreads();
#pragma unroll
        for (int i = 0; i < 16; ++i) { const int k = ty + 4 * i; ldsf[k * 65 + tx] = src[(size_t)(tk * 64 + k) * N + tn * 64 + tx]; }
        __syncthreads();
#pragma unroll
        for (int i = 0; i < 16; ++i) { const int n = ty + 4 * i; dst[(size_t)(tn * 64 + n) * 1024 + tk * 64 + tx] = to_bf16(ldsf[tx * 65 + n]); }
    }
}
DI void rope_table(f32x2* rope) {
    const int nthreads = gridDim.x * blockDim.x;
    for (int i = blockIdx.x * blockDim.x + threadIdx.x; i < SEQ * 32; i += nthreads) {
        const int pos = i >> 5, j = i & 31;
        const float ang = (float)pos * c_inv_freq[j];
        const float kf = rintf(ang * 0.636619772367581343f);
        float rr = fmaf(-kf, 1.57079637050628662109375f, ang);
        rr = fmaf(-kf, -4.37113882867379294e-8f, rr);
        const float r2 = rr * rr;
        const float sn = rr + rr * r2 * (-1.6666654611e-1f + r2 * (8.3321608736e-3f + r2 * (-1.9515295891e-4f)));
        const float cs = 1.0f - 0.5f * r2 + r2 * r2 * (4.166664568298827e-2f + r2 * (-1.388731625493765e-3f + r2 * 2.443315711809948e-5f));
        const int q = ((int)kf) & 3;
        float c, s;
        if (q == 0) { c = cs; s = sn; } else if (q == 1) { c = -sn; s = cs; } else if (q == 2) { c = -cs; s = -sn; } else { c = sn; s = -cs; }
        f32x2 o = {c, s};
        rope[i] = o;
    }
}

DI void store_row32_bf16(bf16_t* rowp, const u32x2 (&A)[4], int h) {
#pragma unroll
    for (int gp = 0; gp < 2; ++gp) {
        const auto r0 = __builtin_amdgcn_permlane32_swap(A[2 * gp].x, A[2 * gp + 1].x, false, false);
        const auto r1 = __builtin_amdgcn_permlane32_swap(A[2 * gp].y, A[2 * gp + 1].y, false, false);
        u32x4 wv = {(unsigned)r0[0], (unsigned)r1[0], (unsigned)r0[1], (unsigned)r1[1]};
        *(u32x4*)(rowp + 16 * gp + 8 * h) = wv;
    }
}

template <class Epi, bool SW = false>
DI void gemm_phase(const bf16_t* __restrict__ A, const bf16_t* __restrict__ Bt, int M, int N, int K, unsigned char* lds, const Epi& epi) {
    constexpr int STR = 144, TB = 128 * STR;
    const int tid = threadIdx.x, lane = tid & 63, w = tid >> 6, wm = w >> 1, wn = w & 1, r = lane & 31, h = lane >> 5;
    const int tilesN = N >> 7, ntiles = (M >> 7) * tilesN, nk = K >> 6;
    const int lrow = tid >> 3, lcol = tid & 7;
    const int G = gridDim.x, tilesM = M >> 7;
    const bool xcd_order = (G & 7) == 0;
    const int nlb = xcd_order ? (G >> 3) : 1, PW = (tilesN & 7) == 0 ? 8 : tilesN;
    const int npad = ((ntiles + G - 1) / G) * G;
    for (int tile_ = blockIdx.x; tile_ < npad * REP_GEMM; tile_ += G) {
        int tile = (REP_GEMM == 1) ? tile_ : tile_ % npad;
        if (xcd_order) {
            const int rd = tile / G, c = tile - rd * G;
            const int lin = ((rd << 3) + (c & 7)) * nlb + (c >> 3);
            tile = lin;
        }
        if (tile >= ntiles) continue;
        const int pnl = tile / (tilesM * PW), rem = tile - pnl * (tilesM * PW);
        const int tm = rem / PW, tn = pnl * PW + (rem - tm * PW);
        const bf16_t* Ag = A + (size_t)(tm * 128 + lrow) * K + lcol * 8;
        const bf16_t* Bg = Bt + (size_t)(tn * 128 + lrow) * K + lcol * 8;
        u32x4 ra0[4], rb0[4], ra1[4], rb1[4];
#define GEMM_LOAD(RA, RB, KT) { _Pragma("unroll") for (int i = 0; i < 4; ++i) { RA[i] = *(const u32x4*)(Ag + (size_t)(32 * i) * K + (KT) * 64); RB[i] = *(const u32x4*)(Bg + (size_t)(32 * i) * K + (KT) * 64); } }
#define GEMM_STORE(RA, RB, BUF) { _Pragma("unroll") for (int i = 0; i < 4; ++i) { *(u32x4*)(lds + (BUF) * TB + (lrow + 32 * i) * STR + lcol * 16) = RA[i]; *(u32x4*)(lds + 2 * TB + (BUF) * TB + (lrow + 32 * i) * STR + lcol * 16) = RB[i]; } }
#define GEMM_COMPUTE(BUF) { \
            const unsigned char* la = lds + (BUF) * TB + (wm * 64 + r) * STR + h * 16; \
            const unsigned char* lb = lds + 2 * TB + (BUF) * TB + (wn * 64 + r) * STR + h * 16; \
            _Pragma("unroll") for (int ks = 0; ks < 4; ++ks) { \
                bf16x8 af[2], bfr[2]; \
                _Pragma("unroll") for (int mi = 0; mi < 2; ++mi) af[mi] = *(const bf16x8*)(la + mi * 32 * STR + ks * 32); \
                _Pragma("unroll") for (int ni = 0; ni < 2; ++ni) bfr[ni] = *(const bf16x8*)(lb + ni * 32 * STR + ks * 32); \
                _Pragma("unroll") for (int mi = 0; mi < 2; ++mi) \
                    _Pragma("unroll") for (int ni = 0; ni < 2; ++ni) acc[mi][ni] = SW ? MFMA(af[mi], bfr[ni], acc[mi][ni]) : MFMA(bfr[ni], af[mi], acc[mi][ni]); \
            } }
        GEMM_LOAD(ra0, rb0, 0)
        if (nk > 1) GEMM_LOAD(ra1, rb1, 1)
        f32x16 acc[2][2];
#pragma unroll
        for (int mi = 0; mi < 2; ++mi)
#pragma unroll
            for (int ni = 0; ni < 2; ++ni)
#pragma unroll
                for (int i = 0; i < 16; ++i) acc[mi][ni][i] = 0.f;
        GEMM_STORE(ra0, rb0, 0)
        __syncthreads();
        for (int kt = 0; kt < nk; kt += 2) {
            __builtin_amdgcn_s_setprio(1);
            if (kt + 2 < nk) GEMM_LOAD(ra0, rb0, kt + 2)
            GEMM_COMPUTE(0)
            __builtin_amdgcn_s_setprio(0);
            if (kt + 1 < nk) GEMM_STORE(ra1, rb1, 1)
            __syncthreads();
            if (kt + 1 < nk) {
                __builtin_amdgcn_s_setprio(1);
                if (kt + 3 < nk) GEMM_LOAD(ra1, rb1, kt + 3)
                GEMM_COMPUTE(1)
                __builtin_amdgcn_s_setprio(0);
                if (kt + 2 < nk) GEMM_STORE(ra0, rb0, 0)
                __syncthreads();
            }
        }
#undef GEMM_LOAD
#undef GEMM_STORE
#undef GEMM_COMPUTE
        epi(acc, tm * 128 + wm * 64, tn * 128 + wn * 64, r, h);
    }
}

struct EpiQKV {
    bf16_t* q; bf16_t* k; bf16_t* vt; const f32x2* rope; const float* bias; int nq, nk, dv_shift, hv;
    DI void operator()(const f32x16 (&acc)[2][2], int m0, int n0, int r, int h) const {
        if (n0 < nq + nk) {
            const bool isq = n0 < nq;
            bf16_t* dst = isq ? q + n0 : k + (n0 - nq);
            const int ld = isq ? nq : nk;
            const float qs = isq ? 0.125f * LOG2E : 1.0f;
#pragma unroll
            for (int mi = 0; mi < 2; ++mi) {
                const int m = m0 + mi * 32 + r, pos = m & (SEQ - 1);
                const f32x4* rp = (const f32x4*)(rope + pos * 32);
                u32x2 A1[4], A2[4];
#pragma unroll
                for (int g = 0; g < 4; ++g) {
                    const int j0 = 8 * g + 4 * h;
                    const f32x4 cs01 = rp[j0 >> 1], cs23 = rp[(j0 >> 1) + 1];
                    f32x4 b1 = {0.f, 0.f, 0.f, 0.f}, b2 = {0.f, 0.f, 0.f, 0.f};
                    if (bias) { b1 = *(const f32x4*)(bias + n0 + j0); b2 = *(const f32x4*)(bias + n0 + 32 + j0); }
                    const float c[4] = {cs01.x, cs01.z, cs23.x, cs23.z}, s[4] = {cs01.y, cs01.w, cs23.y, cs23.w};
                    float o1[4], o2[4];
#pragma unroll
                    for (int e = 0; e < 4; ++e) {
                        const float t1 = acc[mi][0][4 * g + e] + b1[e], t2 = acc[mi][1][4 * g + e] + b2[e];
                        o1[e] = (t1 * c[e] - t2 * s[e]) * qs; o2[e] = (t2 * c[e] + t1 * s[e]) * qs;
                    }
                    A1[g].x = pk_bf16(o1[0], o1[1]); A1[g].y = pk_bf16(o1[2], o1[3]); A2[g].x = pk_bf16(o2[0], o2[1]); A2[g].y = pk_bf16(o2[2], o2[3]);
                }
                store_row32_bf16(dst + (size_t)m * ld, A1, h);
                store_row32_bf16(dst + (size_t)m * ld + 32, A2, h);
            }
        }
    }
};
struct EpiVt {
    bf16_t* vt; const float* bias; int dv_shift, hv;
    DI void operator()(const f32x16 (&acc)[2][2], int m0, int n0, int r, int h) const {
        const int b = m0 >> 13, s0 = m0 & (SEQ - 1);
#pragma unroll
        for (int ni = 0; ni < 2; ++ni) {
            const int eg = n0 + ni * 32 + r;
            const float bv = bias ? bias[eg] : 0.f;
            const int hh = eg >> dv_shift, e = eg & ((1 << dv_shift) - 1);
            bf16_t* rowp = vt + ((size_t)((b * hv + hh) << dv_shift) + e) * SEQ + s0;
#pragma unroll
            for (int mi = 0; mi < 2; ++mi) {
                u32x2 A[4];
#pragma unroll
                for (int g = 0; g < 4; ++g) { A[g].x = pk_bf16(acc[mi][ni][4 * g] + bv, acc[mi][ni][4 * g + 1] + bv); A[g].y = pk_bf16(acc[mi][ni][4 * g + 2] + bv, acc[mi][ni][4 * g + 3] + bv); }
                store_row32_bf16(rowp + mi * 32, A, h);
            }
        }
    }
};
template <bool RES_F32> struct EpiRes {
    const void* res; const float* bias; bf16_t* y;
    DI void operator()(const f32x16 (&acc)[2][2], int m0, int n0, int r, int h) const {
#pragma unroll
        for (int mi = 0; mi < 2; ++mi) {
            const int m = m0 + mi * 32 + r;
#pragma unroll
            for (int ni = 0; ni < 2; ++ni) {
                u32x2 A[4];
#pragma unroll
                for (int g = 0; g < 4; ++g) {
                    const int n = n0 + ni * 32 + 8 * g + 4 * h;
                    f32x4 xr;
                    if (RES_F32) xr = *(const f32x4*)((const float*)res + (size_t)m * DM + n);
                    else { const u32x2 u = *(const u32x2*)((const bf16_t*)res + (size_t)m * DM + n); xr.x = bf_lo(u.x); xr.y = bf_hi(u.x); xr.z = bf_lo(u.y); xr.w = bf_hi(u.y); }
                    f32x4 bv = {0.f, 0.f, 0.f, 0.f};
                    if (bias) bv = *(const f32x4*)(bias + n);
                    f32x4 o;
#pragma unroll
                    for (int e = 0; e < 4; ++e) o[e] = DN_ALPHA * xr[e] + acc[mi][ni][4 * g + e] + bv[e];
                    A[g].x = pk_bf16(o[0], o[1]); A[g].y = pk_bf16(o[2], o[3]);
                }
                store_row32_bf16(y + (size_t)m * DM + n0 + ni * 32, A, h);
            }
        }
    }
};
struct EpiBf16 {
    bf16_t* o;
    DI void operator()(const f32x16 (&acc)[2][2], int m0, int n0, int r, int h) const {
#pragma unroll
        for (int mi = 0; mi < 2; ++mi) {
            const int m = m0 + mi * 32 + r;
#pragma unroll
            for (int ni = 0; ni < 2; ++ni) {
                u32x2 A[4];
#pragma unroll
                for (int g = 0; g < 4; ++g) { A[g].x = pk_bf16(acc[mi][ni][4 * g], acc[mi][ni][4 * g + 1]); A[g].y = pk_bf16(acc[mi][ni][4 * g + 2], acc[mi][ni][4 * g + 3]); }
                store_row32_bf16(o + (size_t)m * DM + n0 + ni * 32, A, h);
            }
        }
    }
};

DI void ln_phase(const bf16_t* __restrict__ y, const float* __restrict__ g, const float* __restrict__ b, bf16_t* __restrict__ xo, float* __restrict__ xf = nullptr) {
    const int lane = threadIdx.x & 63, w = threadIdx.x >> 6;
    const int gw = blockIdx.x * 4 + w, nw = gridDim.x * 4;
    f32x4 gv[4], bv[4];
#pragma unroll
    for (int i = 0; i < 4; ++i) { gv[i] = ((const f32x4*)g)[lane + 64 * i]; bv[i] = ((const f32x4*)b)[lane + 64 * i]; }
    for (int row = gw; row < T_TOK; row += nw) {
        const u32x2* yr = (const u32x2*)(y + (size_t)row * DM);
        f32x4 v[4];
#pragma unroll
        for (int i = 0; i < 4; ++i) { const u32x2 u = yr[lane + 64 * i]; v[i].x = bf_lo(u.x); v[i].y = bf_hi(u.x); v[i].z = bf_lo(u.y); v[i].w = bf_hi(u.y); }
        float s = 0.f;
#pragma unroll
        for (int i = 0; i < 4; ++i) s += (v[i].x + v[i].y) + (v[i].z + v[i].w);
        const float mu = wave_sum(s) * (1.0f / DM);
        float q = 0.f;
#pragma unroll
        for (int i = 0; i < 4; ++i) { const f32x4 d = v[i] - mu; q += (d.x * d.x + d.y * d.y) + (d.z * d.z + d.w * d.w); }
        const float rstd = rsqrtf(wave_sum(q) * (1.0f / DM) + LN_EPS);
#pragma unroll
        for (int i = 0; i < 4; ++i) {
            const f32x4 o = (v[i] - mu) * rstd * gv[i] + bv[i];
            if (xf) *(f32x4*)(xf + (size_t)row * DM + 4 * (lane + 64 * i)) = o;
            if (xo) { u32x2 wv = {pk_bf16(o.x, o.y), pk_bf16(o.z, o.w)}; *(u32x2*)(xo + (size_t)row * DM + 4 * (lane + 64 * i)) = wv; }
        }
    }
}

struct AttnArgs {
    const bf16_t* q; const bf16_t* k; const bf16_t* vt; bf16_t* o;
    const float* lam_params; const float* subln_g; const float* sinks; float* scr;
};
DI int pi_perm(int r) { return (r & 0x13) | ((r & 4) << 1) | ((r & 8) >> 1); }

template <int MODE>
DI void attn_phase(const AttnArgs& a, unsigned char* lds) {
    constexpr int DV = MODE == 0 ? 128 : 64, EB = DV / 32;
    constexpr int KSTR = 144, VSTR = 144, KBUF = 64 * KSTR, VBUF = DV * VSTR;
    constexpr int KCH = 2, VCH = DV / 32;
    constexpr int LDK = MODE == 0 ? 1024 : 128, HV = MODE == 0 ? 8 : 2;
    constexpr int NITEMS = 8192;
    const int tid = threadIdx.x, lane = tid & 63, w = tid >> 6, r = lane & 31, h = lane >> 5;
    unsigned char* kl = lds;
    unsigned char* vl = lds + 3 * KBUF;
    const float NEG_INF = -__builtin_inff();
    const int G = gridDim.x;
    const int krow = tid >> 3, kcc = tid & 7;

    constexpr int REPA = MODE == 0 ? REP_ATT0 : REP_ATT1;
    for (int it_ = blockIdx.x; it_ < NITEMS * REPA; it_ += G) {
        const int it = (REPA == 1) ? it_ : it_ % NITEMS;
        int b, qb, qcol0, kcol0, vh, p = 0;
        if (MODE == 0) {
            int bh;
            const int s = it / G, c = it - s * G;
            if (G == 512) { const int jj = c >> 3; bh = (c & 7) + 8 * (s >> 1); p = jj & 1; qb = (s & 1) ? (jj >> 1) : 63 - (jj >> 1); }
            else if (G == 256) { const int jj = c >> 3; bh = (c & 7) + 8 * (s >> 2); p = s & 1; qb = (s & 2) ? jj : 63 - jj; }
            else { bh = it >> 7; p = it & 1; qb = 63 - ((it >> 1) & 63); }
            b = bh >> 3; const int hh = bh & 7; qcol0 = hh * 128; kcol0 = hh * 128; vh = hh;
        } else {
            const int head = it & 15; qb = (it >> 4) & 63; b = it >> 10;
            qcol0 = head * 64; vh = head >> 3; kcol0 = vh * 64;
        }
        const int q0 = qb * 128, qw0 = q0 + 32 * w, qpos = qw0 + r;
        const int kt0 = MODE == 0 ? 0 : ((q0 >= 128 ? q0 - 128 : 0) >> 6), kt1 = (q0 + 128) >> 6;
        const bf16_t* vg = a.vt + (size_t)(b * HV + vh) * DV * SEQ + (size_t)krow * SEQ + kcc * 8;
        const size_t tok = (size_t)b * SEQ + qpos;

        {
            const bf16_t* kg = a.k + (size_t)b * SEQ * LDK + kcol0 + p * 64 + (size_t)krow * LDK + kcc * 8;
            bf16x8 qf[4];
            {
                const bf16_t* qp = a.q + tok * 1024 + qcol0 + p * 64 + h * 8;
#pragma unroll
                for (int ks = 0; ks < 4; ++ks) qf[ks] = *(const bf16x8*)(qp + ks * 16);
            }
            f32x16 O[EB];
#pragma unroll
            for (int eb = 0; eb < EB; ++eb)
#pragma unroll
                for (int i = 0; i < 16; ++i) O[eb][i] = 0.f;
            float mrow = NEG_INF, lsum = 0.f;
            if (MODE == 1) { mrow = a.sinks[it & 15] * LOG2E; lsum = (h == 0) ? 1.0f : 0.0f; }

            u32x4 rk[KCH], rv[VCH];
#define ATT_LOADK(KT) { _Pragma("unroll") for (int i = 0; i < KCH; ++i) rk[i] = *(const u32x4*)(kg + (size_t)((KT) * 64 + 32 * i) * LDK); }
#define ATT_LOADV(KT) { _Pragma("unroll") for (int i = 0; i < VCH; ++i) rv[i] = *(const u32x4*)(vg + (size_t)(32 * i) * SEQ + (KT) * 64); }
#define ATT_STOREK(KT) { unsigned char* kd_ = kl + (((KT) - kt0) % 3) * KBUF; _Pragma("unroll") for (int i = 0; i < KCH; ++i) *(u32x4*)(kd_ + (krow + 32 * i) * KSTR + kcc * 16) = rk[i]; }
#define ATT_STOREV(KT) { unsigned char* vd_ = vl + (((KT) - kt0) & 1) * VBUF; _Pragma("unroll") for (int i = 0; i < VCH; ++i) *(u32x4*)(vd_ + (krow + 32 * i) * VSTR + kcc * 16) = rv[i]; }
            auto s_compute = [&](f32x16 (&sx)[2], const int kt) __attribute__((always_inline)) {
                const unsigned char* kb_ = kl + ((kt - kt0) % 3) * KBUF;
#pragma unroll
                for (int kb = 0; kb < 2; ++kb) {
#pragma unroll
                    for (int i = 0; i < 16; ++i) sx[kb][i] = 0.f;
#pragma unroll
                    for (int ks = 0; ks < 4; ++ks) {
                        const bf16x8 kf = *(const bf16x8*)(kb_ + (kb * 32 + pi_perm(r)) * KSTR + ks * 32 + h * 16);
                        sx[kb] = MFMA(kf, qf[ks], sx[kb]);
                    }
                }
            };
            auto step = [&](f32x16 (&s)[2], f32x16 (&sn)[2], const int kt) __attribute__((always_inline)) {
                const bool more1 = kt + 1 < kt1, more2 = kt + 2 < kt1;
                if (more2) ATT_LOADK(kt + 2)
                if (more1) ATT_LOADV(kt + 1)
                const int key0 = kt * 64;
                bool need_mask = key0 + 63 > qw0;
                if (MODE == 1) need_mask = need_mask || (key0 < qw0 + 31 - 127);
                if (need_mask) {
                    asm volatile("" ::: "memory");
#pragma unroll
                    for (int kb = 0; kb < 2; ++kb)
#pragma unroll
                        for (int i = 0; i < 16; ++i) {
                            const int key = key0 + kb * 32 + 16 * (i >> 3) + 8 * h + (i & 7);
                            bool valid = key <= qpos;
                            if (MODE == 1) valid = valid && (key > qpos - 128);
                            s[kb][i] = valid ? s[kb][i] : NEG_INF;
                        }
                }
                float mx = NEG_INF;
#pragma unroll
                for (int kb = 0; kb < 2; ++kb)
#pragma unroll
                    for (int i = 0; i < 16; ++i) mx = fmaxf(mx, s[kb][i]);
                mx = fmaxf(mx, __shfl_xor(mx, 32));
                if (__builtin_amdgcn_ballot_w64(mx > mrow + 8.0f) != 0ull) {
                    asm volatile("" ::: "memory");
                    const float mnew = fmaxf(mrow, mx);
                    const float alpha = __builtin_amdgcn_exp2f(mrow - mnew);
                    mrow = mnew;
                    lsum *= alpha;
#pragma unroll
                    for (int eb = 0; eb < EB; ++eb)
#pragma unroll
                        for (int i = 0; i < 16; ++i) O[eb][i] *= alpha;
                }
                __builtin_amdgcn_s_setprio(1);
                s_compute(sn, kt + 1);
                f32x2 ps2 = {0.f, 0.f};
#pragma unroll
                for (int kb = 0; kb < 2; ++kb)
#pragma unroll
                    for (int i = 0; i < 16; i += 2) {
                        f32x2 pv = {__builtin_amdgcn_exp2f(s[kb][i] - mrow), __builtin_amdgcn_exp2f(s[kb][i + 1] - mrow)};
                        s[kb][i] = pv.x; s[kb][i + 1] = pv.y; ps2 += pv;
                    }
                lsum += ps2.x + ps2.y;
                bf16x8 pf[2][2];
#pragma unroll
                for (int kb = 0; kb < 2; ++kb)
#pragma unroll
                    for (int s2 = 0; s2 < 2; ++s2) {
                        u32x4 u;
                        u.x = pk_bf16(s[kb][8 * s2 + 0], s[kb][8 * s2 + 1]); u.y = pk_bf16(s[kb][8 * s2 + 2], s[kb][8 * s2 + 3]);
                        u.z = pk_bf16(s[kb][8 * s2 + 4], s[kb][8 * s2 + 5]); u.w = pk_bf16(s[kb][8 * s2 + 6], s[kb][8 * s2 + 7]);
                        pf[kb][s2] = __builtin_bit_cast(bf16x8, u);
                    }
                const unsigned char* vb_ = vl + ((kt - kt0) & 1) * VBUF;
#pragma unroll
                for (int eb = 0; eb < EB; ++eb) {
#pragma unroll
                    for (int kb = 0; kb < 2; ++kb)
#pragma unroll
                        for (int s2 = 0; s2 < 2; ++s2) {
                            const bf16x8 vf = *(const bf16x8*)(vb_ + (eb * 32 + r) * VSTR + (kb * 32 + 16 * s2 + 8 * h) * 2);
                            O[eb] = MFMA(vf, pf[kb][s2], O[eb]);
                        }
                }
                __builtin_amdgcn_s_setprio(0);
                if (more2) ATT_STOREK(kt + 2)
                if (more1) ATT_STOREV(kt + 1)
                __syncthreads();
            };
            ATT_LOADK(kt0) ATT_LOADV(kt0)
            ATT_STOREK(kt0) ATT_STOREV(kt0)
            if (kt0 + 1 < kt1) { ATT_LOADK(kt0 + 1) ATT_STOREK(kt0 + 1) }
            __syncthreads();
            f32x16 sA[2], sB[2];
            s_compute(sA, kt0);
            for (int kt = kt0; kt < kt1; kt += 2) {
                step(sA, sB, kt);
                if (kt + 1 < kt1) step(sB, sA, kt + 1);
            }
#undef ATT_LOADK
#undef ATT_LOADV
#undef ATT_STOREK
#undef ATT_STOREV
            const float inv0 = 1.0f / (lsum + __shfl_xor(lsum, 32));
            bf16_t* op = (MODE == 0) ? a.o + tok * 2048 + qcol0 * 2 + p * 128 : a.o + tok * 1024 + qcol0;
#pragma unroll
            for (int eb = 0; eb < EB; ++eb) {
                u32x2 A[4];
#pragma unroll
                for (int g = 0; g < 4; ++g) { A[g].x = pk_bf16(O[eb][4 * g] * inv0, O[eb][4 * g + 1] * inv0); A[g].y = pk_bf16(O[eb][4 * g + 2] * inv0, O[eb][4 * g + 3] * inv0); }
                store_row32_bf16(op + eb * 32, A, h);
            }
        }
    }
}

DI void diff_combine_phase(const bf16_t* __restrict__ op, const float* __restrict__ lam_params, const float* __restrict__ subln_g, bf16_t* __restrict__ o) {
    const int lane = threadIdx.x & 63, w = threadIdx.x >> 6;
    const int gwave = blockIdx.x * 4 + w, nwave = gridDim.x * 4;
    const float p1 = wave_sum(lam_params[lane] * lam_params[64 + lane]);
    const float p2 = wave_sum(lam_params[128 + lane] * lam_params[192 + lane]);
    const float lam = __expf(p1) - __expf(p2) + LAMBDA_INIT0;
    const int hd = lane >> 3, d0 = 16 * (lane & 7);
    f32x4 gg[4];
#pragma unroll
    for (int i = 0; i < 4; ++i) gg[i] = *(const f32x4*)(subln_g + d0 + 4 * i);
    for (int t = gwave; t < T_TOK; t += nwave) {
        const bf16_t* p0 = op + (size_t)t * 2048 + hd * 256 + d0;
        const u32x4 a0 = *(const u32x4*)p0, a1 = *(const u32x4*)(p0 + 8), b0 = *(const u32x4*)(p0 + 128), b1 = *(const u32x4*)(p0 + 136);
        float v[16];
#pragma unroll
        for (int i = 0; i < 4; ++i) {
            v[2 * i] = bf_lo(a0[i]) - lam * bf_lo(b0[i]); v[2 * i + 1] = bf_hi(a0[i]) - lam * bf_hi(b0[i]);
            v[8 + 2 * i] = bf_lo(a1[i]) - lam * bf_lo(b1[i]); v[8 + 2 * i + 1] = bf_hi(a1[i]) - lam * bf_hi(b1[i]);
        }
        float ss = 0.f;
#pragma unroll
        for (int i = 0; i < 16; ++i) ss += v[i] * v[i];
        ss += __shfl_xor(ss, 1); ss += __shfl_xor(ss, 2); ss += __shfl_xor(ss, 4);
        const float rs = rsqrtf(ss * (1.0f / 128.0f) + LN_EPS) * (1.0f - LAMBDA_INIT0);
        u32x4 w0, w1;
#pragma unroll
        for (int i = 0; i < 4; ++i) {
            const int e = (i & 1) * 2;
            w0[i] = pk_bf16(v[2 * i] * rs * gg[i >> 1][e], v[2 * i + 1] * rs * gg[i >> 1][e + 1]);
            w1[i] = pk_bf16(v[8 + 2 * i] * rs * gg[2 + (i >> 1)][e], v[8 + 2 * i + 1] * rs * gg[2 + (i >> 1)][e + 1]);
        }
        bf16_t* dst = o + (size_t)t * 1024 + hd * 128 + d0;
        *(u32x4*)dst = w0; *(u32x4*)(dst + 8) = w1;
    }
}

DI unsigned f2ord(float f) { const unsigned u = __float_as_uint(f); return (u & 0x80000000u) ? ~u : (u | 0x80000000u); }
DI float ord2f(unsigned o) { const unsigned u = (o & 0x80000000u) ? (o & 0x7fffffffu) : ~o; return __uint_as_float(u); }
__host__ __device__ constexpr int combo_row_start(int a) { int s = 0; for (int i = 0; i < a; ++i) s += 16 / (i + 1); return s; }

constexpr int SORT16[63][2] = {{0,1}, {2,3}, {0,2}, {1,3}, {1,2}, {4,5}, {6,7}, {4,6}, {5,7}, {5,6}, {0,4}, {2,6}, {2,4}, {1,5}, {3,7}, {3,5}, {1,2}, {3,4}, {5,6}, {8,9}, {10,11}, {8,10}, {9,11}, {9,10}, {12,13}, {14,15}, {12,14}, {13,15}, {13,14}, {8,12}, {10,14}, {10,12}, {9,13}, {11,15}, {11,13}, {9,10}, {11,12}, {13,14}, {0,8}, {4,12}, {4,8}, {2,10}, {6,14}, {6,10}, {2,4}, {6,8}, {10,12}, {1,9}, {5,13}, {5,9}, {3,11}, {7,15}, {7,11}, {3,5}, {7,9}, {11,13}, {1,2}, {3,4}, {5,6}, {7,8}, {9,10}, {11,12}, {13,14}};
constexpr int BMERGE16[32][2] = {{0,8}, {1,9}, {2,10}, {3,11}, {4,12}, {5,13}, {6,14}, {7,15}, {0,4}, {1,5}, {2,6}, {3,7}, {8,12}, {9,13}, {10,14}, {11,15}, {0,2}, {1,3}, {4,6}, {5,7}, {8,10}, {9,11}, {12,14}, {13,15}, {0,1}, {2,3}, {4,5}, {6,7}, {8,9}, {10,11}, {12,13}, {14,15}};
DI void cex(unsigned& a, unsigned& b) { const unsigned hi = max(a, b), lo = min(a, b); a = hi; b = lo; }
DI void merge_top16(unsigned (&A)[16], const unsigned (&B)[16]) {
#pragma unroll
    for (int i = 0; i < 16; ++i) A[i] = max(A[i], B[15 - i]);
#pragma unroll
    for (int n = 0; n < 32; ++n) cex(A[BMERGE16[n][0]], A[BMERGE16[n][1]]);
}
DI void peer_topk_phase(const bf16_t* __restrict__ qpk, const bf16_t* __restrict__ subk, int* __restrict__ eidx, float* __restrict__ gout) {
    int tidv = threadIdx.x;
    asm volatile("" : "+v"(tidv));
    const int lane = tidv & 63, w = tidv >> 6, r = lane & 31, h = lane >> 5;
    const int gwave = blockIdx.x * 4 + w, nwave = gridDim.x * 4;
    for (int item_ = gwave; item_ < 2048 * 8 * REP_TOPK; item_ += nwave) {
        const int item = (REP_TOPK == 1) ? item_ : item_ % (2048 * 8);
        const int tt = item >> 3, hh = item & 7, t0 = tt * 32;
        unsigned top[2][16];
#pragma unroll
        for (int c = 0; c < 2; ++c) {
            f32x16 acc[4];
#pragma unroll
            for (int nb = 0; nb < 4; ++nb)
#pragma unroll
                for (int i = 0; i < 16; ++i) acc[nb][i] = 0.f;
            const bf16_t* qp = qpk + (size_t)(t0 + r) * 1024 + hh * 128 + c * 64 + h * 8;
            const bf16_t* kp = subk + ((size_t)(hh * 2 + c) * 128 + r) * 64 + h * 8;
#pragma unroll
            for (int ks = 0; ks < 4; ++ks) {
                const bf16x8 qfr = *(const bf16x8*)(qp + ks * 16);
#pragma unroll
                for (int nb = 0; nb < 4; ++nb) {
                    const bf16x8 kf = *(const bf16x8*)(kp + nb * 32 * 64 + ks * 16);
                    acc[nb] = MFMA(kf, qfr, acc[nb]);
                }
            }
            unsigned key[64];
#pragma unroll
            for (int nb = 0; nb < 4; ++nb)
#pragma unroll
                for (int i = 0; i < 16; ++i) {
                    const int n = nb * 32 + (i & 3) + 8 * (i >> 2) + 4 * h;
                    key[nb * 16 + i] = (f2ord(acc[nb][i]) & ~127u) | (unsigned)(127 - n);
                }
            unsigned g0[16], g1[16], g2[16], g3[16];
#pragma unroll
            for (int i = 0; i < 16; ++i) { g0[i] = key[i]; g1[i] = key[16 + i]; g2[i] = key[32 + i]; g3[i] = key[48 + i]; }
#pragma unroll
            for (int n = 0; n < 63; ++n) { cex(g0[SORT16[n][0]], g0[SORT16[n][1]]); cex(g1[SORT16[n][0]], g1[SORT16[n][1]]); cex(g2[SORT16[n][0]], g2[SORT16[n][1]]); cex(g3[SORT16[n][0]], g3[SORT16[n][1]]); }
            merge_top16(g0, g1); merge_top16(g2, g3); merge_top16(g0, g2);
            unsigned pb[16];
#pragma unroll
            for (int i = 0; i < 16; ++i) pb[i] = (unsigned)__shfl_xor((int)g0[i], 32);
            merge_top16(g0, pb);
#pragma unroll
            for (int i = 0; i < 16; ++i) top[c][i] = g0[i];
        }
        unsigned ck[50];
#pragma unroll
        for (int a = 0; a < 16; ++a)
#pragma unroll
            for (int b = 0; b < 16 / (a + 1); ++b) {
                const float cv = ord2f(top[0][a] & ~127u) + ord2f(top[1][b] & ~127u);
                ck[combo_row_start(a) + b] = (f2ord(cv) & ~255u) | (unsigned)(((15 - a) << 4) | (15 - b));
            }
        unsigned c0[16], c1[16], c2[16], c3[16];
#pragma unroll
        for (int i = 0; i < 16; ++i) { c0[i] = ck[i]; c1[i] = ck[16 + i]; c2[i] = ck[32 + i]; c3[i] = (i < 2) ? ck[48 + i] : 0u; }
#pragma unroll
        for (int n = 0; n < 63; ++n) { cex(c1[SORT16[n][0]], c1[SORT16[n][1]]); cex(c2[SORT16[n][0]], c2[SORT16[n][1]]); }
        merge_top16(c0, c1); merge_top16(c2, c3); merge_top16(c0, c2);
        float sv[16]; int se[16];
#pragma unroll
        for (int rd = 0; rd < 16; ++rd) {
            const unsigned m = c0[rd];
            const int asel = 15 - (int)((m >> 4) & 15u), bsel = 15 - (int)(m & 15u);
            unsigned ka = top[0][0], kb = top[1][0];
#pragma unroll
            for (int i = 1; i < 16; ++i) { ka = (asel == i) ? top[0][i] : ka; kb = (bsel == i) ? top[1][i] : kb; }
            sv[rd] = ord2f(ka & ~127u) + ord2f(kb & ~127u);
            se[rd] = (127 - (int)(ka & 127u)) * 128 + (127 - (int)(kb & 127u));
        }
        float den = 0.f;
        const float mx0 = sv[0];
#pragma unroll
        for (int i = 0; i < 16; ++i) { sv[i] = __expf(sv[i] - mx0); den += sv[i]; }
        const float inv = 1.0f / den;
        const size_t ob = (size_t)(t0 + r) * 128 + hh * 16;
        if (h == 0) {
#pragma unroll
            for (int i = 0; i < 4; ++i) { int4 v = make_int4(se[4 * i], se[4 * i + 1], se[4 * i + 2], se[4 * i + 3]); *(int4*)(eidx + ob + 4 * i) = v; }
        } else {
#pragma unroll
            for (int i = 0; i < 4; ++i) { f32x4 v = {sv[4 * i] * inv, sv[4 * i + 1] * inv, sv[4 * i + 2] * inv, sv[4 * i + 3] * inv}; *(f32x4*)(gout + ob + 4 * i) = v; }
        }
    }
}

DI float gelu_exact(float v) { return 0.5f * v * (1.0f + erff(v * 0.70710678118654752f)); }
DI void convert_rows_fp8(const float* __restrict__ src, unsigned char* __restrict__ dst, float* __restrict__ inv, int nrows) {
    const int lane = threadIdx.x & 63, w = threadIdx.x >> 6;
    const int gwave = blockIdx.x * 4 + w, nwave = gridDim.x * 4;
    for (int row_ = gwave; row_ < nrows * REP_P0; row_ += nwave) {
        const int row = (REP_P0 == 1) ? row_ : row_ % nrows;
        const f32x4* p = (const f32x4*)(src + (size_t)row * DM + 16 * lane);
        f32x4 v[4];
#pragma unroll
        for (int i = 0; i < 4; ++i) v[i] = p[i];
        float am = 0.f;
#pragma unroll
        for (int i = 0; i < 4; ++i) am = fmaxf(am, fmaxf(fmaxf(fabsf(v[i].x), fabsf(v[i].y)), fmaxf(fabsf(v[i].z), fabsf(v[i].w))));
#pragma unroll
        for (int o = 32; o >= 1; o >>= 1) am = fmaxf(am, __shfl_xor(am, o));
        const unsigned eb = (__float_as_uint(am) >> 23) & 0xffu;
        float sc = 1.0f, isc = 1.0f;
        if (eb >= 16u && eb <= 250u) { sc = __uint_as_float((261u - eb) << 23); isc = __uint_as_float((eb - 7u) << 23); }
        u32x4 o;
#pragma unroll
        for (int i = 0; i < 4; ++i) {
            int pk = __builtin_amdgcn_cvt_pk_fp8_f32(v[i].x * sc, v[i].y * sc, 0, false);
            pk = __builtin_amdgcn_cvt_pk_fp8_f32(v[i].z * sc, v[i].w * sc, pk, true);
            o[i] = (unsigned)pk;
        }
        *(u32x4*)(dst + (size_t)row * DM + 16 * lane) = o;
        if (lane == 0) inv[row] = isc;
    }
}
DI float dot16(const unsigned (&a)[8], u32x4 b0, u32x4 b1) {
    float acc;
    asm volatile("v_dot2_f32_bf16 %0, %1, %9, 0\n\tv_dot2_f32_bf16 %0, %2, %10, %0\n\tv_dot2_f32_bf16 %0, %3, %11, %0\n\tv_dot2_f32_bf16 %0, %4, %12, %0\n\t"
                 "v_dot2_f32_bf16 %0, %5, %13, %0\n\tv_dot2_f32_bf16 %0, %6, %14, %0\n\tv_dot2_f32_bf16 %0, %7, %15, %0\n\tv_dot2_f32_bf16 %0, %8, %16, %0\n\ts_nop 2"
                 : "=&v"(acc)
                 : "v"(a[0]), "v"(a[1]), "v"(a[2]), "v"(a[3]), "v"(a[4]), "v"(a[5]), "v"(a[6]), "v"(a[7]),
                   "v"(b0.x), "v"(b0.y), "v"(b0.z), "v"(b0.w), "v"(b1.x), "v"(b1.y), "v"(b1.z), "v"(b1.w));
    return acc;
}
DI float dot_fp8_row(u32x4 u, u32x4 xa, u32x4 xb) {
    unsigned a[8];
#pragma unroll
    for (int j = 0; j < 4; ++j) {
        a[2 * j] = __builtin_bit_cast(unsigned, __builtin_amdgcn_cvt_scalef32_pk_bf16_fp8(u[j], 1.0f, false));
        a[2 * j + 1] = __builtin_bit_cast(unsigned, __builtin_amdgcn_cvt_scalef32_pk_bf16_fp8(u[j], 1.0f, true));
    }
    return dot16(a, xa, xb);
}
DI void axpy_fp8_row(f32x2 (&o)[8], float wgt, u32x4 v) {
    const f32x2 w2 = {wgt, wgt};
#pragma unroll
    for (int j = 0; j < 4; ++j) {
        const f32x2 lo = __builtin_amdgcn_cvt_pk_f32_fp8(v[j], false), hi = __builtin_amdgcn_cvt_pk_f32_fp8(v[j], true);
        o[2 * j] = __builtin_elementwise_fma(w2, lo, o[2 * j]);
        o[2 * j + 1] = __builtin_elementwise_fma(w2, hi, o[2 * j + 1]);
    }
}
struct TokMeta { int e0, e1; float su0, su1, gv0, gv1; u32x4 xa, xb; };
DI TokMeta load_meta(int t, int lane, const bf16_t* __restrict__ x1, const int* __restrict__ eidx, const float* __restrict__ gws, const float* __restrict__ su, const float* __restrict__ sv) {
    TokMeta m;
    m.e0 = eidx[(size_t)t * 128 + lane]; m.e1 = eidx[(size_t)t * 128 + 64 + lane];
    const float g0 = gws[(size_t)t * 128 + lane], g1 = gws[(size_t)t * 128 + 64 + lane];
    m.su0 = su[m.e0]; m.su1 = su[m.e1];
    m.gv0 = g0 * sv[m.e0]; m.gv1 = g1 * sv[m.e1];
    m.xa = *(const u32x4*)(x1 + (size_t)t * DM + 16 * lane); m.xb = *(const u32x4*)(x1 + (size_t)t * DM + 16 * lane + 8);
    return m;
}
DI void gather_issue(u32x4 (&bu)[8], u32x4 (&bv)[8], int ev, int lbase, int lane, const unsigned char* __restrict__ U8, const unsigned char* __restrict__ V8) {
#pragma unroll
    for (int i = 0; i < 8; ++i) {
        const int e = __builtin_amdgcn_readlane(ev, lbase + i);
        bu[i] = *(const u32x4*)(U8 + (size_t)e * DM + 16 * lane);
        bv[i] = *(const u32x4*)(V8 + (size_t)e * DM + 16 * lane);
    }
}
DI void gather_compute(const u32x4 (&bu)[8], const u32x4 (&bv)[8], float suv, float gvv, int lbase, int lane_in, u32x4 xa, u32x4 xb, f32x2 (&out)[8]) {
    int lane = lane_in;
    float d[8];
#pragma unroll
    for (int i = 0; i < 8; ++i) { d[i] = dot_fp8_row(bu[i], xa, xb) * __builtin_bit_cast(float, __builtin_amdgcn_readlane(__builtin_bit_cast(int, suv), lbase + i)); __builtin_amdgcn_sched_barrier(0); }
    float d4[4], d2[2], d1;
    asm volatile("" : "+v"(lane));
    {
        const bool hi = (lane & 32) != 0;
#pragma unroll
        for (int i = 0; i < 4; ++i) { const float keep = hi ? d[i + 4] : d[i], send = hi ? d[i] : d[i + 4]; d4[i] = keep + __shfl_xor(send, 32); }
    }
    {
        const bool hi = (lane & 16) != 0;
#pragma unroll
        for (int i = 0; i < 2; ++i) { const float keep = hi ? d4[i + 2] : d4[i], send = hi ? d4[i] : d4[i + 2]; d2[i] = keep + __shfl_xor(send, 16); }
    }
    {
        const bool hi = (lane & 8) != 0;
        const float keep = hi ? d2[1] : d2[0], send = hi ? d2[0] : d2[1];
        d1 = keep + __shfl_xor(send, 8);
    }
    d1 += __shfl_xor(d1, 4); d1 += __shfl_xor(d1, 2); d1 += __shfl_xor(d1, 1);
    const float hv = gelu_exact(d1);
#pragma unroll
    for (int i = 0; i < 8; ++i) {
        const int src = 8 * (i & 1) + 16 * ((i >> 1) & 1) + 32 * ((i >> 2) & 1);
        const float wi = __builtin_bit_cast(float, __builtin_amdgcn_readlane(__builtin_bit_cast(int, gvv), lbase + i)) *
                         __builtin_bit_cast(float, __builtin_amdgcn_readlane(__builtin_bit_cast(int, hv), src));
        axpy_fp8_row(out, wi, bv[i]);
        __builtin_amdgcn_sched_barrier(0);
    }
}
DI void peer_gather_phase(const bf16_t* __restrict__ x1, const int* __restrict__ eidx, const float* __restrict__ gws, const unsigned char* __restrict__ U8,
                          const unsigned char* __restrict__ V8, const float* __restrict__ su, const float* __restrict__ sv, const float* __restrict__ lng,
                          const float* __restrict__ lnb, bf16_t* __restrict__ xo_bf, float* __restrict__ xo_f32) {
    const int lane = threadIdx.x & 63, w = threadIdx.x >> 6;
    const int gwave = blockIdx.x * 4 + w, nwave = gridDim.x * 4;
    if (gwave < T_TOK) {
        TokMeta cur = load_meta(gwave, lane, x1, eidx, gws, su, sv);
        u32x4 au[8], av[8], bu[8], bv[8];
        gather_issue(au, av, cur.e0, 0, lane, U8, V8);
        for (int t_ = gwave; t_ < T_TOK * REP_GATHER; t_ += nwave) {
            const int t = (REP_GATHER == 1) ? t_ : t_ % T_TOK;
            const bool has_next = t_ + nwave < T_TOK * REP_GATHER;
            TokMeta nxt = cur;
            if (has_next) nxt = load_meta((REP_GATHER == 1) ? t_ + nwave : (t_ + nwave) % T_TOK, lane, x1, eidx, gws, su, sv);
            f32x2 out[8];
#pragma unroll
            for (int i = 0; i < 8; ++i) { out[i].x = 0.f; out[i].y = 0.f; }
            for (int jb = 0; jb < 16; jb += 2) {
                const int ev = (jb < 8) ? cur.e0 : cur.e1;
                const float suv = (jb < 8) ? cur.su0 : cur.su1, gvv = (jb < 8) ? cur.gv0 : cur.gv1;
                const int lbase = (jb & 7) * 8;
                gather_issue(bu, bv, ev, lbase + 8, lane, U8, V8);
                gather_compute(au, av, suv, gvv, lbase, lane, cur.xa, cur.xb, out);
                if (jb + 2 < 16) {
                    const int ev2 = (jb + 2 < 8) ? cur.e0 : cur.e1;
                    gather_issue(au, av, ev2, ((jb + 2) & 7) * 8, lane, U8, V8);
                } else if (has_next) {
                    gather_issue(au, av, nxt.e0, 0, lane, U8, V8);
                }
                gather_compute(bu, bv, suv, gvv, lbase + 8, lane, cur.xa, cur.xb, out);
            }
            float y[16];
            {
                const u32x4 xa = cur.xa, xb = cur.xb;
                y[0] = bf_lo(xa.x); y[1] = bf_hi(xa.x); y[2] = bf_lo(xa.y); y[3] = bf_hi(xa.y); y[4] = bf_lo(xa.z); y[5] = bf_hi(xa.z); y[6] = bf_lo(xa.w); y[7] = bf_hi(xa.w);
                y[8] = bf_lo(xb.x); y[9] = bf_hi(xb.x); y[10] = bf_lo(xb.y); y[11] = bf_hi(xb.y); y[12] = bf_lo(xb.z); y[13] = bf_hi(xb.z); y[14] = bf_lo(xb.w); y[15] = bf_hi(xb.w);
            }
            float s = 0.f;
#pragma unroll
            for (int i = 0; i < 8; ++i) { y[2 * i] = DN_ALPHA * y[2 * i] + out[i].x; y[2 * i + 1] = DN_ALPHA * y[2 * i + 1] + out[i].y; s += y[2 * i] + y[2 * i + 1]; }
            const float mu = wave_sum(s) * (1.0f / DM);
            float qq = 0.f;
#pragma unroll
            for (int i = 0; i < 16; ++i) { const float dd = y[i] - mu; qq += dd * dd; }
            const float rstd = rsqrtf(wave_sum(qq) * (1.0f / DM) + LN_EPS);
            const int col = 16 * lane;
            f32x4 o4[4];
#pragma unroll
            for (int q4 = 0; q4 < 4; ++q4) {
                const f32x4 ga = *(const f32x4*)(lng + col + 4 * q4), ba = *(const f32x4*)(lnb + col + 4 * q4);
#pragma unroll
                for (int e = 0; e < 4; ++e) o4[q4][e] = (y[4 * q4 + e] - mu) * rstd * ga[e] + ba[e];
            }
            if (xo_f32) {
#pragma unroll
                for (int q4 = 0; q4 < 4; ++q4) *(f32x4*)(xo_f32 + (size_t)t * DM + col + 4 * q4) = o4[q4];
            }
            if (xo_bf) {
                u32x4 w0 = {pk_bf16(o4[0].x, o4[0].y), pk_bf16(o4[0].z, o4[0].w), pk_bf16(o4[1].x, o4[1].y), pk_bf16(o4[1].z, o4[1].w)};
                u32x4 w1 = {pk_bf16(o4[2].x, o4[2].y), pk_bf16(o4[2].z, o4[2].w), pk_bf16(o4[3].x, o4[3].y), pk_bf16(o4[3].z, o4[3].w)};
                *(u32x4*)(xo_bf + (size_t)t * DM + col) = w0; *(u32x4*)(xo_bf + (size_t)t * DM + col + 8) = w1;
            }
            cur = nxt;
        }
    }
}

struct SliceMap { int j0, jstep, wslot, nslot; };
DI SliceMap slice_map(int w) {
    SliceMap m; const int G = gridDim.x;
    if (G >= 8) { m.j0 = blockIdx.x & 7; m.jstep = 8; m.wslot = (blockIdx.x >> 3) * 4 + w; m.nslot = ((G - m.j0 + 7) >> 3) * 4; }
    else { m.j0 = 0; m.jstep = 1; m.wslot = blockIdx.x * 4 + w; m.nslot = G * 4; }
    return m;
}
DI void peer_u_phase(const bf16_t* __restrict__ x1, const int* __restrict__ eidx, const unsigned char* __restrict__ U8, float* __restrict__ ph) {
    int tidv = threadIdx.x;
    asm volatile("" : "+v"(tidv));
    const int lane = tidv & 63, w = tidv >> 6, grp = lane >> 3, l8 = lane & 7;
    const SliceMap sm = slice_map(w);
    for (int j_ = sm.j0; j_ < 8 * REP_PU; j_ += sm.jstep) {
        const int j = j_ & 7;
        const unsigned char* ub = U8 + 128 * j + 16 * l8;
        const bf16_t* xb_ = x1 + 128 * j + 16 * l8;
        float* pj = ph + (size_t)j * T_TOK * 128;
        const int step = sm.nslot;
        int t = sm.wslot;
        if (t >= T_TOK) continue;
        u32x4 sa[16], sb[16];
        int e0n = 0, e1n = 0;
        u32x4 xa, xb, xan, xbn;
#define U_ISSUE(SEG, E0, E1) { _Pragma("unroll") for (int b = 0; b < 16; ++b) { const int e = __shfl((b < 8) ? (E0) : (E1), (b & 7) * 8 + grp); SEG[b] = *(const u32x4*)(ub + (size_t)e * DM); } }
#define U_COMPUTE(SEG, TT) { float hsum[2]; __builtin_amdgcn_s_setprio(1); \
            _Pragma("unroll") for (int hf = 0; hf < 2; ++hf) { float d[8]; \
                _Pragma("unroll") for (int i = 0; i < 8; ++i) { d[i] = dot_fp8_row(SEG[hf * 8 + i], xa, xb); } \
                float d4[4], d2[2]; \
                { const bool hi = (l8 & 4) != 0; _Pragma("unroll") for (int i = 0; i < 4; ++i) { const float keep = hi ? d[i + 4] : d[i], send = hi ? d[i] : d[i + 4]; d4[i] = keep + __shfl_xor(send, 4); } } \
                { const bool hi = (l8 & 2) != 0; _Pragma("unroll") for (int i = 0; i < 2; ++i) { const float keep = hi ? d4[i + 2] : d4[i], send = hi ? d4[i] : d4[i + 2]; d2[i] = keep + __shfl_xor(send, 2); } } \
                { const bool hi = (l8 & 1) != 0; const float keep = hi ? d2[1] : d2[0], send = hi ? d2[0] : d2[1]; hsum[hf] = keep + __shfl_xor(send, 1); } } \
            __builtin_amdgcn_s_setprio(0); \
            pj[(size_t)(TT) * 128 + 8 * l8 + grp] = hsum[0]; pj[(size_t)(TT) * 128 + 64 + 8 * l8 + grp] = hsum[1]; }
        {
            const int e0 = eidx[(size_t)t * 128 + lane], e1 = eidx[(size_t)t * 128 + 64 + lane];
            xa = *(const u32x4*)(xb_ + (size_t)t * DM); xb = *(const u32x4*)(xb_ + (size_t)t * DM + 8);
            U_ISSUE(sa, e0, e1)
            if (t + step < T_TOK) { e0n = eidx[(size_t)(t + step) * 128 + lane]; e1n = eidx[(size_t)(t + step) * 128 + 64 + lane]; }
        }
        for (; t < T_TOK; t += 2 * step) {
            int e0nn = 0, e1nn = 0;
            const bool n1 = t + step < T_TOK, n2 = t + 2 * step < T_TOK, n3 = t + 3 * step < T_TOK;
            if (n1) { U_ISSUE(sb, e0n, e1n) xan = *(const u32x4*)(xb_ + (size_t)(t + step) * DM); xbn = *(const u32x4*)(xb_ + (size_t)(t + step) * DM + 8); }
            if (n2) { e0nn = eidx[(size_t)(t + 2 * step) * 128 + lane]; e1nn = eidx[(size_t)(t + 2 * step) * 128 + 64 + lane]; }
            U_COMPUTE(sa, t)
            if (n1) {
                xa = xan; xb = xbn;
                if (n2) { U_ISSUE(sa, e0nn, e1nn) xan = *(const u32x4*)(xb_ + (size_t)(t + 2 * step) * DM); xbn = *(const u32x4*)(xb_ + (size_t)(t + 2 * step) * DM + 8); }
                if (n3) { e0n = eidx[(size_t)(t + 3 * step) * 128 + lane]; e1n = eidx[(size_t)(t + 3 * step) * 128 + 64 + lane]; }
                U_COMPUTE(sb, t + step)
                xa = xan; xb = xbn;
            }
        }
#undef U_ISSUE
#undef U_COMPUTE
    }
}
DI void peer_hw_phase(const float* __restrict__ ph, const int* __restrict__ eidx, const float* __restrict__ su, const float* __restrict__ sv, float* __restrict__ gws) {
    const size_t n = (size_t)T_TOK * 128, nthreads = (size_t)gridDim.x * blockDim.x;
    for (size_t i = (size_t)blockIdx.x * blockDim.x + threadIdx.x; i < n; i += nthreads) {
        float hsum = 0.f;
#pragma unroll
        for (int j = 0; j < 8; ++j) hsum += ph[(size_t)j * n + i];
        const int e = eidx[i];
        gws[i] = gws[i] * gelu_exact(hsum * su[e]) * sv[e];
    }
}
DI void peer_v_phase(const bf16_t* __restrict__ x1, const int* __restrict__ eidx, const float* __restrict__ wgt, const unsigned char* __restrict__ V8, bf16_t* __restrict__ y) {
    int tidv = threadIdx.x;
    asm volatile("" : "+v"(tidv));
    const int lane = tidv & 63, w = tidv >> 6, grp = lane >> 3, l8 = lane & 7;
    const SliceMap sm = slice_map(w);
    for (int j_ = sm.j0; j_ < 8 * REP_PV; j_ += sm.jstep) {
        const int j = j_ & 7;
        const unsigned char* vb = V8 + 128 * j + 16 * l8;
        const int col = 128 * j + 16 * l8 + 2 * grp;
        const int step = sm.nslot;
        int t = sm.wslot;
        if (t >= T_TOK) continue;
        u32x4 sa[16], sb[16];
        int e0n = 0, e1n = 0;
        float w0, w1, w0n = 0.f, w1n = 0.f;
#define V_ISSUE(SEG, E0, E1) { _Pragma("unroll") for (int b = 0; b < 16; ++b) { const int e = __shfl((b < 8) ? (E0) : (E1), (b & 7) * 8 + grp); SEG[b] = *(const u32x4*)(vb + (size_t)e * DM); } }
#define V_COMPUTE(SEG, TT) { f32x2 acc[8]; __builtin_amdgcn_s_setprio(1); \
            _Pragma("unroll") for (int i = 0; i < 8; ++i) { acc[i].x = 0.f; acc[i].y = 0.f; } \
            _Pragma("unroll") for (int b = 0; b < 16; ++b) { const float wv = __shfl((b < 8) ? w0 : w1, (b & 7) * 8 + grp); axpy_fp8_row(acc, wv, SEG[b]); } \
            float a8[8], a4[4], a2[2]; \
            { const bool hi = (lane & 32) != 0; _Pragma("unroll") for (int i = 0; i < 8; ++i) { const float lo_ = (i & 1) ? acc[i >> 1].y : acc[i >> 1].x, hi_ = (i & 1) ? acc[4 + (i >> 1)].y : acc[4 + (i >> 1)].x; \
                const float keep = hi ? hi_ : lo_, send = hi ? lo_ : hi_; a8[i] = keep + __shfl_xor(send, 32); } } \
            { const bool hi = (lane & 16) != 0; _Pragma("unroll") for (int i = 0; i < 4; ++i) { const float keep = hi ? a8[i + 4] : a8[i], send = hi ? a8[i] : a8[i + 4]; a4[i] = keep + __shfl_xor(send, 16); } } \
            { const bool hi = (lane & 8) != 0; _Pragma("unroll") for (int i = 0; i < 2; ++i) { const float keep = hi ? a4[i + 2] : a4[i], send = hi ? a4[i] : a4[i + 2]; a2[i] = keep + __shfl_xor(send, 8); } } \
            __builtin_amdgcn_s_setprio(0); \
            const unsigned xr = *(const unsigned*)(x1 + (size_t)(TT) * DM + col); \
            *(unsigned*)(y + (size_t)(TT) * DM + col) = pk_bf16(DN_ALPHA * bf_lo(xr) + a2[0], DN_ALPHA * bf_hi(xr) + a2[1]); }
        {
            const int e0 = eidx[(size_t)t * 128 + lane], e1 = eidx[(size_t)t * 128 + 64 + lane];
            w0 = wgt[(size_t)t * 128 + lane]; w1 = wgt[(size_t)t * 128 + 64 + lane];
            V_ISSUE(sa, e0, e1)
            if (t + step < T_TOK) { e0n = eidx[(size_t)(t + step) * 128 + lane]; e1n = eidx[(size_t)(t + step) * 128 + 64 + lane]; }
        }
        for (; t < T_TOK; t += 2 * step) {
            int e0nn = 0, e1nn = 0;
            const bool n1 = t + step < T_TOK, n2 = t + 2 * step < T_TOK, n3 = t + 3 * step < T_TOK;
            if (n1) { V_ISSUE(sb, e0n, e1n) w0n = wgt[(size_t)(t + step) * 128 + lane]; w1n = wgt[(size_t)(t + step) * 128 + 64 + lane]; }
            if (n2) { e0nn = eidx[(size_t)(t + 2 * step) * 128 + lane]; e1nn = eidx[(size_t)(t + 2 * step) * 128 + 64 + lane]; }
            V_COMPUTE(sa, t)
            if (n1) {
                w0 = w0n; w1 = w1n;
                if (n2) { V_ISSUE(sa, e0nn, e1nn) w0n = wgt[(size_t)(t + 2 * step) * 128 + lane]; w1n = wgt[(size_t)(t + 2 * step) * 128 + 64 + lane]; }
                if (n3) { e0n = eidx[(size_t)(t + 3 * step) * 128 + lane]; e1n = eidx[(size_t)(t + 3 * step) * 128 + 64 + lane]; }
                V_COMPUTE(sb, t + step)
                w0 = w0n; w1 = w1n;
            }
        }
#undef V_ISSUE
#undef V_COMPUTE
    }
}

#define XB_TMO      128
#define XB_XCNT(j)  (256  + 64 * (j))
#define XB_XSUB(j)  (1280 + 64 * (j))
#define XB_XGEN(j)  (2304 + 64 * (j))
#define XB_TOP      3328
#define XB_TOPGEN   3392
#define XCD_BAR_WORDS 3456
#define XB_SPIN_CAP (1u << 22)
#define LAS __attribute__((address_space(3)))

__device__ __forceinline__ unsigned xb_ld(unsigned* p)              { return __hip_atomic_load(p, __ATOMIC_RELAXED, __HIP_MEMORY_SCOPE_AGENT); }
__device__ __forceinline__ unsigned xb_add(unsigned* p, unsigned v) { return __hip_atomic_fetch_add(p, v, __ATOMIC_RELAXED, __HIP_MEMORY_SCOPE_AGENT); }
__device__ __forceinline__ unsigned xb_xcc_id() { return (unsigned)__builtin_amdgcn_s_getreg((3 << 11) | 20) & 0xFu; }
#define XB_SPIN(cond, bar) do { unsigned _sp = 0; while (cond) { __builtin_amdgcn_s_sleep(1); \
    if ((++_sp & 255u) == 0u) { if (xb_ld(&(bar)[XB_TMO])) break; if (_sp > XB_SPIN_CAP) { atomicAdd(&(bar)[XB_TMO], 1u); break; } } } } while (0)

struct XcdBarrier {
    unsigned* bar; unsigned x;
    volatile LAS unsigned* st;
};

__device__ __forceinline__ XcdBarrier xcd_barrier_post(unsigned* bar, volatile LAS unsigned* st) {
    XcdBarrier b; b.bar = bar; b.x = xb_xcc_id(); b.st = st;
    if (threadIdx.x == 0) (void)xb_add(&bar[XB_XCNT(b.x)], 1u);
    return b;
}
__device__ __forceinline__ void xcd_barrier_complete(unsigned* bar, unsigned x, unsigned& nloc, unsigned& nx) {
    const unsigned G = gridDim.x * gridDim.y * gridDim.z;
    unsigned sum, cnt, mine, sp = 0u;
    for (;;) {
        sum = 0u; cnt = 0u; mine = 0u;
#pragma unroll
        for (unsigned j = 0; j < 16; ++j) { const unsigned c = xb_ld(&bar[XB_XCNT(j)]); sum += c; cnt += (c > 0u) ? 1u : 0u; mine = (j == x) ? c : mine; }
        if (sum == G) break;
        __builtin_amdgcn_s_sleep(1);
        if ((++sp & 255u) == 0u) { if (xb_ld(&bar[XB_TMO])) break; if (sp > XB_SPIN_CAP) { atomicAdd(&bar[XB_TMO], 1u); break; } }
    }
    nloc = mine > 0u ? mine : 1u; nx = cnt > 0u ? cnt : 1u;
}

__device__ __forceinline__ void xcd_barrier(const XcdBarrier& b) {
    asm volatile("s_waitcnt vmcnt(0)" ::: "memory");
    __syncthreads();
    if (threadIdx.x == 0) {
        unsigned* bar = b.bar;
        __builtin_amdgcn_s_waitcnt(0);
        unsigned nloc = b.st[0], nx = b.st[1];
        if (nloc == 0u) { xcd_barrier_complete(bar, b.x, nloc, nx); b.st[0] = nloc; b.st[1] = nx; }
        const unsigned old = xb_add(&bar[XB_XSUB(b.x)], 1u);
        const unsigned gen = old / nloc;
        if (old + 1u == (gen + 1u) * nloc) {
            __builtin_amdgcn_fence(__ATOMIC_RELEASE, "agent");
            asm volatile("s_waitcnt vmcnt(0)" ::: "memory");
            const unsigned og = xb_add(&bar[XB_TOP], 1u);
            const unsigned tg = og / nx;
            if (og + 1u == (tg + 1u) * nx) xb_add(&bar[XB_TOPGEN], 1u);
            else XB_SPIN(xb_ld(&bar[XB_TOPGEN]) == tg, bar);
            __builtin_amdgcn_fence(__ATOMIC_ACQUIRE, "agent");
            xb_add(&bar[XB_XGEN(b.x)], 1u);
            asm volatile("s_waitcnt vmcnt(0)" ::: "memory");
        } else {
            XB_SPIN(xb_ld(&bar[XB_XGEN(b.x)]) == gen, bar);
            __builtin_amdgcn_fence(__ATOMIC_ACQUIRE, "agent");
            asm volatile("s_waitcnt vmcnt(0)" ::: "memory");
        }
    }
    __syncthreads();
}


DI void gsync(cg::grid_group& g) {
    asm volatile("s_waitcnt vmcnt(0) lgkmcnt(0)" ::: "memory");
    g.sync();
    if (threadIdx.x == 0) { __builtin_amdgcn_fence(__ATOMIC_ACQUIRE, "agent"); asm volatile("s_waitcnt vmcnt(0)" ::: "memory"); }
    __syncthreads();
}

__global__ void __launch_bounds__(256, 2) mega_fwd(Params P) {
    extern __shared__ __attribute__((aligned(16))) unsigned char lds[];
    cg::grid_group grid = cg::this_grid();
    volatile LAS unsigned* xb_st = (volatile LAS unsigned*)(lds + LDS_PHASE_BYTES);
    if (threadIdx.x == 0) { xb_st[0] = 0u; xb_st[1] = 0u; }
    __syncthreads();
    const XcdBarrier xbar = xcd_barrier_post((unsigned*)(P.ws + W_BAR), xb_st);
    unsigned char* ws = P.ws;
    bf16_t* r0 = (bf16_t*)(ws + R0);
    bf16_t* r1 = (bf16_t*)(ws + R1);
    bf16_t* r2 = (bf16_t*)(ws + R2);
    bf16_t* r3 = (bf16_t*)(ws + R3);
    int* eidx = (int*)(ws + R4);
    float* gws = (float*)(ws + R4 + 32 * MBy);
    unsigned char* U8 = ws + R5;
    unsigned char* V8 = ws + R5 + 32 * MBy;
    float* su = (float*)(ws + W_SCALE);
    float* sv = su + 2 * 16384;
    bf16_t* w_daqkv = (bf16_t*)(ws + W_DAQKV);
    bf16_t* w_dawo = (bf16_t*)(ws + W_DAWO);
    bf16_t* w_swqkv = (bf16_t*)(ws + W_SWQKV);
    bf16_t* w_swwo = (bf16_t*)(ws + W_SWWO);
    bf16_t* w_pkq0 = (bf16_t*)(ws + W_PKQ0);
    bf16_t* w_pkq1 = (bf16_t*)(ws + W_PKQ1);
    bf16_t* subk = (bf16_t*)(ws + W_SUBK);
    f32x2* rope = (f32x2*)(ws + W_ROPE);
    float* yf = (float*)(ws + R0);
    bf16_t* yb = (bf16_t*)(ws + R0);
    constexpr size_t TD = (size_t)T_TOK * DM;
    constexpr size_t NE = (size_t)16384 * DM;

    convert_flat(P.x, r1, TD);
    convert_rows_fp8(P.pk_u, U8, su, 2 * 16384);
    convert_rows_fp8(P.pk_v, V8, sv, 2 * 16384);
    convert_flat(P.pk_sub_keys, subk, (size_t)2 * 8 * 2 * 128 * 64);
    transpose_convert(P.da_w_qkv, w_daqkv, 3072, (float*)lds);
    transpose_convert(P.da_w_o, w_dawo, 1024, (float*)lds);
    transpose_convert(P.sw_w_qkv, w_swqkv, 1280, (float*)lds);
    transpose_convert(P.sw_w_o, w_swwo, 1024, (float*)lds);
    transpose_convert(P.pk_w_query, w_pkq0, 1024, (float*)lds);
    transpose_convert(P.pk_w_query + (size_t)1024 * 1024, w_pkq1, 1024, (float*)lds);
    rope_table(rope);
    gsync(grid);

    {
        bf16_t* q = r0; bf16_t* k = r0 + TD; bf16_t* vt = r0 + 2 * TD;
        EpiQKV e{q, k, vt, rope, nullptr, 1024, 1024, 7, 8};
        gemm_phase(r1, w_daqkv, T_TOK, 2048, 1024, lds, e);
        { EpiVt ev{vt, nullptr, 7, 8}; gemm_phase<EpiVt, true>(r1, w_daqkv + (size_t)2048 * 1024, T_TOK, 1024, 1024, lds, ev); }
        xcd_barrier(xbar);
        AttnArgs a{q, k, vt, r2, P.da_lambda, P.da_subln_g, nullptr, nullptr};
        attn_phase<0>(a, lds);
        xcd_barrier(xbar);
        diff_combine_phase(r2, P.da_lambda, P.da_subln_g, r1);
        xcd_barrier(xbar);
        EpiRes<true> er{(const void*)P.x, nullptr, yb};
        gemm_phase(r1, w_dawo, T_TOK, 1024, 1024, lds, er);
        xcd_barrier(xbar);
        ln_phase(yb, P.ln1_g, P.ln1_b, r2);
        xcd_barrier(xbar);
        EpiBf16 eq{r3};
        gemm_phase(r2, w_pkq0, T_TOK, 1024, 1024, lds, eq);
        xcd_barrier(xbar);
        peer_topk_phase(r3, subk, eidx, gws);
        xcd_barrier(xbar);
        peer_u_phase(r2, eidx, U8, yf);
        xcd_barrier(xbar);
        peer_hw_phase(yf, eidx, su, sv, gws);
        xcd_barrier(xbar);
        peer_v_phase(r2, eidx, gws, V8, yb);
        xcd_barrier(xbar);
        ln_phase(yb, P.ln2_g, P.ln2_b, r1);
        xcd_barrier(xbar);
    }
    {
        bf16_t* q = r0; bf16_t* k = r0 + TD; bf16_t* vt = k + (size_t)T_TOK * 128;
        EpiQKV e{q, k, vt, rope, P.sw_b_qkv, 1024, 128, 6, 2};
        gemm_phase(r1, w_swqkv, T_TOK, 1152, 1024, lds, e);
        { EpiVt ev{vt, P.sw_b_qkv + 1152, 6, 2}; gemm_phase<EpiVt, true>(r1, w_swqkv + (size_t)1152 * 1024, T_TOK, 128, 1024, lds, ev); }
        xcd_barrier(xbar);
        AttnArgs a{q, k, vt, r2, nullptr, nullptr, P.sw_sinks, nullptr};
        attn_phase<1>(a, lds);
        xcd_barrier(xbar);
        EpiRes<false> er{(const void*)r1, P.sw_b_o, yb};
        gemm_phase(r2, w_swwo, T_TOK, 1024, 1024, lds, er);
        xcd_barrier(xbar);
        ln_phase(yb, P.ln1_g + DM, P.ln1_b + DM, r3);
        xcd_barrier(xbar);
        EpiBf16 eq{r2};
        gemm_phase(r3, w_pkq1, T_TOK, 1024, 1024, lds, eq);
        xcd_barrier(xbar);
        peer_topk_phase(r2, subk + (size_t)8 * 2 * 128 * 64, eidx, gws);
        xcd_barrier(xbar);
        peer_u_phase(r3, eidx, U8 + NE, yf);
        xcd_barrier(xbar);
        peer_hw_phase(yf, eidx, su + 16384, sv + 16384, gws);
        xcd_barrier(xbar);
        peer_v_phase(r3, eidx, gws, V8 + NE, yb);
        xcd_barrier(xbar);
        ln_phase(yb, P.ln2_g + DM, P.ln2_b + DM, nullptr, P.out);
    }
}

extern "C" void kernel_launch(void* const* d_in, const int* in_sizes, int n_in, void* d_out, int out_size, void* d_ws, size_t ws_size, hipStream_t stream) {
    static int grid_blocks = 0;
    if (grid_blocks == 0) {
        if (n_in != 18 || ws_size < WS_END) { fprintf(stderr, "kernel_launch: unexpected n_in %d or ws_size %zu (< %zu)\n", n_in, ws_size, (size_t)WS_END); grid_blocks = -1; return; }
        int dev = 0, cus = 0, per_cu = 0;
        hipGetDevice(&dev);
        hipDeviceGetAttribute(&cus, hipDeviceAttributeMultiprocessorCount, dev);
        if (hipFuncSetAttribute((const void*)mega_fwd, hipFuncAttributeMaxDynamicSharedMemorySize, LDS_BYTES) != hipSuccess) { fprintf(stderr, "kernel_launch: hipFuncSetAttribute failed\n"); grid_blocks = -1; return; }
        if (hipOccupancyMaxActiveBlocksPerMultiprocessor(&per_cu, (const void*)mega_fwd, 256, LDS_BYTES) != hipSuccess || per_cu < 1) { fprintf(stderr, "kernel_launch: occupancy query failed (%d)\n", per_cu); per_cu = 1; (void)hipGetLastError(); }
        grid_blocks = cus * per_cu;
        fprintf(stderr, "kernel_launch: grid %d (%d CUs x %d)\n", grid_blocks, cus, per_cu);
    }
    if (grid_blocks < 0) return;
    Params p{};
    p.x = (const float*)d_in[0]; p.da_w_qkv = (const float*)d_in[1]; p.da_lambda = (const float*)d_in[2]; p.da_subln_g = (const float*)d_in[3]; p.da_w_o = (const float*)d_in[4];
    p.sw_w_qkv = (const float*)d_in[5]; p.sw_b_qkv = (const float*)d_in[6]; p.sw_sinks = (const float*)d_in[7]; p.sw_w_o = (const float*)d_in[8]; p.sw_b_o = (const float*)d_in[9];
    p.pk_w_query = (const float*)d_in[10]; p.pk_sub_keys = (const float*)d_in[11]; p.pk_u = (const float*)d_in[12]; p.pk_v = (const float*)d_in[13];
    p.ln1_g = (const float*)d_in[14]; p.ln1_b = (const float*)d_in[15]; p.ln2_g = (const float*)d_in[16]; p.ln2_b = (const float*)d_in[17];
    p.out = (float*)d_out; p.ws = (unsigned char*)d_ws;
    if (hipMemsetAsync((unsigned char*)d_ws + W_BAR, 0, XCD_BAR_WORDS * sizeof(unsigned), stream) != hipSuccess) { fprintf(stderr, "kernel_launch: hipMemsetAsync failed\n"); return; }
    void* args[] = {&p};
    hipError_t e = hipLaunchCooperativeKernel((const void*)mega_fwd, dim3(grid_blocks), dim3(256), args, LDS_BYTES, stream);
    if (e != hipSuccess) fprintf(stderr, "cooperative launch failed: %s (grid %d)\n", hipGetErrorString(e), grid_blocks);
}
```

```cpp
#include <hip/hip_runtime.h>
#include <hip/hip_cooperative_groups.h>
#include <cstdio>
#include <cstdint>
namespace cg = cooperative_groups;

#define DI __device__ __forceinline__
typedef unsigned short bf16_t;
typedef short bf16x8 __attribute__((ext_vector_type(8)));
typedef float f32x16 __attribute__((ext_vector_type(16)));
typedef float f32x4 __attribute__((ext_vector_type(4)));
typedef float f32x2 __attribute__((ext_vector_type(2)));
typedef unsigned u32x4 __attribute__((ext_vector_type(4)));
typedef unsigned u32x2 __attribute__((ext_vector_type(2)));
typedef __bf16 bf16x2_t __attribute__((ext_vector_type(2)));
#define MFMA(a, b, c) __builtin_amdgcn_mfma_f32_32x32x16_bf16((a), (b), (c), 0, 0, 0)

constexpr int T_TOK = 65536, DM = 1024, SEQ = 8192;
constexpr float DN_ALPHA = 1.41421356237309515f;
constexpr float LN_EPS = 1e-5f;
constexpr float LOG2E = 1.44269504088896341f;
constexpr float LAMBDA_INIT0 = 0.2f;

constexpr size_t MBy = 1u << 20;
constexpr size_t R0 = 0, R1 = 384 * MBy, R2 = 512 * MBy, R3 = 640 * MBy, R4 = 768 * MBy, R5 = 832 * MBy, R6 = 960 * MBy;
constexpr size_t W_DAQKV = R6, W_DAWO = R6 + 6 * MBy, W_SWQKV = R6 + 8 * MBy, W_SWWO = R6 + 11 * MBy, W_PKQ0 = R6 + 13 * MBy, W_PKQ1 = R6 + 15 * MBy,
                 W_SUBK = R6 + 17 * MBy, W_ROPE = R6 + 18 * MBy, W_SCALE = R6 + 20 * MBy, W_BAR = R6 + 21 * MBy, WS_END = R6 + 22 * MBy;
constexpr int LDS_PHASE_BYTES = 73728, LDS_BYTES = LDS_PHASE_BYTES + 16;
#ifndef REP_GEMM
#define REP_GEMM 1
#endif
#ifndef REP_ATT0
#define REP_ATT0 1
#endif
#ifndef REP_ATT1
#define REP_ATT1 1
#endif
#ifndef REP_TOPK
#define REP_TOPK 1
#endif
#ifndef REP_GATHER
#define REP_GATHER 1
#endif
#ifndef REP_P0
#define REP_P0 1
#endif
#ifndef REP_PU
#define REP_PU 1
#endif
#ifndef REP_PV
#define REP_PV 1
#endif

__constant__ float c_inv_freq[32] = {
    1.000000000e+00f, 7.498942018e-01f, 5.623413324e-01f, 4.216965139e-01f, 3.162277639e-01f, 2.371373922e-01f, 1.778279394e-01f, 1.333521456e-01f,
    1.000000015e-01f, 7.498941571e-02f, 5.623412877e-02f, 4.216964915e-02f, 3.162277862e-02f, 2.371373586e-02f, 1.778279431e-02f, 1.333521493e-02f,
    9.999999776e-03f, 7.498942316e-03f, 5.623413250e-03f, 4.216964822e-03f, 3.162277862e-03f, 2.371373819e-03f, 1.778279431e-03f, 1.333521446e-03f,
    1.000000047e-03f, 7.498941850e-04f, 5.623413017e-04f, 4.216965463e-04f, 3.162277862e-04f, 2.371373848e-04f, 1.778279402e-04f, 1.333521504e-04f};

struct Params {
    const float* x; const float* da_w_qkv; const float* da_lambda; const float* da_subln_g; const float* da_w_o;
    const float* sw_w_qkv; const float* sw_b_qkv; const float* sw_sinks; const float* sw_w_o; const float* sw_b_o;
    const float* pk_w_query; const float* pk_sub_keys; const float* pk_u; const float* pk_v;
    const float* ln1_g; const float* ln1_b; const float* ln2_g; const float* ln2_b;
    float* out; unsigned char* ws;
};

DI unsigned pk_bf16(float a, float b) { f32x2 f = {a, b}; return __builtin_bit_cast(unsigned, __builtin_convertvector(f, bf16x2_t)); }
DI bf16_t to_bf16(float a) { return (bf16_t)(pk_bf16(a, a) & 0xffffu); }
DI float bf_lo(unsigned u) { return __uint_as_float(u << 16); }
DI float bf_hi(unsigned u) { return __uint_as_float(u & 0xffff0000u); }
DI float wave_sum(float v) {
#pragma unroll
    for (int o = 32; o >= 1; o >>= 1) v += __shfl_xor(v, o);
    return v;
}

DI void convert_flat(const float* __restrict__ src, bf16_t* __restrict__ dst, size_t n) {
    const size_t nthreads = (size_t)gridDim.x * blockDim.x;
    for (size_t i_ = (size_t)blockIdx.x * blockDim.x + threadIdx.x; i_ < (n / 8) * REP_P0; i_ += nthreads) {
        const size_t i = (REP_P0 == 1) ? i_ : i_ % (n / 8);
        const f32x4 a = ((const f32x4*)src)[2 * i], b = ((const f32x4*)src)[2 * i + 1];
        u32x4 o; o.x = pk_bf16(a.x, a.y); o.y = pk_bf16(a.z, a.w); o.z = pk_bf16(b.x, b.y); o.w = pk_bf16(b.z, b.w);
        ((u32x4*)dst)[i] = o;
    }
}
DI void transpose_convert(const float* __restrict__ src, bf16_t* __restrict__ dst, int N, float* ldsf) {
    const int tilesN = N >> 6, ntiles = 16 * tilesN;
    const int tx = threadIdx.x & 63, ty = threadIdx.x >> 6;
    for (int tile = blockIdx.x; tile < ntiles; tile += gridDim.x) {
        const int tk = tile / tilesN, tn = tile - tk * tilesN;
        __syncthreads();
#pragma unroll
        for (int i = 0; i < 16; ++i) { const int k = ty + 4 * i; ldsf[k * 65 + tx] = src[(size_t)(tk * 64 + k) * N + tn * 64 + tx]; }
        __syncthreads();
#pragma unroll
        for (int i = 0; i < 16; ++i) { const int n = ty + 4 * i; dst[(size_t)(tn * 64 + n) * 1024 + tk * 64 + tx] = to_bf16(ldsf[tx * 65 + n]); }
    }
}
DI void rope_table(f32x2* rope) {
    const int nthreads = gridDim.x * blockDim.x;
    for (int i = blockIdx.x * blockDim.x + threadIdx.x; i < SEQ * 32; i += nthreads) {
        const int pos = i >> 5, j = i & 31;
        const float ang = (float)pos * c_inv_freq[j];
        const float kf = rintf(ang * 0.636619772367581343f);
        float rr = fmaf(-kf, 1.57079637050628662109375f, ang);
        rr = fmaf(-kf, -4.37113882867379294e-8f, rr);
        const float r2 = rr * rr;
        const float sn = rr + rr * r2 * (-1.6666654611e-1f + r2 * (8.3321608736e-3f + r2 * (-1.9515295891e-4f)));
        const float cs = 1.0f - 0.5f * r2 + r2 * r2 * (4.166664568298827e-2f + r2 * (-1.388731625493765e-3f + r2 * 2.443315711809948e-5f));
        const int q = ((int)kf) & 3;
        float c, s;
        if (q == 0) { c = cs; s = sn; } else if (q == 1) { c = -sn; s = cs; } else if (q == 2) { c = -cs; s = -sn; } else { c = sn; s = -cs; }
        f32x2 o = {c, s};
        rope[i] = o;
    }
}

DI void store_row32_bf16(bf16_t* rowp, const u32x2 (&A)[4], int h) {
#pragma unroll
    for (int gp = 0; gp < 2; ++gp) {
        const auto r0 = __builtin_amdgcn_permlane32_swap(A[2 * gp].x, A[2 * gp + 1].x, false, false);
        const auto r1 = __builtin_amdgcn_permlane32_swap(A[2 * gp].y, A[2 * gp + 1].y, false, false);
        u32x4 wv = {(unsigned)r0[0], (unsigned)r1[0], (unsigned)r0[1], (unsigned)r1[1]};
        *(u32x4*)(rowp + 16 * gp + 8 * h) = wv;
    }
}

template <class Epi, bool SW = false>
DI void gemm_phase(const bf16_t* __restrict__ A, const bf16_t* __restrict__ Bt, int M, int N, int K, unsigned char* lds, const Epi& epi) {
    constexpr int STR = 144, TB = 128 * STR;
    const int tid = threadIdx.x, lane = tid & 63, w = tid >> 6, wm = w >> 1, wn = w & 1, r = lane & 31, h = lane >> 5;
    const int tilesN = N >> 7, ntiles = (M >> 7) * tilesN, nk = K >> 6;
    const int lrow = tid >> 3, lcol = tid & 7;
    const int G = gridDim.x, tilesM = M >> 7;
    const bool xcd_order = (G & 7) == 0;
    const int nlb = xcd_order ? (G >> 3) : 1, PW = (tilesN & 7) == 0 ? 8 : tilesN;
    const int npad = ((ntiles + G - 1) / G) * G;
    for (int tile_ = blockIdx.x; tile_ < npad * REP_GEMM; tile_ += G) {
        int tile = (REP_GEMM == 1) ? tile_ : tile_ % npad;
        if (xcd_order) {
            const int rd = tile / G, c = tile - rd * G;
            const int lin = ((rd << 3) + (c & 7)) * nlb + (c >> 3);
            tile = lin;
        }
        if (tile >= ntiles) continue;
        const int pnl = tile / (tilesM * PW), rem = tile - pnl * (tilesM * PW);
        const int tm = rem / PW, tn = pnl * PW + (rem - tm * PW);
        const bf16_t* Ag = A + (size_t)(tm * 128 + lrow) * K + lcol * 8;
        const bf16_t* Bg = Bt + (size_t)(tn * 128 + lrow) * K + lcol * 8;
        u32x4 ra0[4], rb0[4], ra1[4], rb1[4];
#define GEMM_LOAD(RA, RB, KT) { _Pragma("unroll") for (int i = 0; i < 4; ++i) { RA[i] = *(const u32x4*)(Ag + (size_t)(32 * i) * K + (KT) * 64); RB[i] = *(const u32x4*)(Bg + (size_t)(32 * i) * K + (KT) * 64); } }
#define GEMM_STORE(RA, RB, BUF) { _Pragma("unroll") for (int i = 0; i < 4; ++i) { *(u32x4*)(lds + (BUF) * TB + (lrow + 32 * i) * STR + lcol * 16) = RA[i]; *(u32x4*)(lds + 2 * TB + (BUF) * TB + (lrow + 32 * i) * STR + lcol * 16) = RB[i]; } }
#define GEMM_COMPUTE(BUF) { \
            const unsigned char* la = lds + (BUF) * TB + (wm * 64 + r) * STR + h * 16; \
            const unsigned char* lb = lds + 2 * TB + (BUF) * TB + (wn * 64 + r) * STR + h * 16; \
            _Pragma("unroll") for (int ks = 0; ks < 4; ++ks) { \
                bf16x8 af[2], bfr[2]; \
                _Pragma("unroll") for (int mi = 0; mi < 2; ++mi) af[mi] = *(const bf16x8*)(la + mi * 32 * STR + ks * 32); \
                _Pragma("unroll") for (int ni = 0; ni < 2; ++ni) bfr[ni] = *(const bf16x8*)(lb + ni * 32 * STR + ks * 32); \
                _Pragma("unroll") for (int mi = 0; mi < 2; ++mi) \
                    _Pragma("unroll") for (int ni = 0; ni < 2; ++ni) acc[mi][ni] = SW ? MFMA(af[mi], bfr[ni], acc[mi][ni]) : MFMA(bfr[ni], af[mi], acc[mi][ni]); \
            } }
        GEMM_LOAD(ra0, rb0, 0)
        if (nk > 1) GEMM_LOAD(ra1, rb1, 1)
        f32x16 acc[2][2];
#pragma unroll
        for (int mi = 0; mi < 2; ++mi)
#pragma unroll
            for (int ni = 0; ni < 2; ++ni)
#pragma unroll
                for (int i = 0; i < 16; ++i) acc[mi][ni][i] = 0.f;
        GEMM_STORE(ra0, rb0, 0)
        __syncthreads();
        for (int kt = 0; kt < nk; kt += 2) {
            __builtin_amdgcn_s_setprio(1);
            if (kt + 2 < nk) GEMM_LOAD(ra0, rb0, kt + 2)
            GEMM_COMPUTE(0)
            __builtin_amdgcn_s_setprio(0);
            if (kt + 1 < nk) GEMM_STORE(ra1, rb1, 1)
            __syncthreads();
            if (kt + 1 < nk) {
                __builtin_amdgcn_s_setprio(1);
                if (kt + 3 < nk) GEMM_LOAD(ra1, rb1, kt + 3)
                GEMM_COMPUTE(1)
                __builtin_amdgcn_s_setprio(0);
                if (kt + 2 < nk) GEMM_STORE(ra0, rb0, 0)
                __syncthreads();
            }
        }
#undef GEMM_LOAD
#undef GEMM_STORE
#undef GEMM_COMPUTE
        epi(acc, tm * 128 + wm * 64, tn * 128 + wn * 64, r, h);
    }
}

struct EpiQKV {
    bf16_t* q; bf16_t* k; bf16_t* vt; const f32x2* rope; const float* bias; int nq, nk, dv_shift, hv;
    DI void operator()(const f32x16 (&acc)[2][2], int m0, int n0, int r, int h) const {
        if (n0 < nq + nk) {
            const bool isq = n0 < nq;
            bf16_t* dst = isq ? q + n0 : k + (n0 - nq);
            const int ld = isq ? nq : nk;
            const float qs = isq ? 0.125f * LOG2E : 1.0f;
#pragma unroll
            for (int mi = 0; mi < 2; ++mi) {
                const int m = m0 + mi * 32 + r, pos = m & (SEQ - 1);
                const f32x4* rp = (const f32x4*)(rope + pos * 32);
                u32x2 A1[4], A2[4];
#pragma unroll
                for (int g = 0; g < 4; ++g) {
                    const int j0 = 8 * g + 4 * h;
                    const f32x4 cs01 = rp[j0 >> 1], cs23 = rp[(j0 >> 1) + 1];
                    f32x4 b1 = {0.f, 0.f, 0.f, 0.f}, b2 = {0.f, 0.f, 0.f, 0.f};
                    if (bias) { b1 = *(const f32x4*)(bias + n0 + j0); b2 = *(const f32x4*)(bias + n0 + 32 + j0); }
                    const float c[4] = {cs01.x, cs01.z, cs23.x, cs23.z}, s[4] = {cs01.y, cs01.w, cs23.y, cs23.w};
                    float o1[4], o2[4];
#pragma unroll
                    for (int e = 0; e < 4; ++e) {
                        const float t1 = acc[mi][0][4 * g + e] + b1[e], t2 = acc[mi][1][4 * g + e] + b2[e];
                        o1[e] = (t1 * c[e] - t2 * s[e]) * qs; o2[e] = (t2 * c[e] + t1 * s[e]) * qs;
                    }
                    A1[g].x = pk_bf16(o1[0], o1[1]); A1[g].y = pk_bf16(o1[2], o1[3]); A2[g].x = pk_bf16(o2[0], o2[1]); A2[g].y = pk_bf16(o2[2], o2[3]);
                }
                store_row32_bf16(dst + (size_t)m * ld, A1, h);
                store_row32_bf16(dst + (size_t)m * ld + 32, A2, h);
            }
        }
    }
};
struct EpiVt {
    bf16_t* vt; const float* bias; int dv_shift, hv;
    DI void operator()(const f32x16 (&acc)[2][2], int m0, int n0, int r, int h) const {
        const int b = m0 >> 13, s0 = m0 & (SEQ - 1);
#pragma unroll
        for (int ni = 0; ni < 2; ++ni) {
            const int eg = n0 + ni * 32 + r;
            const float bv = bias ? bias[eg] : 0.f;
            const int hh = eg >> dv_shift, e = eg & ((1 << dv_shift) - 1);
            bf16_t* rowp = vt + ((size_t)((b * hv + hh) << dv_shift) + e) * SEQ + s0;
#pragma unroll
            for (int mi = 0; mi < 2; ++mi) {
                u32x2 A[4];
#pragma unroll
                for (int g = 0; g < 4; ++g) { A[g].x = pk_bf16(acc[mi][ni][4 * g] + bv, acc[mi][ni][4 * g + 1] + bv); A[g].y = pk_bf16(acc[mi][ni][4 * g + 2] + bv, acc[mi][ni][4 * g + 3] + bv); }
                store_row32_bf16(rowp + mi * 32, A, h);
            }
        }
    }
};
template <bool RES_F32> struct EpiRes {
    const void* res; const float* bias; bf16_t* y;
    DI void operator()(const f32x16 (&acc)[2][2], int m0, int n0, int r, int h) const {
#pragma unroll
        for (int mi = 0; mi < 2; ++mi) {
            const int m = m0 + mi * 32 + r;
#pragma unroll
            for (int ni = 0; ni < 2; ++ni) {
                u32x2 A[4];
#pragma unroll
                for (int g = 0; g < 4; ++g) {
                    const int n = n0 + ni * 32 + 8 * g + 4 * h;
                    f32x4 xr;
                    if (RES_F32) xr = *(const f32x4*)((const float*)res + (size_t)m * DM + n);
                    else { const u32x2 u = *(const u32x2*)((const bf16_t*)res + (size_t)m * DM + n); xr.x = bf_lo(u.x); xr.y = bf_hi(u.x); xr.z = bf_lo(u.y); xr.w = bf_hi(u.y); }
                    f32x4 bv = {0.f, 0.f, 0.f, 0.f};
                    if (bias) bv = *(const f32x4*)(bias + n);
                    f32x4 o;
#pragma unroll
                    for (int e = 0; e < 4; ++e) o[e] = DN_ALPHA * xr[e] + acc[mi][ni][4 * g + e] + bv[e];
                    A[g].x = pk_bf16(o[0], o[1]); A[g].y = pk_bf16(o[2], o[3]);
                }
                store_row32_bf16(y + (size_t)m * DM + n0 + ni * 32, A, h);
            }
        }
    }
};
struct EpiBf16 {
    bf16_t* o;
    DI void operator()(const f32x16 (&acc)[2][2], int m0, int n0, int r, int h) const {
#pragma unroll
        for (int mi = 0; mi < 2; ++mi) {
            const int m = m0 + mi * 32 + r;
#pragma unroll
            for (int ni = 0; ni < 2; ++ni) {
                u32x2 A[4];
#pragma unroll
                for (int g = 0; g < 4; ++g) { A[g].x = pk_bf16(acc[mi][ni][4 * g], acc[mi][ni][4 * g + 1]); A[g].y = pk_bf16(acc[mi][ni][4 * g + 2], acc[mi][ni][4 * g + 3]); }
                store_row32_bf16(o + (size_t)m * DM + n0 + ni * 32, A, h);
            }
        }
    }
};

DI void ln_phase(const bf16_t* __restrict__ y, const float* __restrict__ g, const float* __restrict__ b, bf16_t* __restrict__ xo, float* __restrict__ xf = nullptr) {
    const int lane = threadIdx.x & 63, w = threadIdx.x >> 6;
    const int gw = blockIdx.x * 4 + w, nw = gridDim.x * 4;
    f32x4 gv[4], bv[4];
#pragma unroll
    for (int j = 0; j < 2; ++j) {
        gv[2 * j] = *(const f32x4*)(g + 8 * (lane + 64 * j)); gv[2 * j + 1] = *(const f32x4*)(g + 8 * (lane + 64 * j) + 4);
        bv[2 * j] = *(const f32x4*)(b + 8 * (lane + 64 * j)); bv[2 * j + 1] = *(const f32x4*)(b + 8 * (lane + 64 * j) + 4);
    }
    u32x4 cur[2], nxt[2];
    if (gw < T_TOK) {
#pragma unroll
        for (int j = 0; j < 2; ++j) cur[j] = *(const u32x4*)(y + (size_t)gw * DM + 8 * (lane + 64 * j));
    }
    for (int row = gw; row < T_TOK; row += nw) {
        if (row + nw < T_TOK) {
#pragma unroll
            for (int j = 0; j < 2; ++j) nxt[j] = *(const u32x4*)(y + (size_t)(row + nw) * DM + 8 * (lane + 64 * j));
        }
        f32x4 v[4];
#pragma unroll
        for (int j = 0; j < 2; ++j) {
            v[2 * j].x = bf_lo(cur[j].x); v[2 * j].y = bf_hi(cur[j].x); v[2 * j].z = bf_lo(cur[j].y); v[2 * j].w = bf_hi(cur[j].y);
            v[2 * j + 1].x = bf_lo(cur[j].z); v[2 * j + 1].y = bf_hi(cur[j].z); v[2 * j + 1].z = bf_lo(cur[j].w); v[2 * j + 1].w = bf_hi(cur[j].w);
        }
        float s = 0.f;
#pragma unroll
        for (int i = 0; i < 4; ++i) s += (v[i].x + v[i].y) + (v[i].z + v[i].w);
        const float mu = wave_sum(s) * (1.0f / DM);
        float q = 0.f;
#pragma unroll
        for (int i = 0; i < 4; ++i) { const f32x4 d = v[i] - mu; q += (d.x * d.x + d.y * d.y) + (d.z * d.z + d.w * d.w); }
        const float rstd = rsqrtf(wave_sum(q) * (1.0f / DM) + LN_EPS);
#pragma unroll
        for (int j = 0; j < 2; ++j) {
            const f32x4 o0 = (v[2 * j] - mu) * rstd * gv[2 * j] + bv[2 * j], o1 = (v[2 * j + 1] - mu) * rstd * gv[2 * j + 1] + bv[2 * j + 1];
            const size_t off = (size_t)row * DM + 8 * (lane + 64 * j);
            if (xf) { *(f32x4*)(xf + off) = o0; *(f32x4*)(xf + off + 4) = o1; }
            if (xo) { u32x4 wv = {pk_bf16(o0.x, o0.y), pk_bf16(o0.z, o0.w), pk_bf16(o1.x, o1.y), pk_bf16(o1.z, o1.w)}; *(u32x4*)(xo + off) = wv; }
        }
#pragma unroll
        for (int j = 0; j < 2; ++j) cur[j] = nxt[j];
    }
}

struct AttnArgs {
    const bf16_t* q; const bf16_t* k; const bf16_t* vt; bf16_t* o;
    const float* lam_params; const float* subln_g; const float* sinks; float* scr;
};
DI int pi_perm(int r) { return (r & 0x13) | ((r & 4) << 1) | ((r & 8) >> 1); }

template <int MODE>
DI void attn_phase(const AttnArgs& a, unsigned char* lds) {
    constexpr int DV = MODE == 0 ? 128 : 64, EB = DV / 32;
    constexpr int KSTR = 144, VSTR = 144, KBUF = 64 * KSTR, VBUF = DV * VSTR;
    constexpr int KCH = 2, VCH = DV / 32;
    constexpr int LDK = MODE == 0 ? 1024 : 128, HV = MODE == 0 ? 8 : 2;
    constexpr int NITEMS = 8192;
    const int tid = threadIdx.x, lane = tid & 63, w = tid >> 6, r = lane & 31, h = lane >> 5;
    unsigned char* kl = lds;
    unsigned char* vl = lds + 3 * KBUF;
    const float NEG_INF = -__builtin_inff();
    const int G = gridDim.x;
    const int krow = tid >> 3, kcc = tid & 7;

    constexpr int REPA = MODE == 0 ? REP_ATT0 : REP_ATT1;
    for (int it_ = blockIdx.x; it_ < NITEMS * REPA; it_ += G) {
        const int it = (REPA == 1) ? it_ : it_ % NITEMS;
        int b, qb, qcol0, kcol0, vh, p = 0;
        if (MODE == 0) {
            int bh;
            const int s = it / G, c = it - s * G;
            if (G == 512) { const int jj = c >> 3; bh = (c & 7) + 8 * (s >> 1); p = jj & 1; qb = (s & 1) ? (jj >> 1) : 63 - (jj >> 1); }
            else if (G == 256) { const int jj = c >> 3; bh = (c & 7) + 8 * (s >> 2); p = s & 1; qb = (s & 2) ? jj : 63 - jj; }
            else { bh = it >> 7; p = it & 1; qb = 63 - ((it >> 1) & 63); }
            b = bh >> 3; const int hh = bh & 7; qcol0 = hh * 128; kcol0 = hh * 128; vh = hh;
        } else {
            const int head = it & 15; qb = (it >> 4) & 63; b = it >> 10;
            qcol0 = head * 64; vh = head >> 3; kcol0 = vh * 64;
        }
        const int q0 = qb * 128, qw0 = q0 + 32 * w, qpos = qw0 + r;
        const int kt0 = MODE == 0 ? 0 : ((q0 >= 128 ? q0 - 128 : 0) >> 6), kt1 = (q0 + 128) >> 6;
        const bf16_t* vg = a.vt + (size_t)(b * HV + vh) * DV * SEQ + (size_t)krow * SEQ + kcc * 8;
        const size_t tok = (size_t)b * SEQ + qpos;

        {
            const bf16_t* kg = a.k + (size_t)b * SEQ * LDK + kcol0 + p * 64 + (size_t)krow * LDK + kcc * 8;
            bf16x8 qf[4];
            {
                const bf16_t* qp = a.q + tok * 1024 + qcol0 + p * 64 + h * 8;
#pragma unroll
                for (int ks = 0; ks < 4; ++ks) qf[ks] = *(const bf16x8*)(qp + ks * 16);
            }
            f32x16 O[EB];
#pragma unroll
            for (int eb = 0; eb < EB; ++eb)
#pragma unroll
                for (int i = 0; i < 16; ++i) O[eb][i] = 0.f;
            float mrow = NEG_INF, lsum = 0.f;
            if (MODE == 1) { mrow = a.sinks[it & 15] * LOG2E; lsum = (h == 0) ? 1.0f : 0.0f; }

            u32x4 rk[KCH], rv[VCH];
#define ATT_LOADK(KT) { _Pragma("unroll") for (int i = 0; i < KCH; ++i) rk[i] = *(const u32x4*)(kg + (size_t)((KT) * 64 + 32 * i) * LDK); }
#define ATT_LOADV(KT) { _Pragma("unroll") for (int i = 0; i < VCH; ++i) rv[i] = *(const u32x4*)(vg + (size_t)(32 * i) * SEQ + (KT) * 64); }
#define ATT_STOREK(KT) { unsigned char* kd_ = kl + (((KT) - kt0) % 3) * KBUF; _Pragma("unroll") for (int i = 0; i < KCH; ++i) *(u32x4*)(kd_ + (krow + 32 * i) * KSTR + kcc * 16) = rk[i]; }
#define ATT_STOREV(KT) { unsigned char* vd_ = vl + (((KT) - kt0) & 1) * VBUF; _Pragma("unroll") for (int i = 0; i < VCH; ++i) *(u32x4*)(vd_ + (krow + 32 * i) * VSTR + kcc * 16) = rv[i]; }
            auto s_compute = [&](f32x16 (&sx)[2], const int kt) __attribute__((always_inline)) {
                const unsigned char* kb_ = kl + ((kt - kt0) % 3) * KBUF;
#pragma unroll
                for (int kb = 0; kb < 2; ++kb) {
#pragma unroll
                    for (int i = 0; i < 16; ++i) sx[kb][i] = 0.f;
#pragma unroll
                    for (int ks = 0; ks < 4; ++ks) {
                        const bf16x8 kf = *(const bf16x8*)(kb_ + (kb * 32 + pi_perm(r)) * KSTR + ks * 32 + h * 16);
                        sx[kb] = MFMA(kf, qf[ks], sx[kb]);
                    }
                }
            };
            auto step = [&](f32x16 (&s)[2], f32x16 (&sn)[2], const int kt) __attribute__((always_inline)) {
                const bool more1 = kt + 1 < kt1, more2 = kt + 2 < kt1;
                if (more2) ATT_LOADK(kt + 2)
                if (more1) ATT_LOADV(kt + 1)
                const int key0 = kt * 64;
                bool need_mask = key0 + 63 > qw0;
                if (MODE == 1) need_mask = need_mask || (key0 < qw0 + 31 - 127);
                if (need_mask) {
                    asm volatile("" ::: "memory");
#pragma unroll
                    for (int kb = 0; kb < 2; ++kb)
#pragma unroll
                        for (int i = 0; i < 16; ++i) {
                            const int key = key0 + kb * 32 + 16 * (i >> 3) + 8 * h + (i & 7);
                            bool valid = key <= qpos;
                            if (MODE == 1) valid = valid && (key > qpos - 128);
                            s[kb][i] = valid ? s[kb][i] : NEG_INF;
                        }
                }
                float mx = NEG_INF;
#pragma unroll
                for (int kb = 0; kb < 2; ++kb)
#pragma unroll
                    for (int i = 0; i < 16; ++i) mx = fmaxf(mx, s[kb][i]);
                mx = fmaxf(mx, __shfl_xor(mx, 32));
                if (__builtin_amdgcn_ballot_w64(mx > mrow + 8.0f) != 0ull) {
                    asm volatile("" ::: "memory");
                    const float mnew = fmaxf(mrow, mx);
                    const float alpha = __builtin_amdgcn_exp2f(mrow - mnew);
                    mrow = mnew;
                    lsum *= alpha;
#pragma unroll
                    for (int eb = 0; eb < EB; ++eb)
#pragma unroll
                        for (int i = 0; i < 16; ++i) O[eb][i] *= alpha;
                }
                __builtin_amdgcn_s_setprio(1);
                s_compute(sn, kt + 1);
                f32x2 ps2 = {0.f, 0.f};
#pragma unroll
                for (int kb = 0; kb < 2; ++kb)
#pragma unroll
                    for (int i = 0; i < 16; i += 2) {
                        f32x2 pv = {__builtin_amdgcn_exp2f(s[kb][i] - mrow), __builtin_amdgcn_exp2f(s[kb][i + 1] - mrow)};
                        s[kb][i] = pv.x; s[kb][i + 1] = pv.y; ps2 += pv;
                    }
                lsum += ps2.x + ps2.y;
                bf16x8 pf[2][2];
#pragma unroll
                for (int kb = 0; kb < 2; ++kb)
#pragma unroll
                    for (int s2 = 0; s2 < 2; ++s2) {
                        u32x4 u;
                        u.x = pk_bf16(s[kb][8 * s2 + 0], s[kb][8 * s2 + 1]); u.y = pk_bf16(s[kb][8 * s2 + 2], s[kb][8 * s2 + 3]);
                        u.z = pk_bf16(s[kb][8 * s2 + 4], s[kb][8 * s2 + 5]); u.w = pk_bf16(s[kb][8 * s2 + 6], s[kb][8 * s2 + 7]);
                        pf[kb][s2] = __builtin_bit_cast(bf16x8, u);
                    }
                const unsigned char* vb_ = vl + ((kt - kt0) & 1) * VBUF;
#pragma unroll
                for (int eb = 0; eb < EB; ++eb) {
#pragma unroll
                    for (int kb = 0; kb < 2; ++kb)
#pragma unroll
                        for (int s2 = 0; s2 < 2; ++s2) {
                            const bf16x8 vf = *(const bf16x8*)(vb_ + (eb * 32 + r) * VSTR + (kb * 32 + 16 * s2 + 8 * h) * 2);
                            O[eb] = MFMA(vf, pf[kb][s2], O[eb]);
                        }
                }
                __builtin_amdgcn_s_setprio(0);
                if (more2) ATT_STOREK(kt + 2)
                if (more1) ATT_STOREV(kt + 1)
                __syncthreads();
            };
            ATT_LOADK(kt0) ATT_LOADV(kt0)
            ATT_STOREK(kt0) ATT_STOREV(kt0)
            if (kt0 + 1 < kt1) { ATT_LOADK(kt0 + 1) ATT_STOREK(kt0 + 1) }
            __syncthreads();
            f32x16 sA[2], sB[2];
            s_compute(sA, kt0);
            for (int kt = kt0; kt < kt1; kt += 2) {
                step(sA, sB, kt);
                if (kt + 1 < kt1) step(sB, sA, kt + 1);
            }
#undef ATT_LOADK
#undef ATT_LOADV
#undef ATT_STOREK
#undef ATT_STOREV
            const float inv0 = 1.0f / (lsum + __shfl_xor(lsum, 32));
            bf16_t* op = (MODE == 0) ? a.o + tok * 2048 + qcol0 * 2 + p * 128 : a.o + tok * 1024 + qcol0;
#pragma unroll
            for (int eb = 0; eb < EB; ++eb) {
                u32x2 A[4];
#pragma unroll
                for (int g = 0; g < 4; ++g) { A[g].x = pk_bf16(O[eb][4 * g] * inv0, O[eb][4 * g + 1] * inv0); A[g].y = pk_bf16(O[eb][4 * g + 2] * inv0, O[eb][4 * g + 3] * inv0); }
                store_row32_bf16(op + eb * 32, A, h);
            }
        }
    }
}

DI void diff_combine_phase(const bf16_t* __restrict__ op, const float* __restrict__ lam_params, const float* __restrict__ subln_g, bf16_t* __restrict__ o) {
    const int lane = threadIdx.x & 63, w = threadIdx.x >> 6;
    const int gwave = blockIdx.x * 4 + w, nwave = gridDim.x * 4;
    const float p1 = wave_sum(lam_params[lane] * lam_params[64 + lane]);
    const float p2 = wave_sum(lam_params[128 + lane] * lam_params[192 + lane]);
    const float lam = __expf(p1) - __expf(p2) + LAMBDA_INIT0;
    const int hd = lane >> 3, d0 = 16 * (lane & 7);
    f32x4 gg[4];
#pragma unroll
    for (int i = 0; i < 4; ++i) gg[i] = *(const f32x4*)(subln_g + d0 + 4 * i);
    for (int t = gwave; t < T_TOK; t += nwave) {
        const bf16_t* p0 = op + (size_t)t * 2048 + hd * 256 + d0;
        const u32x4 a0 = *(const u32x4*)p0, a1 = *(const u32x4*)(p0 + 8), b0 = *(const u32x4*)(p0 + 128), b1 = *(const u32x4*)(p0 + 136);
        float v[16];
#pragma unroll
        for (int i = 0; i < 4; ++i) {
            v[2 * i] = bf_lo(a0[i]) - lam * bf_lo(b0[i]); v[2 * i + 1] = bf_hi(a0[i]) - lam * bf_hi(b0[i]);
            v[8 + 2 * i] = bf_lo(a1[i]) - lam * bf_lo(b1[i]); v[8 + 2 * i + 1] = bf_hi(a1[i]) - lam * bf_hi(b1[i]);
        }
        float ss = 0.f;
#pragma unroll
        for (int i = 0; i < 16; ++i) ss += v[i] * v[i];
        ss += __shfl_xor(ss, 1); ss += __shfl_xor(ss, 2); ss += __shfl_xor(ss, 4);
        const float rs = rsqrtf(ss * (1.0f / 128.0f) + LN_EPS) * (1.0f - LAMBDA_INIT0);
        u32x4 w0, w1;
#pragma unroll
        for (int i = 0; i < 4; ++i) {
            const int e = (i & 1) * 2;
            w0[i] = pk_bf16(v[2 * i] * rs * gg[i >> 1][e], v[2 * i + 1] * rs * gg[i >> 1][e + 1]);
            w1[i] = pk_bf16(v[8 + 2 * i] * rs * gg[2 + (i >> 1)][e], v[8 + 2 * i + 1] * rs * gg[2 + (i >> 1)][e + 1]);
        }
        bf16_t* dst = o + (size_t)t * 1024 + hd * 128 + d0;
        *(u32x4*)dst = w0; *(u32x4*)(dst + 8) = w1;
    }
}

DI unsigned f2ord(float f) { const unsigned u = __float_as_uint(f); return (u & 0x80000000u) ? ~u : (u | 0x80000000u); }
DI float ord2f(unsigned o) { const unsigned u = (o & 0x80000000u) ? (o & 0x7fffffffu) : ~o; return __uint_as_float(u); }
__host__ __device__ constexpr int combo_row_start(int a) { int s = 0; for (int i = 0; i < a; ++i) s += 16 / (i + 1); return s; }

constexpr int SORT16[63][2] = {{0,1}, {2,3}, {0,2}, {1,3}, {1,2}, {4,5}, {6,7}, {4,6}, {5,7}, {5,6}, {0,4}, {2,6}, {2,4}, {1,5}, {3,7}, {3,5}, {1,2}, {3,4}, {5,6}, {8,9}, {10,11}, {8,10}, {9,11}, {9,10}, {12,13}, {14,15}, {12,14}, {13,15}, {13,14}, {8,12}, {10,14}, {10,12}, {9,13}, {11,15}, {11,13}, {9,10}, {11,12}, {13,14}, {0,8}, {4,12}, {4,8}, {2,10}, {6,14}, {6,10}, {2,4}, {6,8}, {10,12}, {1,9}, {5,13}, {5,9}, {3,11}, {7,15}, {7,11}, {3,5}, {7,9}, {11,13}, {1,2}, {3,4}, {5,6}, {7,8}, {9,10}, {11,12}, {13,14}};
constexpr int BMERGE16[32][2] = {{0,8}, {1,9}, {2,10}, {3,11}, {4,12}, {5,13}, {6,14}, {7,15}, {0,4}, {1,5}, {2,6}, {3,7}, {8,12}, {9,13}, {10,14}, {11,15}, {0,2}, {1,3}, {4,6}, {5,7}, {8,10}, {9,11}, {12,14}, {13,15}, {0,1}, {2,3}, {4,5}, {6,7}, {8,9}, {10,11}, {12,13}, {14,15}};
DI void cex(unsigned& a, unsigned& b) { const unsigned hi = max(a, b), lo = min(a, b); a = hi; b = lo; }
DI void merge_top16(unsigned (&A)[16], const unsigned (&B)[16]) {
#pragma unroll
    for (int i = 0; i < 16; ++i) A[i] = max(A[i], B[15 - i]);
#pragma unroll
    for (int n = 0; n < 32; ++n) cex(A[BMERGE16[n][0]], A[BMERGE16[n][1]]);
}
DI void peer_topk_phase(const bf16_t* __restrict__ qpk, const bf16_t* __restrict__ subk, int* __restrict__ eidx, float* __restrict__ gout) {
    int tidv = threadIdx.x;
    asm volatile("" : "+v"(tidv));
    const int lane = tidv & 63, w = tidv >> 6, r = lane & 31, h = lane >> 5;
    const int gwave = blockIdx.x * 4 + w, nwave = gridDim.x * 4;
    for (int item_ = gwave; item_ < 2048 * 8 * REP_TOPK; item_ += nwave) {
        const int item = (REP_TOPK == 1) ? item_ : item_ % (2048 * 8);
        const int tt = item >> 3, hh = item & 7, t0 = tt * 32;
        unsigned top[2][16];
#pragma unroll
        for (int c = 0; c < 2; ++c) {
            f32x16 acc[4];
#pragma unroll
            for (int nb = 0; nb < 4; ++nb)
#pragma unroll
                for (int i = 0; i < 16; ++i) acc[nb][i] = 0.f;
            const bf16_t* qp = qpk + (size_t)(t0 + r) * 1024 + hh * 128 + c * 64 + h * 8;
            const bf16_t* kp = subk + ((size_t)(hh * 2 + c) * 128 + r) * 64 + h * 8;
#pragma unroll
            for (int ks = 0; ks < 4; ++ks) {
                const bf16x8 qfr = *(const bf16x8*)(qp + ks * 16);
#pragma unroll
                for (int nb = 0; nb < 4; ++nb) {
                    const bf16x8 kf = *(const bf16x8*)(kp + nb * 32 * 64 + ks * 16);
                    acc[nb] = MFMA(kf, qfr, acc[nb]);
                }
            }
            unsigned key[64];
#pragma unroll
            for (int nb = 0; nb < 4; ++nb)
#pragma unroll
                for (int i = 0; i < 16; ++i) {
                    const int n = nb * 32 + (i & 3) + 8 * (i >> 2) + 4 * h;
                    key[nb * 16 + i] = (f2ord(acc[nb][i]) & ~127u) | (unsigned)(127 - n);
                }
            unsigned g0[16], g1[16], g2[16], g3[16];
#pragma unroll
            for (int i = 0; i < 16; ++i) { g0[i] = key[i]; g1[i] = key[16 + i]; g2[i] = key[32 + i]; g3[i] = key[48 + i]; }
#pragma unroll
            for (int n = 0; n < 63; ++n) { cex(g0[SORT16[n][0]], g0[SORT16[n][1]]); cex(g1[SORT16[n][0]], g1[SORT16[n][1]]); cex(g2[SORT16[n][0]], g2[SORT16[n][1]]); cex(g3[SORT16[n][0]], g3[SORT16[n][1]]); }
            merge_top16(g0, g1); merge_top16(g2, g3); merge_top16(g0, g2);
            unsigned pb[16];
#pragma unroll
            for (int i = 0; i < 16; ++i) pb[i] = (unsigned)__shfl_xor((int)g0[i], 32);
            merge_top16(g0, pb);
#pragma unroll
            for (int i = 0; i < 16; ++i) top[c][i] = g0[i];
        }
        unsigned ck[50];
#pragma unroll
        for (int a = 0; a < 16; ++a)
#pragma unroll
            for (int b = 0; b < 16 / (a + 1); ++b) {
                const float cv = ord2f(top[0][a] & ~127u) + ord2f(top[1][b] & ~127u);
                ck[combo_row_start(a) + b] = (f2ord(cv) & ~255u) | (unsigned)(((15 - a) << 4) | (15 - b));
            }
        unsigned c0[16], c1[16], c2[16], c3[16];
#pragma unroll
        for (int i = 0; i < 16; ++i) { c0[i] = ck[i]; c1[i] = ck[16 + i]; c2[i] = ck[32 + i]; c3[i] = (i < 2) ? ck[48 + i] : 0u; }
#pragma unroll
        for (int n = 0; n < 63; ++n) { cex(c1[SORT16[n][0]], c1[SORT16[n][1]]); cex(c2[SORT16[n][0]], c2[SORT16[n][1]]); }
        merge_top16(c0, c1); merge_top16(c2, c3); merge_top16(c0, c2);
        float sv[16]; int se[16];
#pragma unroll
        for (int rd = 0; rd < 16; ++rd) {
            const unsigned m = c0[rd];
            const int asel = 15 - (int)((m >> 4) & 15u), bsel = 15 - (int)(m & 15u);
            unsigned ka = top[0][0], kb = top[1][0];
#pragma unroll
            for (int i = 1; i < 16; ++i) { ka = (asel == i) ? top[0][i] : ka; kb = (bsel == i) ? top[1][i] : kb; }
            sv[rd] = ord2f(ka & ~127u) + ord2f(kb & ~127u);
            se[rd] = (127 - (int)(ka & 127u)) * 128 + (127 - (int)(kb & 127u));
        }
        float den = 0.f;
        const float mx0 = sv[0];
#pragma unroll
        for (int i = 0; i < 16; ++i) { sv[i] = __expf(sv[i] - mx0); den += sv[i]; }
        const float inv = 1.0f / den;
        const size_t ob = (size_t)(t0 + r) * 128 + hh * 16;
        if (h == 0) {
#pragma unroll
            for (int i = 0; i < 4; ++i) { int4 v = make_int4(se[4 * i], se[4 * i + 1], se[4 * i + 2], se[4 * i + 3]); *(int4*)(eidx + ob + 4 * i) = v; }
        } else {
#pragma unroll
            for (int i = 0; i < 4; ++i) { f32x4 v = {sv[4 * i] * inv, sv[4 * i + 1] * inv, sv[4 * i + 2] * inv, sv[4 * i + 3] * inv}; *(f32x4*)(gout + ob + 4 * i) = v; }
        }
    }
}

DI float gelu_exact(float v) { return 0.5f * v * (1.0f + erff(v * 0.70710678118654752f)); }
DI void convert_rows_fp8(const float* __restrict__ src, unsigned char* __restrict__ dst, float* __restrict__ inv, int nrows) {
    const int lane = threadIdx.x & 63, w = threadIdx.x >> 6;
    const int gwave = blockIdx.x * 4 + w, nwave = gridDim.x * 4;
    for (int row_ = gwave; row_ < nrows * REP_P0; row_ += nwave) {
        const int row = (REP_P0 == 1) ? row_ : row_ % nrows;
        const f32x4* p = (const f32x4*)(src + (size_t)row * DM + 16 * lane);
        f32x4 v[4];
#pragma unroll
        for (int i = 0; i < 4; ++i) v[i] = p[i];
        float am = 0.f;
#pragma unroll
        for (int i = 0; i < 4; ++i) am = fmaxf(am, fmaxf(fmaxf(fabsf(v[i].x), fabsf(v[i].y)), fmaxf(fabsf(v[i].z), fabsf(v[i].w))));
#pragma unroll
        for (int o = 32; o >= 1; o >>= 1) am = fmaxf(am, __shfl_xor(am, o));
        const unsigned eb = (__float_as_uint(am) >> 23) & 0xffu;
        float sc = 1.0f, isc = 1.0f;
        if (eb >= 16u && eb <= 250u) { sc = __uint_as_float((261u - eb) << 23); isc = __uint_as_float((eb - 7u) << 23); }
        u32x4 o;
#pragma unroll
        for (int i = 0; i < 4; ++i) {
            int pk = __builtin_amdgcn_cvt_pk_fp8_f32(v[i].x * sc, v[i].y * sc, 0, false);
            pk = __builtin_amdgcn_cvt_pk_fp8_f32(v[i].z * sc, v[i].w * sc, pk, true);
            o[i] = (unsigned)pk;
        }
        *(u32x4*)(dst + (size_t)row * DM + 16 * lane) = o;
        if (lane == 0) inv[row] = isc;
    }
}
DI float dot16(const unsigned (&a)[8], u32x4 b0, u32x4 b1) {
    float acc;
    asm volatile("v_dot2_f32_bf16 %0, %1, %9, 0\n\tv_dot2_f32_bf16 %0, %2, %10, %0\n\tv_dot2_f32_bf16 %0, %3, %11, %0\n\tv_dot2_f32_bf16 %0, %4, %12, %0\n\t"
                 "v_dot2_f32_bf16 %0, %5, %13, %0\n\tv_dot2_f32_bf16 %0, %6, %14, %0\n\tv_dot2_f32_bf16 %0, %7, %15, %0\n\tv_dot2_f32_bf16 %0, %8, %16, %0\n\ts_nop 2"
                 : "=&v"(acc)
                 : "v"(a[0]), "v"(a[1]), "v"(a[2]), "v"(a[3]), "v"(a[4]), "v"(a[5]), "v"(a[6]), "v"(a[7]),
                   "v"(b0.x), "v"(b0.y), "v"(b0.z), "v"(b0.w), "v"(b1.x), "v"(b1.y), "v"(b1.z), "v"(b1.w));
    return acc;
}
DI float dot_fp8_row(u32x4 u, u32x4 xa, u32x4 xb) {
    unsigned a[8];
#pragma unroll
    for (int j = 0; j < 4; ++j) {
        a[2 * j] = __builtin_bit_cast(unsigned, __builtin_amdgcn_cvt_scalef32_pk_bf16_fp8(u[j], 1.0f, false));
        a[2 * j + 1] = __builtin_bit_cast(unsigned, __builtin_amdgcn_cvt_scalef32_pk_bf16_fp8(u[j], 1.0f, true));
    }
    return dot16(a, xa, xb);
}
DI void axpy_fp8_row(f32x2 (&o)[8], float wgt, u32x4 v) {
    const f32x2 w2 = {wgt, wgt};
#pragma unroll
    for (int j = 0; j < 4; ++j) {
        const f32x2 lo = __builtin_amdgcn_cvt_pk_f32_fp8(v[j], false), hi = __builtin_amdgcn_cvt_pk_f32_fp8(v[j], true);
        o[2 * j] = __builtin_elementwise_fma(w2, lo, o[2 * j]);
        o[2 * j + 1] = __builtin_elementwise_fma(w2, hi, o[2 * j + 1]);
    }
}
struct TokMeta { int e0, e1; float su0, su1, gv0, gv1; u32x4 xa, xb; };
DI TokMeta load_meta(int t, int lane, const bf16_t* __restrict__ x1, const int* __restrict__ eidx, const float* __restrict__ gws, const float* __restrict__ su, const float* __restrict__ sv) {
    TokMeta m;
    m.e0 = eidx[(size_t)t * 128 + lane]; m.e1 = eidx[(size_t)t * 128 + 64 + lane];
    const float g0 = gws[(size_t)t * 128 + lane], g1 = gws[(size_t)t * 128 + 64 + lane];
    m.su0 = su[m.e0]; m.su1 = su[m.e1];
    m.gv0 = g0 * sv[m.e0]; m.gv1 = g1 * sv[m.e1];
    m.xa = *(const u32x4*)(x1 + (size_t)t * DM + 16 * lane); m.xb = *(const u32x4*)(x1 + (size_t)t * DM + 16 * lane + 8);
    return m;
}
DI void gather_issue(u32x4 (&bu)[8], u32x4 (&bv)[8], int ev, int lbase, int lane, const unsigned char* __restrict__ U8, const unsigned char* __restrict__ V8) {
#pragma unroll
    for (int i = 0; i < 8; ++i) {
        const int e = __builtin_amdgcn_readlane(ev, lbase + i);
        bu[i] = *(const u32x4*)(U8 + (size_t)e * DM + 16 * lane);
        bv[i] = *(const u32x4*)(V8 + (size_t)e * DM + 16 * lane);
    }
}
DI void gather_compute(const u32x4 (&bu)[8], const u32x4 (&bv)[8], float suv, float gvv, int lbase, int lane_in, u32x4 xa, u32x4 xb, f32x2 (&out)[8]) {
    int lane = lane_in;
    float d[8];
#pragma unroll
    for (int i = 0; i < 8; ++i) { d[i] = dot_fp8_row(bu[i], xa, xb) * __builtin_bit_cast(float, __builtin_amdgcn_readlane(__builtin_bit_cast(int, suv), lbase + i)); __builtin_amdgcn_sched_barrier(0); }
    float d4[4], d2[2], d1;
    asm volatile("" : "+v"(lane));
    {
        const bool hi = (lane & 32) != 0;
#pragma unroll
        for (int i = 0; i < 4; ++i) { const float keep = hi ? d[i + 4] : d[i], send = hi ? d[i] : d[i + 4]; d4[i] = keep + __shfl_xor(send, 32); }
    }
    {
        const bool hi = (lane & 16) != 0;
#pragma unroll
        for (int i = 0; i < 2; ++i) { const float keep = hi ? d4[i + 2] : d4[i], send = hi ? d4[i] : d4[i + 2]; d2[i] = keep + __shfl_xor(send, 16); }
    }
    {
        const bool hi = (lane & 8) != 0;
        const float keep = hi ? d2[1] : d2[0], send = hi ? d2[0] : d2[1];
        d1 = keep + __shfl_xor(send, 8);
    }
    d1 += __shfl_xor(d1, 4); d1 += __shfl_xor(d1, 2); d1 += __shfl_xor(d1, 1);
    const float hv = gelu_exact(d1);
#pragma unroll
    for (int i = 0; i < 8; ++i) {
        const int src = 8 * (i & 1) + 16 * ((i >> 1) & 1) + 32 * ((i >> 2) & 1);
        const float wi = __builtin_bit_cast(float, __builtin_amdgcn_readlane(__builtin_bit_cast(int, gvv), lbase + i)) *
                         __builtin_bit_cast(float, __builtin_amdgcn_readlane(__builtin_bit_cast(int, hv), src));
        axpy_fp8_row(out, wi, bv[i]);
        __builtin_amdgcn_sched_barrier(0);
    }
}
DI void peer_gather_phase(const bf16_t* __restrict__ x1, const int* __restrict__ eidx, const float* __restrict__ gws, const unsigned char* __restrict__ U8,
                          const unsigned char* __restrict__ V8, const float* __restrict__ su, const float* __restrict__ sv, const float* __restrict__ lng,
                          const float* __restrict__ lnb, bf16_t* __restrict__ xo_bf, float* __restrict__ xo_f32) {
    const int lane = threadIdx.x & 63, w = threadIdx.x >> 6;
    const int gwave = blockIdx.x * 4 + w, nwave = gridDim.x * 4;
    if (gwave < T_TOK) {
        TokMeta cur = load_meta(gwave, lane, x1, eidx, gws, su, sv);
        u32x4 au[8], av[8], bu[8], bv[8];
        gather_issue(au, av, cur.e0, 0, lane, U8, V8);
        for (int t_ = gwave; t_ < T_TOK * REP_GATHER; t_ += nwave) {
            const int t = (REP_GATHER == 1) ? t_ : t_ % T_TOK;
            const bool has_next = t_ + nwave < T_TOK * REP_GATHER;
            TokMeta nxt = cur;
            if (has_next) nxt = load_meta((REP_GATHER == 1) ? t_ + nwave : (t_ + nwave) % T_TOK, lane, x1, eidx, gws, su, sv);
            f32x2 out[8];
#pragma unroll
            for (int i = 0; i < 8; ++i) { out[i].x = 0.f; out[i].y = 0.f; }
            for (int jb = 0; jb < 16; jb += 2) {
                const int ev = (jb < 8) ? cur.e0 : cur.e1;
                const float suv = (jb < 8) ? cur.su0 : cur.su1, gvv = (jb < 8) ? cur.gv0 : cur.gv1;
                const int lbase = (jb & 7) * 8;
                gather_issue(bu, bv, ev, lbase + 8, lane, U8, V8);
                gather_compute(au, av, suv, gvv, lbase, lane, cur.xa, cur.xb, out);
                if (jb + 2 < 16) {
                    const int ev2 = (jb + 2 < 8) ? cur.e0 : cur.e1;
                    gather_issue(au, av, ev2, ((jb + 2) & 7) * 8, lane, U8, V8);
                } else if (has_next) {
                    gather_issue(au, av, nxt.e0, 0, lane, U8, V8);
                }
                gather_compute(bu, bv, suv, gvv, lbase + 8, lane, cur.xa, cur.xb, out);
            }
            float y[16];
            {
                const u32x4 xa = cur.xa, xb = cur.xb;
                y[0] = bf_lo(xa.x); y[1] = bf_hi(xa.x); y[2] = bf_lo(xa.y); y[3] = bf_hi(xa.y); y[4] = bf_lo(xa.z); y[5] = bf_hi(xa.z); y[6] = bf_lo(xa.w); y[7] = bf_hi(xa.w);
                y[8] = bf_lo(xb.x); y[9] = bf_hi(xb.x); y[10] = bf_lo(xb.y); y[11] = bf_hi(xb.y); y[12] = bf_lo(xb.z); y[13] = bf_hi(xb.z); y[14] = bf_lo(xb.w); y[15] = bf_hi(xb.w);
            }
            float s = 0.f;
#pragma unroll
            for (int i = 0; i < 8; ++i) { y[2 * i] = DN_ALPHA * y[2 * i] + out[i].x; y[2 * i + 1] = DN_ALPHA * y[2 * i + 1] + out[i].y; s += y[2 * i] + y[2 * i + 1]; }
            const float mu = wave_sum(s) * (1.0f / DM);
            float qq = 0.f;
#pragma unroll
            for (int i = 0; i < 16; ++i) { const float dd = y[i] - mu; qq += dd * dd; }
            const float rstd = rsqrtf(wave_sum(qq) * (1.0f / DM) + LN_EPS);
            const int col = 16 * lane;
            f32x4 o4[4];
#pragma unroll
            for (int q4 = 0; q4 < 4; ++q4) {
                const f32x4 ga = *(const f32x4*)(lng + col + 4 * q4), ba = *(const f32x4*)(lnb + col + 4 * q4);
#pragma unroll
                for (int e = 0; e < 4; ++e) o4[q4][e] = (y[4 * q4 + e] - mu) * rstd * ga[e] + ba[e];
            }
            if (xo_f32) {
#pragma unroll
                for (int q4 = 0; q4 < 4; ++q4) *(f32x4*)(xo_f32 + (size_t)t * DM + col + 4 * q4) = o4[q4];
            }
            if (xo_bf) {
                u32x4 w0 = {pk_bf16(o4[0].x, o4[0].y), pk_bf16(o4[0].z, o4[0].w), pk_bf16(o4[1].x, o4[1].y), pk_bf16(o4[1].z, o4[1].w)};
                u32x4 w1 = {pk_bf16(o4[2].x, o4[2].y), pk_bf16(o4[2].z, o4[2].w), pk_bf16(o4[3].x, o4[3].y), pk_bf16(o4[3].z, o4[3].w)};
                *(u32x4*)(xo_bf + (size_t)t * DM + col) = w0; *(u32x4*)(xo_bf + (size_t)t * DM + col + 8) = w1;
            }
            cur = nxt;
        }
    }
}

struct SliceMap { int j0, jstep, wslot, nslot; };
DI SliceMap slice_map(int w) {
    SliceMap m; const int G = gridDim.x;
    if (G >= 8) { m.j0 = blockIdx.x & 7; m.jstep = 8; m.wslot = (blockIdx.x >> 3) * 4 + w; m.nslot = ((G - m.j0 + 7) >> 3) * 4; }
    else { m.j0 = 0; m.jstep = 1; m.wslot = blockIdx.x * 4 + w; m.nslot = G * 4; }
    return m;
}
DI void peer_u_phase(const bf16_t* __restrict__ x1, const int* __restrict__ eidx, const unsigned char* __restrict__ U8, float* __restrict__ ph) {
    int tidv = threadIdx.x;
    asm volatile("" : "+v"(tidv));
    const int lane = tidv & 63, w = tidv >> 6, grp = lane >> 3, l8 = lane & 7;
    const SliceMap sm = slice_map(w);
    for (int j_ = sm.j0; j_ < 8 * REP_PU; j_ += sm.jstep) {
        const int j = j_ & 7;
        const unsigned char* ub = U8 + 128 * j + 16 * l8;
        const bf16_t* xb_ = x1 + 128 * j + 16 * l8;
        float* pj = ph + (size_t)j * T_TOK * 128;
        const int step = sm.nslot;
        int t = sm.wslot;
        if (t >= T_TOK) continue;
        u32x4 sa[16], sb[16];
        int e0n = 0, e1n = 0;
        u32x4 xa, xb, xan, xbn;
#define U_ISSUE(SEG, E0, E1) { _Pragma("unroll") for (int b = 0; b < 16; ++b) { const int e = __shfl((b < 8) ? (E0) : (E1), (b & 7) * 8 + grp); SEG[b] = *(const u32x4*)(ub + (size_t)e * DM); } }
#define U_COMPUTE(SEG, TT) { float hsum[2]; __builtin_amdgcn_s_setprio(1); \
            _Pragma("unroll") for (int hf = 0; hf < 2; ++hf) { float d[8]; \
                _Pragma("unroll") for (int i = 0; i < 8; ++i) { d[i] = dot_fp8_row(SEG[hf * 8 + i], xa, xb); } \
                float d4[4], d2[2]; \
                { const bool hi = (l8 & 4) != 0; _Pragma("unroll") for (int i = 0; i < 4; ++i) { const float keep = hi ? d[i + 4] : d[i], send = hi ? d[i] : d[i + 4]; d4[i] = keep + __shfl_xor(send, 4); } } \
                { const bool hi = (l8 & 2) != 0; _Pragma("unroll") for (int i = 0; i < 2; ++i) { const float keep = hi ? d4[i + 2] : d4[i], send = hi ? d4[i] : d4[i + 2]; d2[i] = keep + __shfl_xor(send, 2); } } \
                { const bool hi = (l8 & 1) != 0; const float keep = hi ? d2[1] : d2[0], send = hi ? d2[0] : d2[1]; hsum[hf] = keep + __shfl_xor(send, 1); } } \
            __builtin_amdgcn_s_setprio(0); \
            pj[(size_t)(TT) * 128 + 8 * l8 + grp] = hsum[0]; pj[(size_t)(TT) * 128 + 64 + 8 * l8 + grp] = hsum[1]; }
        {
            const int e0 = eidx[(size_t)t * 128 + lane], e1 = eidx[(size_t)t * 128 + 64 + lane];
            xa = *(const u32x4*)(xb_ + (size_t)t * DM); xb = *(const u32x4*)(xb_ + (size_t)t * DM + 8);
            U_ISSUE(sa, e0, e1)
            if (t + step < T_TOK) { e0n = eidx[(size_t)(t + step) * 128 + lane]; e1n = eidx[(size_t)(t + step) * 128 + 64 + lane]; }
        }
        for (; t < T_TOK; t += 2 * step) {
            int e0nn = 0, e1nn = 0;
            const bool n1 = t + step < T_TOK, n2 = t + 2 * step < T_TOK, n3 = t + 3 * step < T_TOK;
            if (n1) { U_ISSUE(sb, e0n, e1n) xan = *(const u32x4*)(xb_ + (size_t)(t + step) * DM); xbn = *(const u32x4*)(xb_ + (size_t)(t + step) * DM + 8); }
            if (n2) { e0nn = eidx[(size_t)(t + 2 * step) * 128 + lane]; e1nn = eidx[(size_t)(t + 2 * step) * 128 + 64 + lane]; }
            U_COMPUTE(sa, t)
            if (n1) {
                xa = xan; xb = xbn;
                if (n2) { U_ISSUE(sa, e0nn, e1nn) xan = *(const u32x4*)(xb_ + (size_t)(t + 2 * step) * DM); xbn = *(const u32x4*)(xb_ + (size_t)(t + 2 * step) * DM + 8); }
                if (n3) { e0n = eidx[(size_t)(t + 3 * step) * 128 + lane]; e1n = eidx[(size_t)(t + 3 * step) * 128 + 64 + lane]; }
                U_COMPUTE(sb, t + step)
                xa = xan; xb = xbn;
            }
        }
#undef U_ISSUE
#undef U_COMPUTE
    }
}
DI void peer_hw_phase(const float* __restrict__ ph, const int* __restrict__ eidx, const float* __restrict__ su, const float* __restrict__ sv, float* __restrict__ gws) {
    const size_t n = (size_t)T_TOK * 128, nthreads = (size_t)gridDim.x * blockDim.x;
    for (size_t i = (size_t)blockIdx.x * blockDim.x + threadIdx.x; i < n; i += nthreads) {
        float hsum = 0.f;
#pragma unroll
        for (int j = 0; j < 8; ++j) hsum += ph[(size_t)j * n + i];
        const int e = eidx[i];
        gws[i] = gws[i] * gelu_exact(hsum * su[e]) * sv[e];
    }
}
DI void peer_v_phase(const bf16_t* __restrict__ x1, const int* __restrict__ eidx, const float* __restrict__ wgt, const unsigned char* __restrict__ V8, bf16_t* __restrict__ y) {
    int tidv = threadIdx.x;
    asm volatile("" : "+v"(tidv));
    const int lane = tidv & 63, w = tidv >> 6, grp = lane >> 3, l8 = lane & 7;
    const SliceMap sm = slice_map(w);
    for (int j_ = sm.j0; j_ < 8 * REP_PV; j_ += sm.jstep) {
        const int j = j_ & 7;
        const unsigned char* vb = V8 + 128 * j + 16 * l8;
        const int col = 128 * j + 16 * l8 + 2 * grp;
        const int step = sm.nslot;
        int t = sm.wslot;
        if (t >= T_TOK) continue;
        u32x4 sa[16], sb[16];
        int e0n = 0, e1n = 0;
        float w0, w1, w0n = 0.f, w1n = 0.f;
#define V_ISSUE(SEG, E0, E1) { _Pragma("unroll") for (int b = 0; b < 16; ++b) { const int e = __shfl((b < 8) ? (E0) : (E1), (b & 7) * 8 + grp); SEG[b] = *(const u32x4*)(vb + (size_t)e * DM); } }
#define V_COMPUTE(SEG, TT) { f32x2 acc[8]; __builtin_amdgcn_s_setprio(1); \
            _Pragma("unroll") for (int i = 0; i < 8; ++i) { acc[i].x = 0.f; acc[i].y = 0.f; } \
            _Pragma("unroll") for (int b = 0; b < 16; ++b) { const float wv = __shfl((b < 8) ? w0 : w1, (b & 7) * 8 + grp); axpy_fp8_row(acc, wv, SEG[b]); } \
            float a8[8], a4[4], a2[2]; \
            { const bool hi = (lane & 32) != 0; _Pragma("unroll") for (int i = 0; i < 8; ++i) { const float lo_ = (i & 1) ? acc[i >> 1].y : acc[i >> 1].x, hi_ = (i & 1) ? acc[4 + (i >> 1)].y : acc[4 + (i >> 1)].x; \
                const float keep = hi ? hi_ : lo_, send = hi ? lo_ : hi_; a8[i] = keep + __shfl_xor(send, 32); } } \
            { const bool hi = (lane & 16) != 0; _Pragma("unroll") for (int i = 0; i < 4; ++i) { const float keep = hi ? a8[i + 4] : a8[i], send = hi ? a8[i] : a8[i + 4]; a4[i] = keep + __shfl_xor(send, 16); } } \
            { const bool hi = (lane & 8) != 0; _Pragma("unroll") for (int i = 0; i < 2; ++i) { const float keep = hi ? a4[i + 2] : a4[i], send = hi ? a4[i] : a4[i + 2]; a2[i] = keep + __shfl_xor(send, 8); } } \
            __builtin_amdgcn_s_setprio(0); \
            const unsigned xr = *(const unsigned*)(x1 + (size_t)(TT) * DM + col); \
            *(unsigned*)(y + (size_t)(TT) * DM + col) = pk_bf16(DN_ALPHA * bf_lo(xr) + a2[0], DN_ALPHA * bf_hi(xr) + a2[1]); }
        {
            const int e0 = eidx[(size_t)t * 128 + lane], e1 = eidx[(size_t)t * 128 + 64 + lane];
            w0 = wgt[(size_t)t * 128 + lane]; w1 = wgt[(size_t)t * 128 + 64 + lane];
            V_ISSUE(sa, e0, e1)
            if (t + step < T_TOK) { e0n = eidx[(size_t)(t + step) * 128 + lane]; e1n = eidx[(size_t)(t + step) * 128 + 64 + lane]; }
        }
        for (; t < T_TOK; t += 2 * step) {
            int e0nn = 0, e1nn = 0;
            const bool n1 = t + step < T_TOK, n2 = t + 2 * step < T_TOK, n3 = t + 3 * step < T_TOK;
            if (n1) { V_ISSUE(sb, e0n, e1n) w0n = wgt[(size_t)(t + step) * 128 + lane]; w1n = wgt[(size_t)(t + step) * 128 + 64 + lane]; }
            if (n2) { e0nn = eidx[(size_t)(t + 2 * step) * 128 + lane]; e1nn = eidx[(size_t)(t + 2 * step) * 128 + 64 + lane]; }
            V_COMPUTE(sa, t)
            if (n1) {
                w0 = w0n; w1 = w1n;
                if (n2) { V_ISSUE(sa, e0nn, e1nn) w0n = wgt[(size_t)(t + 2 * step) * 128 + lane]; w1n = wgt[(size_t)(t + 2 * step) * 128 + 64 + lane]; }
                if (n3) { e0n = eidx[(size_t)(t + 3 * step) * 128 + lane]; e1n = eidx[(size_t)(t + 3 * step) * 128 + 64 + lane]; }
                V_COMPUTE(sb, t + step)
                w0 = w0n; w1 = w1n;
            }
        }
#undef V_ISSUE
#undef V_COMPUTE
    }
}

#define XB_TMO      128
#define XB_XCNT(j)  (256  + 64 * (j))
#define XB_XSUB(j)  (1280 + 64 * (j))
#define XB_XGEN(j)  (2304 + 64 * (j))
#define XB_TOP      3328
#define XB_TOPGEN   3392
#define XCD_BAR_WORDS 3456
#define XB_SPIN_CAP (1u << 22)
#define LAS __attribute__((address_space(3)))

__device__ __forceinline__ unsigned xb_ld(unsigned* p)              { return __hip_atomic_load(p, __ATOMIC_RELAXED, __HIP_MEMORY_SCOPE_AGENT); }
__device__ __forceinline__ unsigned xb_add(unsigned* p, unsigned v) { return __hip_atomic_fetch_add(p, v, __ATOMIC_RELAXED, __HIP_MEMORY_SCOPE_AGENT); }
__device__ __forceinline__ unsigned xb_xcc_id() { return (unsigned)__builtin_amdgcn_s_getreg((3 << 11) | 20) & 0xFu; }
#define XB_SPIN(cond, bar) do { unsigned _sp = 0; while (cond) { __builtin_amdgcn_s_sleep(1); \
    if ((++_sp & 255u) == 0u) { if (xb_ld(&(bar)[XB_TMO])) break; if (_sp > XB_SPIN_CAP) { atomicAdd(&(bar)[XB_TMO], 1u); break; } } } } while (0)

struct XcdBarrier {
    unsigned* bar; unsigned x;
    volatile LAS unsigned* st;
};

__device__ __forceinline__ XcdBarrier xcd_barrier_post(unsigned* bar, volatile LAS unsigned* st) {
    XcdBarrier b; b.bar = bar; b.x = xb_xcc_id(); b.st = st;
    if (threadIdx.x == 0) (void)xb_add(&bar[XB_XCNT(b.x)], 1u);
    return b;
}
__device__ __forceinline__ void xcd_barrier_complete(unsigned* bar, unsigned x, unsigned& nloc, unsigned& nx) {
    const unsigned G = gridDim.x * gridDim.y * gridDim.z;
    unsigned sum, cnt, mine, sp = 0u;
    for (;;) {
        sum = 0u; cnt = 0u; mine = 0u;
#pragma unroll
        for (unsigned j = 0; j < 16; ++j) { const unsigned c = xb_ld(&bar[XB_XCNT(j)]); sum += c; cnt += (c > 0u) ? 1u : 0u; mine = (j == x) ? c : mine; }
        if (sum == G) break;
        __builtin_amdgcn_s_sleep(1);
        if ((++sp & 255u) == 0u) { if (xb_ld(&bar[XB_TMO])) break; if (sp > XB_SPIN_CAP) { atomicAdd(&bar[XB_TMO], 1u); break; } }
    }
    nloc = mine > 0u ? mine : 1u; nx = cnt > 0u ? cnt : 1u;
}

__device__ __forceinline__ void xcd_barrier(const XcdBarrier& b) {
    asm volatile("s_waitcnt vmcnt(0)" ::: "memory");
    __syncthreads();
    if (threadIdx.x == 0) {
        unsigned* bar = b.bar;
        __builtin_amdgcn_s_waitcnt(0);
        unsigned nloc = b.st[0], nx = b.st[1];
        if (nloc == 0u) { xcd_barrier_complete(bar, b.x, nloc, nx); b.st[0] = nloc; b.st[1] = nx; }
        const unsigned old = xb_add(&bar[XB_XSUB(b.x)], 1u);
        const unsigned gen = old / nloc;
        if (old + 1u == (gen + 1u) * nloc) {
            __builtin_amdgcn_fence(__ATOMIC_RELEASE, "agent");
            asm volatile("s_waitcnt vmcnt(0)" ::: "memory");
            const unsigned og = xb_add(&bar[XB_TOP], 1u);
            const unsigned tg = og / nx;
            if (og + 1u == (tg + 1u) * nx) xb_add(&bar[XB_TOPGEN], 1u);
            else XB_SPIN(xb_ld(&bar[XB_TOPGEN]) == tg, bar);
            __builtin_amdgcn_fence(__ATOMIC_ACQUIRE, "agent");
            xb_add(&bar[XB_XGEN(b.x)], 1u);
            asm volatile("s_waitcnt vmcnt(0)" ::: "memory");
        } else {
            XB_SPIN(xb_ld(&bar[XB_XGEN(b.x)]) == gen, bar);
            __builtin_amdgcn_fence(__ATOMIC_ACQUIRE, "agent");
            asm volatile("s_waitcnt vmcnt(0)" ::: "memory");
        }
    }
    __syncthreads();
}


DI void gsync(cg::grid_group& g) {
    asm volatile("s_waitcnt vmcnt(0) lgkmcnt(0)" ::: "memory");
    g.sync();
    if (threadIdx.x == 0) { __builtin_amdgcn_fence(__ATOMIC_ACQUIRE, "agent"); asm volatile("s_waitcnt vmcnt(0)" ::: "memory"); }
    __syncthreads();
}

__global__ void __launch_bounds__(256, 2) mega_fwd(Params P) {
    extern __shared__ __attribute__((aligned(16))) unsigned char lds[];
    cg::grid_group grid = cg::this_grid();
    volatile LAS unsigned* xb_st = (volatile LAS unsigned*)(lds + LDS_PHASE_BYTES);
    if (threadIdx.x == 0) { xb_st[0] = 0u; xb_st[1] = 0u; }
    __syncthreads();
    const XcdBarrier xbar = xcd_barrier_post((unsigned*)(P.ws + W_BAR), xb_st);
    unsigned char* ws = P.ws;
    bf16_t* r0 = (bf16_t*)(ws + R0);
    bf16_t* r1 = (bf16_t*)(ws + R1);
    bf16_t* r2 = (bf16_t*)(ws + R2);
    bf16_t* r3 = (bf16_t*)(ws + R3);
    int* eidx = (int*)(ws + R4);
    float* gws = (float*)(ws + R4 + 32 * MBy);
    unsigned char* U8 = ws + R5;
    unsigned char* V8 = ws + R5 + 32 * MBy;
    float* su = (float*)(ws + W_SCALE);
    float* sv = su + 2 * 16384;
    bf16_t* w_daqkv = (bf16_t*)(ws + W_DAQKV);
    bf16_t* w_dawo = (bf16_t*)(ws + W_DAWO);
    bf16_t* w_swqkv = (bf16_t*)(ws + W_SWQKV);
    bf16_t* w_swwo = (bf16_t*)(ws + W_SWWO);
    bf16_t* w_pkq0 = (bf16_t*)(ws + W_PKQ0);
    bf16_t* w_pkq1 = (bf16_t*)(ws + W_PKQ1);
    bf16_t* subk = (bf16_t*)(ws + W_SUBK);
    f32x2* rope = (f32x2*)(ws + W_ROPE);
    float* yf = (float*)(ws + R0);
    bf16_t* yb = (bf16_t*)(ws + R0);
    constexpr size_t TD = (size_t)T_TOK * DM;
    constexpr size_t NE = (size_t)16384 * DM;

    convert_flat(P.x, r1, TD);
    convert_rows_fp8(P.pk_u, U8, su, 2 * 16384);
    convert_rows_fp8(P.pk_v, V8, sv, 2 * 16384);
    convert_flat(P.pk_sub_keys, subk, (size_t)2 * 8 * 2 * 128 * 64);
    transpose_convert(P.da_w_qkv, w_daqkv, 3072, (float*)lds);
    transpose_convert(P.da_w_o, w_dawo, 1024, (float*)lds);
    transpose_convert(P.sw_w_qkv, w_swqkv, 1280, (float*)lds);
    transpose_convert(P.sw_w_o, w_swwo, 1024, (float*)lds);
    transpose_convert(P.pk_w_query, w_pkq0, 1024, (float*)lds);
    transpose_convert(P.pk_w_query + (size_t)1024 * 1024, w_pkq1, 1024, (float*)lds);
    rope_table(rope);
    gsync(grid);

    {
        bf16_t* q = r0; bf16_t* k = r0 + TD; bf16_t* vt = r0 + 2 * TD;
        EpiQKV e{q, k, vt, rope, nullptr, 1024, 1024, 7, 8};
        gemm_phase(r1, w_daqkv, T_TOK, 2048, 1024, lds, e);
        { EpiVt ev{vt, nullptr, 7, 8}; gemm_phase<EpiVt, true>(r1, w_daqkv + (size_t)2048 * 1024, T_TOK, 1024, 1024, lds, ev); }
        xcd_barrier(xbar);
        AttnArgs a{q, k, vt, r2, P.da_lambda, P.da_subln_g, nullptr, nullptr};
        attn_phase<0>(a, lds);
        xcd_barrier(xbar);
        diff_combine_phase(r2, P.da_lambda, P.da_subln_g, r1);
        xcd_barrier(xbar);
        EpiRes<true> er{(const void*)P.x, nullptr, yb};
        gemm_phase(r1, w_dawo, T_TOK, 1024, 1024, lds, er);
        xcd_barrier(xbar);
        ln_phase(yb, P.ln1_g, P.ln1_b, r2);
        xcd_barrier(xbar);
        EpiBf16 eq{r3};
        gemm_phase(r2, w_pkq0, T_TOK, 1024, 1024, lds, eq);
        xcd_barrier(xbar);
        peer_topk_phase(r3, subk, eidx, gws);
        xcd_barrier(xbar);
        peer_u_phase(r2, eidx, U8, yf);
        xcd_barrier(xbar);
        peer_hw_phase(yf, eidx, su, sv, gws);
        xcd_barrier(xbar);
        peer_v_phase(r2, eidx, gws, V8, yb);
        xcd_barrier(xbar);
        ln_phase(yb, P.ln2_g, P.ln2_b, r1);
        xcd_barrier(xbar);
    }
    {
        bf16_t* q = r0; bf16_t* k = r0 + TD; bf16_t* vt = k + (size_t)T_TOK * 128;
        EpiQKV e{q, k, vt, rope, P.sw_b_qkv, 1024, 128, 6, 2};
        gemm_phase(r1, w_swqkv, T_TOK, 1152, 1024, lds, e);
        { EpiVt ev{vt, P.sw_b_qkv + 1152, 6, 2}; gemm_phase<EpiVt, true>(r1, w_swqkv + (size_t)1152 * 1024, T_TOK, 128, 1024, lds, ev); }
        xcd_barrier(xbar);
        AttnArgs a{q, k, vt, r2, nullptr, nullptr, P.sw_sinks, nullptr};
        attn_phase<1>(a, lds);
        xcd_barrier(xbar);
        EpiRes<false> er{(const void*)r1, P.sw_b_o, yb};
        gemm_phase(r2, w_swwo, T_TOK, 1024, 1024, lds, er);
        xcd_barrier(xbar);
        ln_phase(yb, P.ln1_g + DM, P.ln1_b + DM, r3);
        xcd_barrier(xbar);
        EpiBf16 eq{r2};
        gemm_phase(r3, w_pkq1, T_TOK, 1024, 1024, lds, eq);
        xcd_barrier(xbar);
        peer_topk_phase(r2, subk + (size_t)8 * 2 * 128 * 64, eidx, gws);
        xcd_barrier(xbar);
        peer_u_phase(r3, eidx, U8 + NE, yf);
        xcd_barrier(xbar);
        peer_hw_phase(yf, eidx, su + 16384, sv + 16384, gws);
        xcd_barrier(xbar);
        peer_v_phase(r3, eidx, gws, V8 + NE, yb);
        xcd_barrier(xbar);
        ln_phase(yb, P.ln2_g + DM, P.ln2_b + DM, nullptr, P.out);
    }
}

extern "C" void kernel_launch(void* const* d_in, const int* in_sizes, int n_in, void* d_out, int out_size, void* d_ws, size_t ws_size, hipStream_t stream) {
    static int grid_blocks = 0;
    if (grid_blocks == 0) {
        if (n_in != 18 || ws_size < WS_END) { fprintf(stderr, "kernel_launch: unexpected n_in %d or ws_size %zu (< %zu)\n", n_in, ws_size, (size_t)WS_END); grid_blocks = -1; return; }
        int dev = 0, cus = 0, per_cu = 0;
        hipGetDevice(&dev);
        hipDeviceGetAttribute(&cus, hipDeviceAttributeMultiprocessorCount, dev);
        if (hipFuncSetAttribute((const void*)mega_fwd, hipFuncAttributeMaxDynamicSharedMemorySize, LDS_BYTES) != hipSuccess) { fprintf(stderr, "kernel_launch: hipFuncSetAttribute failed\n"); grid_blocks = -1; return; }
        if (hipOccupancyMaxActiveBlocksPerMultiprocessor(&per_cu, (const void*)mega_fwd, 256, LDS_BYTES) != hipSuccess || per_cu < 1) { fprintf(stderr, "kernel_launch: occupancy query failed (%d)\n", per_cu); per_cu = 1; (void)hipGetLastError(); }
        grid_blocks = cus * per_cu;
        fprintf(stderr, "kernel_launch: grid %d (%d CUs x %d)\n", grid_blocks, cus, per_cu);
    }
    if (grid_blocks < 0) return;
    Params p{};
    p.x = (const float*)d_in[0]; p.da_w_qkv = (const float*)d_in[1]; p.da_lambda = (const float*)d_in[2]; p.da_subln_g = (const float*)d_in[3]; p.da_w_o = (const float*)d_in[4];
    p.sw_w_qkv = (const float*)d_in[5]; p.sw_b_qkv = (const float*)d_in[6]; p.sw_sinks = (const float*)d_in[7]; p.sw_w_o = (const float*)d_in[8]; p.sw_b_o = (const float*)d_in[9];
    p.pk_w_query = (const float*)d_in[10]; p.pk_sub_keys = (const float*)d_in[11]; p.pk_u = (const float*)d_in[12]; p.pk_v = (const float*)d_in[13];
    p.ln1_g = (const float*)d_in[14]; p.ln1_b = (const float*)d_in[15]; p.ln2_g = (const float*)d_in[16]; p.ln2_b = (const float*)d_in[17];
    p.out = (float*)d_out; p.ws = (unsigned char*)d_ws;
    if (hipMemsetAsync((unsigned char*)d_ws + W_BAR, 0, XCD_BAR_WORDS * sizeof(unsigned), stream) != hipSuccess) { fprintf(stderr, "kernel_launch: hipMemsetAsync failed\n"); return; }
    void* args[] = {&p};
    hipError_t e = hipLaunchCooperativeKernel((const void*)mega_fwd, dim3(grid_blocks), dim3(256), args, LDS_BYTES, stream);
    if (e != hipSuccess) fprintf(stderr, "cooperative launch failed: %s (grid %d)\n", hipGetErrorString(e), grid_blocks);
}
```
